# Optimizing an MI355X kernel written in HIP

```python
import math
import jax, jax.numpy as jnp
from jax import lax
import numpy as np

D_MODEL = 1024
BATCH = 8
SEQ = 8192
DEPTH = 4

GRID_W = 64
CTX_LEN = 256
HEAD_DIM = 64
N_GROUPS = 4
GROUP_W = D_MODEL // N_GROUPS
HEADS_A = GROUP_W // HEAD_DIM
KV_A = HEADS_A // 2
HEADS_B = GROUP_W // HEAD_DIM
KV_B = HEADS_B // 2
D_HYENA = GROUP_W
D_FNET = GROUP_W
FNET_GROUP_DIM = 64
FNET_GROUPS = D_FNET // FNET_GROUP_DIM
WINDOW = 128
BLOCK = 128
ROPE_THETA = 10000.0
HYENA_BANDS = 8
HYENA_EMB = 2 * HYENA_BANDS + 1
HYENA_HIDDEN = 64
HYENA_FAST_DECAY = 0.3
HYENA_SLOW_DECAY = 1.5
HYENA_TARGET = 1e-2
D_FF = ((8 * D_MODEL // 3 + 63) // 64) * 64
PROJ_SIZES = (HEADS_A * HEAD_DIM, KV_A * HEAD_DIM, KV_A * HEAD_DIM,
              HEADS_B * HEAD_DIM, KV_B * HEAD_DIM, KV_B * HEAD_DIM,
              3 * D_HYENA, D_FNET)
D_PROJ = sum(PROJ_SIZES)
DEEPNORM_ALPHA = (2 * DEPTH) ** 0.25
DEEPNORM_BETA = (8 * DEPTH) ** -0.25
LN_EPS = 1e-6
NEG_INF = -1e30

kernel_name = "hybrid_dit_parallel_groups"


def layer_norm(x, g=None, b=None):
    xf = x.astype(jnp.float32)
    mu = jnp.mean(xf, axis=-1, keepdims=True)
    var = jnp.mean(jnp.square(xf - mu), axis=-1, keepdims=True)
    y = (xf - mu) * lax.rsqrt(var + LN_EPS)
    if g is not None:
        y = y * g.astype(jnp.float32) + b.astype(jnp.float32)
    return y.astype(x.dtype)


def rms_norm(x, g):
    xf = x.astype(jnp.float32)
    y = xf * lax.rsqrt(jnp.mean(jnp.square(xf), axis=-1, keepdims=True) + LN_EPS)
    return (y * g.astype(jnp.float32)).astype(x.dtype)


def modulate(h, shift, scale):
    return h * (1.0 + scale) + shift


def axial_rope_tables(L):
    rows = L // GRID_W
    row = jnp.broadcast_to(jnp.arange(rows)[:, None], (rows, GRID_W)).reshape(-1).astype(jnp.float32)
    col = jnp.broadcast_to(jnp.arange(GRID_W)[None, :], (rows, GRID_W)).reshape(-1).astype(jnp.float32)
    half = HEAD_DIM // 2
    inv = ROPE_THETA ** (-jnp.arange(0, half, 2, dtype=jnp.float32) / half)
    ang = jnp.concatenate([row[:, None] * inv, col[:, None] * inv], axis=-1)
    return jnp.cos(ang), jnp.sin(ang)


def apply_axial_rope(x, cos, sin):
    B, L, H, _ = x.shape
    q = HEAD_DIM // 4
    xs = x.astype(jnp.float32).reshape(B, L, H, 2, 2, q)
    c = cos.reshape(L, 1, 2, q)
    s = sin.reshape(L, 1, 2, q)
    x1, x2 = xs[..., 0, :], xs[..., 1, :]
    out = jnp.stack([x1 * c - x2 * s, x2 * c + x1 * s], axis=-2)
    return out.reshape(B, L, H, HEAD_DIM).astype(x.dtype)


def split_projection(z):
    B, L, _ = z.shape
    idx = np.cumsum(PROJ_SIZES)[:-1].tolist()
    qa, ka, va, qb, kb, vb, zh, zf = jnp.split(z, idx, axis=-1)
    hd = lambda t, n: t.reshape(B, L, n, HEAD_DIM)
    return (hd(qa, HEADS_A), hd(ka, KV_A), hd(va, KV_A),
            hd(qb, HEADS_B), hd(kb, KV_B), hd(vb, KV_B), zh, zf)


def dense_attention(q, k, v, sink):
    B, C, H, _ = q.shape
    KV = k.shape[2]
    G = H // KV
    qg = q.reshape(B, C, KV, G, HEAD_DIM)
    s = jnp.einsum('bqhgd,bkhd->bhgqk', qg, k).astype(jnp.float32) * (HEAD_DIM ** -0.5)
    if sink is not None:
        s_sink = jnp.broadcast_to(sink.astype(jnp.float32).reshape(1, KV, G, 1, 1), s.shape[:-1] + (1,))
        s = jnp.concatenate([s, s_sink], axis=-1)
    p = jax.nn.softmax(s, axis=-1)[..., :k.shape[1]].astype(v.dtype)
    o = jnp.einsum('bhgqk,bkhd->bqhgd', p, v)
    return o.reshape(B, C, H * HEAD_DIM)


def banded_window_attention(q, k, v, kc, vc, sink):
    B, L, H, _ = q.shape
    KV = k.shape[2]
    G = H // KV
    C = kc.shape[1]
    nb = L // BLOCK
    qb = q.reshape(B, nb, BLOCK, KV, G, HEAD_DIM)

    def band(t):
        tb = t.reshape(B, nb, BLOCK, KV, HEAD_DIM)
        tp = jnp.pad(tb, ((0, 0), (1, 1), (0, 0), (0, 0), (0, 0)))
        return jnp.concatenate([tp[:, :-2], tp[:, 1:-1], tp[:, 2:]], axis=2)

    kb, vb = band(k), band(v)
    scale = HEAD_DIM ** -0.5
    s_loc = jnp.einsum('bnqhgd,bnkhd->bnhgqk', qb, kb).astype(jnp.float32) * scale
    qi = jnp.arange(BLOCK)[:, None]
    kj = jnp.arange(3 * BLOCK)[None, :] - BLOCK
    in_window = jnp.abs(kj - qi) <= WINDOW
    kabs = jnp.arange(nb)[:, None] * BLOCK + kj
    in_range = (kabs >= 0) & (kabs < L)
    mask = in_window[None] & in_range[:, None, :]
    s_loc = jnp.where(mask[None, :, None, None], s_loc, NEG_INF)
    s_ctx = jnp.einsum('bnqhgd,bchd->bnhgqc', qb, kc).astype(jnp.float32) * scale
    s_sink = jnp.broadcast_to(sink.astype(jnp.float32).reshape(1, 1, KV, G, 1, 1), s_loc.shape[:-1] + (1,))
    p = jax.nn.softmax(jnp.concatenate([s_loc, s_ctx, s_sink], axis=-1), axis=-1).astype(v.dtype)
    o = (jnp.einsum('bnhgqk,bnkhd->bnqhgd', p[..., :3 * BLOCK], vb)
         + jnp.einsum('bnhgqc,bchd->bnqhgd', p[..., 3 * BLOCK:3 * BLOCK + C], vc))
    return o.reshape(B, L, H * HEAD_DIM)


def blockwise_full_attention(q, k, v, kc, vc):
    B, L, H, _ = q.shape
    KV = k.shape[2]
    G = H // KV
    nb = L // BLOCK
    qb = q.reshape(B, nb, BLOCK, KV, G, HEAD_DIM).swapaxes(0, 1)
    k_all = jnp.concatenate([k, kc], axis=1)
    v_all = jnp.concatenate([v, vc], axis=1)

    def one_block(q_blk):
        s = jnp.einsum('bqhgd,bkhd->bhgqk', q_blk, k_all).astype(jnp.float32) * (HEAD_DIM ** -0.5)
        p = jax.nn.softmax(s, axis=-1).astype(v_all.dtype)
        return jnp.einsum('bhgqk,bkhd->bqhgd', p, v_all)

    o = lax.map(one_block, qb)
    return o.swapaxes(0, 1).reshape(B, L, H * HEAD_DIM)


def dwconv3(u, w, b):
    up = jnp.pad(u, ((0, 0), (1, 1), (0, 0)))
    return up[:, :-2] * w[0] + up[:, 1:-1] * w[1] + up[:, 2:] * w[2] + b


def hyena_filters(L, w1, b1, freq, w2, b2, w3):
    f32 = jnp.float32
    t = jnp.arange(L, dtype=f32)
    t_norm = t / max(L - 1, 1)
    bands = jnp.linspace(1e-4, HYENA_BANDS - 1, HYENA_BANDS, dtype=f32)
    ang = 2.0 * math.pi * t[:, None] * bands[None, :] / L
    z = jnp.concatenate([t_norm[:, None], jnp.cos(ang), -jnp.sin(ang)], axis=-1)
    fr = freq.astype(f32)
    h = jnp.sin(fr * (z @ w1.astype(f32) + b1.astype(f32)))
    h = jnp.sin(fr * (h @ w2.astype(f32) + b2.astype(f32)))
    h = (h @ w3.astype(f32)).reshape(L, 2, D_HYENA)
    min_decay = math.log(HYENA_TARGET) / HYENA_SLOW_DECAY
    max_decay = math.log(HYENA_TARGET) / HYENA_FAST_DECAY
    deltas = jnp.abs(jnp.linspace(min_decay, max_decay, D_HYENA, dtype=f32))
    decay = jnp.exp(-t_norm[:, None] * deltas[None, :])
    h = h * decay[:, None, :]
    return h[:, 0], h[:, 1]


def bidir_long_conv(u, h_fwd, h_bwd):
    B, L, D = u.shape
    k = jnp.concatenate([h_fwd.at[0].add(h_bwd[0]), jnp.zeros((1, D), jnp.float32), h_bwd[1:][::-1]], axis=0)
    U = jnp.fft.rfft(u.astype(jnp.float32), n=2 * L, axis=1)
    K = jnp.fft.rfft(k, axis=0)
    y = jnp.fft.irfft(U * K[None], n=2 * L, axis=1)[:, :L]
    return y.astype(u.dtype)


def hyena_mixer(z, conv_w, conv_b, f_w1, f_b1, f_freq, f_w2, f_b2, f_w3, skip):
    z = dwconv3(z, conv_w, conv_b)
    x0, x1, v = jnp.split(z, 3, axis=-1)
    h_fwd, h_bwd = hyena_filters(z.shape[1], f_w1, f_b1, f_freq, f_w2, f_b2, f_w3)
    v = v * x1
    v = bidir_long_conv(v, h_fwd, h_bwd) + skip * v
    return v * x0


def fnet_mixer(u, w, b):
    B, L, _ = u.shape
    ug = u.astype(jnp.float32).reshape(B, L, FNET_GROUPS, FNET_GROUP_DIM)
    f = jnp.real(jnp.fft.fftn(ug, axes=(1, 3), norm='ortho'))
    return f.reshape(B, L, D_FNET).astype(u.dtype) @ w + b


def merge_groups(oa, ob, oc, od, g):
    o = jnp.stack([oa, ob, oc, od], axis=-2)
    of = o.astype(jnp.float32)
    of = of * lax.rsqrt(jnp.mean(jnp.square(of), axis=-1, keepdims=True) + LN_EPS)
    o = of.reshape(o.shape[:-2] + (N_GROUPS * GROUP_W,)) * g.astype(jnp.float32)
    return o.astype(oa.dtype)


def conv_ffn(h, w_up, b_up, conv_w, conv_b, w_down, b_down):
    u = dwconv3(h @ w_up + b_up, conv_w, conv_b)
    a, g = jnp.split(u, 2, axis=-1)
    return (jax.nn.silu(a) * g) @ w_down + b_down


def setup_inputs(seed: int = 0) -> dict:
    key = jax.random.key(seed)
    ks = iter(jax.random.split(key, 64))
    D = D_MODEL

    def nrm(shape, scale):
        return jax.random.normal(next(ks), shape, jnp.float32) * scale

    return {
        'x': nrm((BATCH, SEQ, D), 1.0),
        'c': nrm((BATCH, D), 1.0),
        'ctx': nrm((BATCH, CTX_LEN, D), 1.0),
        'c_ctx': nrm((D,), 1.0),
        'w_ada': nrm((DEPTH, D, 6 * D), 0.5 * D ** -0.5),
        'b_ada': nrm((DEPTH, 6 * D), 0.02),
        'w_in': nrm((DEPTH, D, D_PROJ), D ** -0.5),
        'sink_a': nrm((DEPTH, HEADS_A), 0.5),
        'q_norm_g': 1.0 + nrm((DEPTH, HEAD_DIM), 0.02),
        'k_norm_g': 1.0 + nrm((DEPTH, HEAD_DIM), 0.02),
        'hy_conv_w': nrm((DEPTH, 3, 3 * D_HYENA), 3 ** -0.5),
        'hy_conv_b': nrm((DEPTH, 3 * D_HYENA), 0.02),
        'hy_f_w1': nrm((DEPTH, HYENA_EMB, HYENA_HIDDEN), HYENA_EMB ** -0.5),
        'hy_f_b1': nrm((DEPTH, HYENA_HIDDEN), 0.02),
        'hy_f_freq': 1.0 + nrm((DEPTH, HYENA_HIDDEN), 0.02),
        'hy_f_w2': nrm((DEPTH, HYENA_HIDDEN, HYENA_HIDDEN), HYENA_HIDDEN ** -0.5),
        'hy_f_b2': nrm((DEPTH, HYENA_HIDDEN), 0.02),
        'hy_f_w3': nrm((DEPTH, HYENA_HIDDEN, 2 * D_HYENA), HYENA_HIDDEN ** -0.5),
        'hy_skip': nrm((DEPTH, D_HYENA), 1.0),
        'fnet_w': nrm((DEPTH, D_FNET, D_FNET), D_FNET ** -0.5),
        'fnet_b': nrm((DEPTH, D_FNET), 0.02),
        'out_norm_g': 1.0 + nrm((DEPTH, D), 0.02),
        'w_out': nrm((DEPTH, D, D), DEEPNORM_BETA * D ** -0.5),
        'b_out': nrm((DEPTH, D), 0.02),
        'ln1_g': 1.0 + nrm((DEPTH, D), 0.02),
        'ln1_b': nrm((DEPTH, D), 0.02),
        'ffn_w_up': nrm((DEPTH, D, 2 * D_FF), D ** -0.5),
        'ffn_b_up': nrm((DEPTH, 2 * D_FF), 0.02),
        'ffn_conv_w': nrm((DEPTH, 3, 2 * D_FF), 3 ** -0.5),
        'ffn_conv_b': nrm((DEPTH, 2 * D_FF), 0.02),
        'ffn_w_down': nrm((DEPTH, D_FF, D), DEEPNORM_BETA * D_FF ** -0.5),
        'ffn_b_down': nrm((DEPTH, D), 0.02),
        'ln2_g': 1.0 + nrm((DEPTH, D), 0.02),
        'ln2_b': nrm((DEPTH, D), 0.02),
    }


def reference(x, c, ctx, c_ctx, w_ada, b_ada, w_in, sink_a, q_norm_g, k_norm_g,
              hy_conv_w, hy_conv_b, hy_f_w1, hy_f_b1, hy_f_freq, hy_f_w2, hy_f_b2, hy_f_w3, hy_skip,
              fnet_w, fnet_b, out_norm_g, w_out, b_out, ln1_g, ln1_b,
              ffn_w_up, ffn_b_up, ffn_conv_w, ffn_conv_b, ffn_w_down, ffn_b_down, ln2_g, ln2_b):
    L = x.shape[1]
    cos, sin = axial_rope_tables(L)
    for l in range(DEPTH):
        mod = jax.nn.silu(c) @ w_ada[l] + b_ada[l]
        mod_c = jax.nn.silu(c_ctx) @ w_ada[l] + b_ada[l]
        sh1, sc1, g1, sh2, sc2, g2 = jnp.split(mod[:, None, :], 6, axis=-1)
        csh1, csc1, cg1, csh2, csc2, cg2 = jnp.split(mod_c, 6, axis=-1)
        hy_p = (hy_conv_w[l], hy_conv_b[l], hy_f_w1[l], hy_f_b1[l], hy_f_freq[l],
                hy_f_w2[l], hy_f_b2[l], hy_f_w3[l], hy_skip[l])
        ffn_p = (ffn_w_up[l], ffn_b_up[l], ffn_conv_w[l], ffn_conv_b[l], ffn_w_down[l], ffn_b_down[l])

        hc = modulate(layer_norm(ctx), csh1, csc1)
        cqa, cka, cva, cqb, ckb, cvb, czh, czf = split_projection(hc @ w_in[l])
        ckb = rms_norm(ckb, k_norm_g[l])

        h = modulate(layer_norm(x), sh1, sc1)
        qa, ka, va, qb, kb, vb, zh, zf = split_projection(h @ w_in[l])
        oa = banded_window_attention(apply_axial_rope(qa, cos, sin), apply_axial_rope(ka, cos, sin),
                                     va, cka, cva, sink_a[l])
        qb = apply_axial_rope(rms_norm(qb, q_norm_g[l]), cos, sin)
        kb = apply_axial_rope(rms_norm(kb, k_norm_g[l]), cos, sin)
        ob = blockwise_full_attention(qb, kb, vb, ckb, cvb)
        oc = hyena_mixer(zh, *hy_p)
        od = fnet_mixer(zf, fnet_w[l], fnet_b[l])
        y = merge_groups(oa, ob, oc, od, out_norm_g[l]) @ w_out[l] + b_out[l]
        x = layer_norm(DEEPNORM_ALPHA * x + g1 * y, ln1_g[l], ln1_b[l])

        h2 = modulate(layer_norm(x), sh2, sc2)
        x = layer_norm(DEEPNORM_ALPHA * x + g2 * conv_ffn(h2, *ffn_p), ln2_g[l], ln2_b[l])

        if l < DEPTH - 1:
            oac = dense_attention(cqa, cka, cva, sink_a[l])
            obc = dense_attention(rms_norm(cqb, q_norm_g[l]), ckb, cvb, None)
            occ = hyena_mixer(czh, *hy_p)
            odc = fnet_mixer(czf, fnet_w[l], fnet_b[l])
            yc = merge_groups(oac, obc, occ, odc, out_norm_g[l]) @ w_out[l] + b_out[l]
            ctx = layer_norm(DEEPNORM_ALPHA * ctx + cg1 * yc, ln1_g[l], ln1_b[l])
            hc2 = modulate(layer_norm(ctx), csh2, csc2)
            ctx = layer_norm(DEEPNORM_ALPHA * ctx + cg2 * conv_ffn(hc2, *ffn_p), ln2_g[l], ln2_b[l])
    return x
```

```cpp
#include <hip/hip_runtime.h>
#include <hip/hip_cooperative_groups.h>
#include <stdint.h>
#include <cstdio>
namespace cg = cooperative_groups;

typedef unsigned short bf16_t;
typedef short bf16x8 __attribute__((ext_vector_type(8)));
typedef float f32x4 __attribute__((ext_vector_type(4)));
typedef float f32x16 __attribute__((ext_vector_type(16)));
typedef __bf16 bf2_t __attribute__((ext_vector_type(2)));
typedef float f2_t __attribute__((ext_vector_type(2)));

#define DI __device__ __forceinline__

constexpr int D = 1024, NB = 8, SEQ = 8192, DEPTH = 4, CL = 256;
constexpr int T = NB * SEQ, TC = NB * CL, MROWS = T + TC;
constexpr int DP = 2048, DFF = 2752, DFF2 = 5504, DFFP = 2816;
constexpr int LV = SEQ + CL + 64;
constexpr int HS = 1088;
constexpr int NTHR = 512;
constexpr float ALPHA = 1.681792830507429f;
constexpr float LOG2E = 1.4426950408889634f;
constexpr float INV2PI = 0.15915494309189535f;
constexpr size_t LDS_BYTES = 135168;
#ifndef PROBE_MIX
#define PROBE_MIX 0
#endif
#ifndef PROBE_DUP
#define PROBE_DUP 0x000
#endif

struct Params {
  const float *x, *c, *ctx, *c_ctx, *w_ada, *b_ada, *w_in, *sink_a, *q_norm_g, *k_norm_g,
      *hy_conv_w, *hy_conv_b, *hy_f_w1, *hy_f_b1, *hy_f_freq, *hy_f_w2, *hy_f_b2, *hy_f_w3, *hy_skip,
      *fnet_w, *fnet_b, *out_norm_g, *w_out, *b_out, *ln1_g, *ln1_b, *ffn_w_up, *ffn_b_up, *ffn_conv_w, *ffn_conv_b,
      *ffn_w_down, *ffn_b_down, *ln2_g, *ln2_b;
  float* out;
  bf16_t *Win, *Wout, *Wup, *Wdn, *Wfn;
  float* mod;
  float2 *Khat, *Khatc;
  float* cx;
  bf16_t *HO, *Y, *Zq;
  float *ZT, *ZTc;
  bf16_t *VT, *F;
  float *kvec, *kvecc;
  bf16_t* ACT;
  float *bupP, *cwP, *cbP;
  unsigned* bar;
};

DI int tidx() { int t = threadIdx.x; asm volatile("" : "+v"(t)); return t; }
DI unsigned pack2(float a, float b) {
  f2_t v = {a, b};
  bf2_t r = __builtin_convertvector(v, bf2_t);
  return __builtin_bit_cast(unsigned, r);
}
DI bf16_t f2bf(float a) { return (bf16_t)(pack2(a, 0.f) & 0xffffu); }
DI float bf2f(unsigned h) { return __uint_as_float(h << 16); }
DI float sin_rev(float r) { return __builtin_amdgcn_sinf(r); }
DI float cos_rev(float r) { return __builtin_amdgcn_cosf(r); }
#define dpp_f(v, ctrl, row_mask) __builtin_bit_cast(float, __builtin_amdgcn_update_dpp(0, __builtin_bit_cast(int, (float)(v)), (ctrl), (row_mask), 0xf, false))
DI float row16_sum(float v) {
  v += dpp_f(v, 0xB1, 0xf);
  v += dpp_f(v, 0x4E, 0xf);
  v += dpp_f(v, 0x141, 0xf);
  v += dpp_f(v, 0x140, 0xf);
  return v;
}
DI float wave_sum(float v) {
  v = row16_sum(v);
  v += dpp_f(v, 0x142, 0xa);
  v += dpp_f(v, 0x143, 0xc);
  return __builtin_bit_cast(float, __builtin_amdgcn_readlane(__builtin_bit_cast(int, v), 63));
}
DI float siluf(float x) { return x * __builtin_amdgcn_rcpf(1.f + __builtin_amdgcn_exp2f(-1.4426950408889634f * x)); }

DI int grid8() { return (int)(gridDim.x & ~7u); }
DI int xcd_local(int it, int per_xcd) {
  const int G8 = grid8();
  if ((int)blockIdx.x >= G8) return -1;
  const int loc = it * (G8 >> 3) + ((int)blockIdx.x >> 3);
  return loc < per_xcd ? loc : -1;
}
DI bool tile_map(int it, int MT, int NTn, int& mt, int& nt) {
  const int G8 = grid8();
  if ((int)blockIdx.x >= G8) return false;
  const int xcd = blockIdx.x & 7, slot = blockIdx.x >> 3, SL = G8 >> 3;
  const int MTx = (MT - xcd + 7) >> 3;
  const int q = it * SL + slot;
  if (q >= MTx * NTn) return false;
  const int gm = q / (4 * NTn), rem = q - gm * 4 * NTn;
  int gsz = MTx - 4 * gm;
  if (gsz > 4) gsz = 4;
  nt = rem / gsz;
  mt = xcd + 8 * (gm * 4 + rem % gsz);
  return true;
}

typedef __attribute__((address_space(3))) unsigned char lds_uc;
constexpr int HTB = 16384;
DI int lds_byte(int r, int c) {
  const int st = (r >> 4) * 2 + (c >> 5), rr = r & 15, cc = c & 31, ob = rr * 64 + cc * 2;
  return st * 1024 + (ob ^ (((ob >> 9) & 1) << 5));
}
DI void stage_rc(int b, int& R, int& C) {
  const int st = b >> 10, sb = b & 1023, swz = sb ^ (((sb >> 9) & 1) << 5);
  R = (st >> 1) * 16 + (swz >> 6);
  C = (st & 1) * 32 + ((swz & 63) >> 1);
}
struct PgUnit { const char* A; const char* B; int mt, nt; };
struct PgDesc { size_t a_h, b_h; int nk; unsigned voffA, voffB; size_t dA, dB; };
#define PG_WAIT_V(n) asm volatile("s_waitcnt vmcnt(" #n ")" ::: "memory")
#define PG_WAIT_L(n) asm volatile("s_waitcnt lgkmcnt(" #n ")" ::: "memory")
#define PG_BAR __builtin_amdgcn_s_barrier()
#define PG_SCHED __builtin_amdgcn_sched_barrier(0)

template <class Src, class Epi>
DI void pgemm(char* lds_, const PgDesc& d, const Src& src, const Epi& epi) {
  lds_uc* lds = (lds_uc*)lds_;
  const int tid = tidx(), wid = __builtin_amdgcn_readfirstlane(tid >> 6), lane = tid & 63, wr = wid >> 2, wc = wid & 3, fr = lane & 15, fq = lane >> 4;
  const int nt = d.nk;
  const size_t kstep = 128, ah = d.a_h, bh = d.b_h, voffA_d = d.dA, voffB_d = d.dB;
  const unsigned voffA = d.voffA, voffB = d.voffB;
  const unsigned ldsw = (unsigned)wid * 1024u;
  const int aoff = lds_byte(wr * 64 + fr, fq * 8), boff = lds_byte(wc * 32 + fr, fq * 8);
#define PG_SA(b, h) (((b) * 2 + (h)) * HTB)
#define PG_SB(b, h) ((4 + (b) * 2 + (h)) * HTB)
#define PG_STAGE(bufoff, gbase, voff) do { _Pragma("unroll") for (int _i = 0; _i < 2; ++_i) \
    __builtin_amdgcn_global_load_lds((const unsigned*)((const char*)(gbase) + (size_t)_i * voff##_d + voff), (__attribute__((address_space(3))) unsigned*)(lds + (bufoff) + ldsw + _i * 8192), 16, 0, 0); } while (0)
#define PG_LDA(dst, b, h) do { _Pragma("unroll") for (int m = 0; m < 4; ++m) _Pragma("unroll") for (int k = 0; k < 2; ++k) dst[m][k] = *(const __attribute__((address_space(3))) bf16x8*)(lds + PG_SA(b, h) + aoff + m * 2048 + k * 1024); } while (0)
#define PG_LDB(dst, b, h) do { _Pragma("unroll") for (int n = 0; n < 2; ++n) _Pragma("unroll") for (int k = 0; k < 2; ++k) dst[n][k] = *(const __attribute__((address_space(3))) bf16x8*)(lds + PG_SB(b, h) + boff + n * 2048 + k * 1024); } while (0)
#define PG_MMA(ai, bj, At, Bt) do { __builtin_amdgcn_s_setprio(1); _Pragma("unroll") for (int m = 0; m < 4; ++m) _Pragma("unroll") for (int n = 0; n < 2; ++n) _Pragma("unroll") for (int k = 0; k < 2; ++k) \
    acc[ai][bj][m][n] = __builtin_amdgcn_mfma_f32_16x16x32_bf16(Bt[n][k], At[m][k], acc[ai][bj][m][n], 0, 0, 0); __builtin_amdgcn_s_setprio(0); } while (0)
  PgUnit cur, nxt;
  int ui = 0;
  if (!src.next(0, cur)) return;
  f32x4 acc[2][2][4][2];
#pragma unroll
  for (int a = 0; a < 2; ++a)
#pragma unroll
    for (int b = 0; b < 2; ++b)
#pragma unroll
      for (int m = 0; m < 4; ++m)
#pragma unroll
        for (int n = 0; n < 2; ++n) acc[a][b][m][n] = (f32x4){0.f, 0.f, 0.f, 0.f};
  bf16x8 At[4][2], B0[2][2], B1[2][2];
  const char* cA = cur.A;
  const char* cB = cur.B;
  PG_WAIT_V(0);
  PG_STAGE(PG_SB(0, 0), cB, voffB); PG_STAGE(PG_SA(0, 0), cA, voffA); PG_STAGE(PG_SB(0, 1), cB + bh, voffB); PG_STAGE(PG_SA(0, 1), cA + ah, voffA);
  if (wr == 1) PG_BAR;
  PG_WAIT_V(4); PG_BAR;
  PG_STAGE(PG_SB(1, 0), cB + kstep, voffB); PG_STAGE(PG_SA(1, 0), cA + kstep, voffA); PG_STAGE(PG_SB(1, 1), cB + bh + kstep, voffB);
  PG_WAIT_V(6); PG_BAR;
  for (;;) {
    const bool has_next = src.next(ui + 1, nxt);
    const char* nA = has_next ? nxt.A : cA;
    const char* nB = has_next ? nxt.B : cB;
    for (int t = 0; t < nt; t += 2) {
      const bool last = (t == nt - 2);
      const char* a1 = cA + (size_t)(t + 1) * kstep;
      const char* a2 = last ? nA : cA + (size_t)(t + 2) * kstep;
      const char* b2 = last ? nB : cB + (size_t)(t + 2) * kstep;
      const char* a3 = a2 + kstep;
      const char* b3 = b2 + kstep;
      PG_LDB(B0, 0, 0); PG_SCHED; PG_LDA(At, 0, 0); PG_STAGE(PG_SA(1, 1), a1 + ah, voffA);
      PG_WAIT_L(8); PG_BAR; PG_WAIT_L(0); PG_MMA(0, 0, At, B0); PG_BAR; PG_SCHED;
      PG_LDB(B1, 0, 1); PG_STAGE(PG_SB(0, 0), b2, voffB);
      PG_BAR; PG_WAIT_L(0); PG_MMA(0, 1, At, B1); PG_BAR;
      PG_LDA(At, 0, 1); PG_STAGE(PG_SA(0, 0), a2, voffA);
      PG_BAR; PG_WAIT_L(0); PG_MMA(1, 0, At, B0); PG_BAR; PG_SCHED;
      PG_STAGE(PG_SB(0, 1), b2 + bh, voffB);
      PG_WAIT_V(6); PG_BAR; PG_MMA(1, 1, At, B1); PG_BAR;
      PG_LDB(B0, 1, 0); PG_SCHED; PG_LDA(At, 1, 0); PG_STAGE(PG_SA(0, 1), a2 + ah, voffA);
      PG_WAIT_L(8); PG_BAR; PG_WAIT_L(0); PG_MMA(0, 0, At, B0); PG_BAR; PG_SCHED;
      PG_LDB(B1, 1, 1); PG_STAGE(PG_SB(1, 0), b3, voffB);
      PG_BAR; PG_WAIT_L(0); PG_MMA(0, 1, At, B1); PG_BAR;
      PG_LDA(At, 1, 1); PG_STAGE(PG_SA(1, 0), a3, voffA);
      PG_BAR; PG_WAIT_L(0); PG_MMA(1, 0, At, B0); PG_BAR; PG_SCHED;
      PG_STAGE(PG_SB(1, 1), b3 + bh, voffB);
      PG_WAIT_V(6); PG_BAR; PG_MMA(1, 1, At, B1); PG_BAR;
    }
    epi(acc, cur, wr, wc, fr, fq);
    if (!has_next) break;
#pragma unroll
    for (int a = 0; a < 2; ++a)
#pragma unroll
      for (int b = 0; b < 2; ++b)
#pragma unroll
        for (int m = 0; m < 4; ++m)
#pragma unroll
          for (int n = 0; n < 2; ++n) acc[a][b][m][n] = (f32x4){0.f, 0.f, 0.f, 0.f};
    cur = nxt; cA = nA; cB = nB; ++ui;
  }
  PG_WAIT_V(0);
  if (wr == 0) PG_BAR;
  PG_BAR;
#undef PG_SA
#undef PG_SB
#undef PG_STAGE
#undef PG_LDA
#undef PG_LDB
#undef PG_MMA
}

struct PlainSrc {
  const bf16_t* A; const bf16_t* Wt; int lda, ldw, MT, NTn;
  DI bool next(int i, PgUnit& u) const {
    if (!tile_map(i, MT, NTn, u.mt, u.nt)) return false;
    u.A = (const char*)(A + (size_t)u.mt * 256 * lda);
    u.B = (const char*)(Wt + (size_t)u.nt * 256 * ldw);
    return true;
  }
};
struct PlainEpi {
  const float* bias; bf16_t* out; int ldo, ocol0;
  DI void operator()(f32x4 (&acc)[2][2][4][2], const PgUnit& u, int wr, int wc, int fr, int fq) const {
    asm volatile("" : "+v"(fr), "+v"(fq));
#pragma unroll
    for (int bj = 0; bj < 2; ++bj)
#pragma unroll
      for (int n = 0; n < 2; ++n) {
        const int col = u.nt * 256 + bj * 128 + wc * 32 + n * 16 + fq * 4;
        const float4 bv = *(const float4*)(bias + col);
#pragma unroll
        for (int ai = 0; ai < 2; ++ai)
#pragma unroll
          for (int m = 0; m < 4; ++m) {
            const int row = u.mt * 256 + ai * 128 + wr * 64 + m * 16 + fr;
            uint2 w;
            w.x = pack2(acc[ai][bj][m][n][0] + bv.x, acc[ai][bj][m][n][1] + bv.y);
            w.y = pack2(acc[ai][bj][m][n][2] + bv.z, acc[ai][bj][m][n][3] + bv.w);
            *(uint2*)(out + (size_t)row * ldo + ocol0 + col) = w;
          }
      }
  }
};
DI void gemm_plain_phase(char* lds, const bf16_t* A, int lda, const bf16_t* Wt, int ldw, int K, int MT, int NTn, const float* bias,
                         bf16_t* out, int ldo, int ocol0) {
  PgDesc d;
  d.a_h = (size_t)128 * lda * 2; d.b_h = (size_t)128 * ldw * 2; d.nk = K / 64;
  {
    int R, C;
    stage_rc(tidx() * 16, R, C);
    d.voffA = (unsigned)(R * lda + C) * 2u; d.dA = (size_t)64 * lda * 2;
    d.voffB = (unsigned)(R * ldw + C) * 2u; d.dB = (size_t)64 * ldw * 2;
  }
  PlainSrc src{A, Wt, lda, ldw, MT, NTn};
  PlainEpi epi{bias, out, ldo, ocol0};
  pgemm(lds, d, src, epi);
}

struct InprojSrc {
  const bf16_t* A; const bf16_t* Wt;
  DI bool next(int i, PgUnit& u) const {
    if (!tile_map(i, MROWS / 256, DP / 256, u.mt, u.nt)) return false;
    u.A = (const char*)(A + (size_t)u.mt * 256 * HS);
    u.B = (const char*)(Wt + (size_t)u.nt * 256 * HS);
    return true;
  }
};
struct InprojEpi {
  const Params* pp; int l;
  DI void operator()(f32x4 (&acc)[2][2][4][2], const PgUnit& u, int wr, int wc, int fr, int fq) const {
    asm volatile("" : "+v"(fr), "+v"(fq));
    const Params& p = *pp;
    const int mt = u.mt, hs = u.nt * 4 + wc;
    const bool isctx = mt >= 256;
    int b, t0;
    if (!isctx) { const int row0 = mt * 256; b = row0 >> 13; t0 = row0 & (SEQ - 1); }
    else { b = mt - 256; t0 = 0; }
    const int rb = wr * 64 + fr;
    if (hs < 6 || (hs >= 8 && hs < 14)) {
      const bool isB = hs >= 8;
      const int hh = isB ? hs - 8 : hs;
      const bool isq = hh < 4;
      if (isB) {
        const float* gp = (isq ? p.q_norm_g : p.k_norm_g) + l * 64 + fq * 4;
        const float4 g00 = *(const float4*)(gp), g01 = *(const float4*)(gp + 16), g10 = *(const float4*)(gp + 32), g11 = *(const float4*)(gp + 48);
#pragma unroll
        for (int ai = 0; ai < 2; ++ai)
#pragma unroll
          for (int m = 0; m < 4; ++m) {
            float ss = 0.f;
#pragma unroll
            for (int bj = 0; bj < 2; ++bj)
#pragma unroll
              for (int n = 0; n < 2; ++n)
#pragma unroll
                for (int j = 0; j < 4; ++j) ss += acc[ai][bj][m][n][j] * acc[ai][bj][m][n][j];
            ss += __shfl_xor(ss, 16, 64); ss += __shfl_xor(ss, 32, 64);
            const float r = rsqrtf(ss * (1.f / 64.f) + 1e-6f);
            acc[ai][0][m][0] *= (f32x4){g00.x * r, g00.y * r, g00.z * r, g00.w * r};
            acc[ai][0][m][1] *= (f32x4){g01.x * r, g01.y * r, g01.z * r, g01.w * r};
            acc[ai][1][m][0] *= (f32x4){g10.x * r, g10.y * r, g10.z * r, g10.w * r};
            acc[ai][1][m][1] *= (f32x4){g11.x * r, g11.y * r, g11.z * r, g11.w * r};
            __builtin_amdgcn_sched_barrier(0);
          }
      }
      if (!isctx) {
        float inv[4];
#pragma unroll
        for (int j = 0; j < 4; ++j) inv[j] = exp2f(-(float)(fq * 4 + j) * (13.287712379549449f / 16.f)) * INV2PI;
#pragma unroll
        for (int ai = 0; ai < 2; ++ai)
#pragma unroll
          for (int m = 0; m < 4; ++m) {
            const int t = t0 + ai * 128 + rb + m * 16;
            const float p0 = (float)(t >> 6), p1 = (float)(t & 63);
#pragma unroll
            for (int j = 0; j < 4; ++j) {
              const float a0 = p0 * inv[j], a1 = p1 * inv[j];
              const float c0 = cos_rev(a0), s0 = sin_rev(a0), c1 = cos_rev(a1), s1 = sin_rev(a1);
              const float x1 = acc[ai][0][m][0][j], x2 = acc[ai][0][m][1][j], y1 = acc[ai][1][m][0][j], y2 = acc[ai][1][m][1][j];
              acc[ai][0][m][0][j] = x1 * c0 - x2 * s0; acc[ai][0][m][1][j] = x2 * c0 + x1 * s0;
              acc[ai][1][m][0][j] = y1 * c1 - y2 * s1; acc[ai][1][m][1][j] = y2 * c1 + y1 * s1;
            }
            __builtin_amdgcn_sched_barrier(0);
          }
      }
      const float sc = isq ? 0.125f * LOG2E : 1.f;
#pragma unroll
      for (int ai = 0; ai < 2; ++ai)
#pragma unroll
        for (int m = 0; m < 4; ++m) {
          bf16_t* zr = p.Zq + (size_t)(mt * 256 + ai * 128 + rb + m * 16) * HS + hs * 64 + fq * 4;
#pragma unroll
          for (int bj = 0; bj < 2; ++bj)
#pragma unroll
            for (int n = 0; n < 2; ++n) {
              uint2 w;
              w.x = pack2(acc[ai][bj][m][n][0] * sc, acc[ai][bj][m][n][1] * sc);
              w.y = pack2(acc[ai][bj][m][n][2] * sc, acc[ai][bj][m][n][3] * sc);
              *(uint2*)(zr + bj * 32 + n * 16) = w;
            }
        }
    } else if (hs < 16) {
      const int grp = hs >= 14 ? 1 : 0, kvh = hs & 1;
      bf16_t* vb = p.VT + (size_t)((grp * 8 + b) * 2 + kvh) * 64 * LV + (isctx ? SEQ : 0) + t0 + rb;
#pragma unroll
      for (int bj = 0; bj < 2; ++bj)
#pragma unroll
        for (int n = 0; n < 2; ++n)
#pragma unroll
          for (int j = 0; j < 4; ++j) {
            bf16_t* vd = vb + (size_t)(bj * 32 + n * 16 + fq * 4 + j) * LV;
#pragma unroll
            for (int ai = 0; ai < 2; ++ai)
#pragma unroll
              for (int m = 0; m < 4; ++m) vd[ai * 128 + m * 16] = f2bf(acc[ai][bj][m][n][j]);
          }
    } else {
      const int colb = hs * 64 - 1024;
      const int Ls = isctx ? CL : SEQ;
      float* zb = (isctx ? p.ZTc + (size_t)b * 1024 * CL : p.ZT + (size_t)b * 1024 * SEQ) + t0 + rb;
#pragma unroll
      for (int bj = 0; bj < 2; ++bj)
#pragma unroll
        for (int n = 0; n < 2; ++n)
#pragma unroll
          for (int j = 0; j < 4; ++j) {
            float* zd = zb + (size_t)(colb + bj * 32 + n * 16 + fq * 4 + j) * Ls;
#pragma unroll
            for (int ai = 0; ai < 2; ++ai)
#pragma unroll
              for (int m = 0; m < 4; ++m) zd[ai * 128 + m * 16] = acc[ai][bj][m][n][j];
          }
    }
  }
};
DI void inproj_phase(const Params& p, int l, char* lds) {
  PgDesc d;
  d.a_h = (size_t)128 * HS * 2; d.b_h = (size_t)32 * HS * 2; d.nk = D / 64;
  {
    int R, C;
    stage_rc(tidx() * 16, R, C);
    d.voffA = (unsigned)(R * HS + C) * 2u; d.dA = (size_t)64 * HS * 2;
    d.voffB = (unsigned)(((R >> 5) * 64 + (R & 31)) * HS + C) * 2u; d.dB = (size_t)128 * HS * 2;
  }
  InprojSrc src{p.HO, p.Win + (size_t)l * DP * HS};
  InprojEpi epi{&p, l};
  pgemm(lds, d, src, epi);
}

DI float dpp_ror1(float v) { return __builtin_bit_cast(float, __builtin_amdgcn_update_dpp(0, __builtin_bit_cast(int, v), 0x121, 0xf, 0xf, false)); }
DI float dpp_rol1(float v) { return __builtin_bit_cast(float, __builtin_amdgcn_update_dpp(0, __builtin_bit_cast(int, v), 0x12f, 0xf, 0xf, false)); }
DI float row_prev(float prevreg, float cur) {
  return __builtin_bit_cast(float, __builtin_amdgcn_update_dpp(__builtin_bit_cast(int, dpp_ror1(prevreg)), __builtin_bit_cast(int, cur), 0x111, 0xf, 0xf, false));
}
DI float row_next(float nextreg, float cur) {
  return __builtin_bit_cast(float, __builtin_amdgcn_update_dpp(__builtin_bit_cast(int, dpp_rol1(nextreg)), __builtin_bit_cast(int, cur), 0x101, 0xf, 0xf, false));
}
constexpr int FUP_MT = 8 * 33 + 8 * 2, FUP_NT = DFFP / 128;
DI void ffn_tile(int mt, int& Ls, int& rowbase, int& ti) {
  if (mt < 264) { const int b = mt / 33; ti = mt - b * 33; Ls = SEQ; rowbase = b * SEQ; }
  else { const int q = mt - 264; const int b = q >> 1; ti = q & 1; Ls = CL; rowbase = T + b * CL; }
}
struct FfnUpSrc {
  const bf16_t* A; const bf16_t* Wt; int MT;
  DI bool next(int i, PgUnit& u) const {
    if (!tile_map(i, MT, FUP_NT, u.mt, u.nt)) return false;
    int Ls, rowbase, ti;
    ffn_tile(u.mt, Ls, rowbase, ti);
    u.A = (const char*)(A + ((long)rowbase + 252 * ti - 1) * HS);
    u.B = (const char*)(Wt + (size_t)u.nt * 128 * HS);
    return true;
  }
};
struct FfnUpEpi {
  const float *bup, *cw, *cb; bf16_t* act;
  DI void operator()(f32x4 (&acc)[2][2][4][2], const PgUnit& u, int wr, int wc, int fr, int fq) const {
    asm volatile("" : "+v"(fr), "+v"(fq));
    int Ls, rowbase, ti;
    ffn_tile(u.mt, Ls, rowbase, ti);
    const int tw = 252 * ti - 1 + 126 * wr;
    bf16_t* ob = act + (size_t)rowbase * DFFP;
#pragma unroll
    for (int n = 0; n < 2; ++n)
#pragma unroll
      for (int jp = 0; jp < 2; ++jp) {
        int col = u.nt * 128 + wc * 32 + n * 16 + fq * 4 + jp * 2;
        asm volatile("" : "+v"(col) :: "memory");
        float oo[8][2];
#pragma unroll
        for (int jj = 0; jj < 2; ++jj) {
          const int j = jp * 2 + jj, c = col + jj;
          {
            const float bu = bup[c], w0 = cw[c], w1 = cw[2 * DFFP + c], w2 = cw[4 * DFFP + c], bb = cb[c];
            float ua[8];
#pragma unroll
            for (int q = 0; q < 8; ++q) {
              const int t = tw + fr * 8 + q;
              ua[q] = (t >= 0 && t < Ls) ? acc[q >> 2][0][q & 3][n][j] + bu : 0.f;
            }
            const float upl = __builtin_bit_cast(float, __builtin_amdgcn_update_dpp(0, __builtin_bit_cast(int, ua[7]), 0x111, 0xf, 0xf, false));
            const float dnl = __builtin_bit_cast(float, __builtin_amdgcn_update_dpp(0, __builtin_bit_cast(int, ua[0]), 0x101, 0xf, 0xf, false));
#pragma unroll
            for (int q = 0; q < 8; ++q) {
              const float up = q > 0 ? ua[q > 0 ? q - 1 : 0] : upl;
              const float dn = q < 7 ? ua[q < 7 ? q + 1 : 7] : dnl;
              oo[q][jj] = siluf(w0 * up + w1 * ua[q] + w2 * dn + bb);
            }
          }
          {
            const float bu = bup[DFFP + c], w0 = cw[DFFP + c], w1 = cw[3 * DFFP + c], w2 = cw[5 * DFFP + c], bb = cb[DFFP + c];
            float ug[8];
#pragma unroll
            for (int q = 0; q < 8; ++q) {
              const int t = tw + fr * 8 + q;
              ug[q] = (t >= 0 && t < Ls) ? acc[q >> 2][1][q & 3][n][j] + bu : 0.f;
            }
            const float upl = __builtin_bit_cast(float, __builtin_amdgcn_update_dpp(0, __builtin_bit_cast(int, ug[7]), 0x111, 0xf, 0xf, false));
            const float dnl = __builtin_bit_cast(float, __builtin_amdgcn_update_dpp(0, __builtin_bit_cast(int, ug[0]), 0x101, 0xf, 0xf, false));
#pragma unroll
            for (int q = 0; q < 8; ++q) {
              const float up = q > 0 ? ug[q > 0 ? q - 1 : 0] : upl;
              const float dn = q < 7 ? ug[q < 7 ? q + 1 : 7] : dnl;
              oo[q][jj] *= (w0 * up + w1 * ug[q] + w2 * dn + bb);
            }
          }
        }
#pragma unroll
        for (int q = 0; q < 8; ++q) {
          const int lr = fr * 8 + q;
          const int t = tw + lr;
          if (lr >= 1 && lr <= 126 && t < Ls) *(unsigned*)(ob + (size_t)t * DFFP + col) = pack2(oo[q][0], oo[q][1]);
        }
        __builtin_amdgcn_sched_barrier(0);
      }
  }
};
DI void ffn_up_phase(const Params& p, int l, char* lds) {
  PgDesc d;
  d.a_h = (size_t)4 * HS * 2; d.b_h = (size_t)DFFP * HS * 2; d.nk = D / 64;
  {
    int R, C;
    stage_rc(tidx() * 16, R, C);
    d.voffA = (unsigned)(((R & 15) * 8 + (R >> 4)) * HS + C) * 2u; d.dA = (size_t)126 * HS * 2;
    d.voffB = (unsigned)(R * HS + C) * 2u; d.dB = (size_t)64 * HS * 2;
  }
  FfnUpSrc src{p.HO, p.Wup + (size_t)l * 2 * DFFP * HS, l == DEPTH - 1 ? 264 : FUP_MT};
  FfnUpEpi epi{p.bupP + (size_t)l * 2 * DFFP, p.cwP + (size_t)l * 6 * DFFP, p.cbP + (size_t)l * 2 * DFFP, p.ACT};
  pgemm(lds, d, src, epi);
}

DI int crow(int i, int h) { return (i & 3) + 8 * (i >> 2) + 4 * h; }
template <bool FIXED>
DI void attn_item(const Params& p, int l, char* lds, int grp, int b, int kvh, int qrow0, int qpos0, int jfirst, int nloc,
                  bool window) {
  const int tid = tidx(), lane = tid & 63, wave = tid >> 6, g = wave >> 2, qw = wave & 3;
  const int q31 = lane & 31, h = lane >> 5;
  const int head = kvh * 2 + g;
  const int qcol = (grp ? 512 : 0) + head * 64, kcol = (grp ? 768 : 256) + kvh * 64;
  const bf16_t* Zq = p.Zq;
  bf16x8 qf[4];
  {
    const bf16_t* qp = Zq + (size_t)(qrow0 + qw * 32 + q31) * HS + qcol + h * 8;
#pragma unroll
    for (int kk = 0; kk < 4; ++kk) qf[kk] = *(const bf16x8*)(qp + kk * 16);
  }
  const bf16_t* vt = p.VT + (size_t)((grp * 8 + b) * 2 + kvh) * 64 * LV;
  float m_run, l_run;
  if (grp == 0) { m_run = p.sink_a[l * 4 + head] * LOG2E; l_run = 1.f; }
  else { m_run = -1e30f; l_run = 0.f; }
  if (FIXED) {
    float gq = fabsf(p.q_norm_g[l * 64 + lane]), gk = fabsf(p.k_norm_g[l * 64 + lane]);
#pragma unroll
    for (int m = 32; m >= 1; m >>= 1) { gq = fmaxf(gq, __shfl_xor(gq, m, 64)); gk = fmaxf(gk, __shfl_xor(gk, m, 64)); }
    m_run = 8.f * LOG2E * gq * gk * 1.001f + 0.01f;
  }
  f32x16 O0, O1;
#pragma unroll
  for (int i = 0; i < 16; ++i) { O0[i] = 0.f; O1[i] = 0.f; }
  const int ntiles = nloc + 4;
  const int srow = tid >> 3, sch = tid & 7;
  char* Kl = lds;
  char* Vl = lds + 4 * 9216;
  uint4 rkA, rvA, rkB, rvB;
#define TILEJ(ti) ((ti) < nloc ? jfirst + (ti) * 64 : SEQ + ((ti) - nloc) * 64)
#define AGLOAD(rk, rv, ti)                                                                                 \
  {                                                                                                        \
    const int j_ = TILEJ(ti);                                                                              \
    const int key_ = j_ + srow;                                                                            \
    const size_t krow_ = key_ < SEQ ? (size_t)b * SEQ + key_ : (size_t)T + (size_t)b * CL + (key_ - SEQ);  \
    rk = *(const uint4*)(Zq + krow_ * HS + kcol + sch * 8);                                                \
    rv = *(const uint4*)(vt + (size_t)srow * LV + j_ + sch * 8);                                           \
  }
#define ASWRITE(rk, rv, slot)                                                                              \
  {                                                                                                        \
    *(uint4*)(Kl + (slot) * 9216 + srow * 144 + sch * 16) = rk;                                            \
    uint2* vp_ = (uint2*)(Vl + (slot) * 8704 + srow * 136 + sch * 16);                                     \
    vp_[0] = make_uint2(rv.x, rv.y);                                                                       \
    vp_[1] = make_uint2(rv.z, rv.w);                                                                       \
  }
  AGLOAD(rkA, rvA, 0);
  AGLOAD(rkB, rvB, 1);
  ASWRITE(rkA, rvA, 0);
  ASWRITE(rkB, rvB, 1);
  __syncthreads();
  const int qpos = qpos0 + qw * 32 + q31;
  int s0 = 0;
#pragma unroll 1
  for (int ti = 0; ti < ntiles; ti += 2) {
    const int s1 = s0 + 1, s2 = 2 - s0;
    if (ti + 2 < ntiles) { AGLOAD(rkA, rvA, ti + 2); AGLOAD(rkB, rvB, ti + 3); }
    {
      const int tcur = ti;
      const char* kb = Kl + s0 * 9216;
      const char* vb = Vl + s0 * 8704;
    f32x16 S0, S1;
    const float sinit = FIXED ? -m_run : 0.f;
#pragma unroll
    for (int i = 0; i < 16; ++i) { S0[i] = sinit; S1[i] = sinit; }
    bf16x8 kf[8];
    union { uint2 u[2]; bf16x8 v; } vfr[8];
#pragma unroll
    for (int kk = 0; kk < 4; ++kk) {
      kf[2 * kk] = *(const bf16x8*)(kb + q31 * 144 + kk * 32 + h * 16);
      kf[2 * kk + 1] = *(const bf16x8*)(kb + (32 + q31) * 144 + kk * 32 + h * 16);
    }
#pragma unroll
    for (int c = 0; c < 4; ++c)
#pragma unroll
      for (int ds = 0; ds < 2; ++ds) {
        const char* vp = vb + (ds * 32 + q31) * 136 + (16 * c + h * 4) * 2;
        vfr[c * 2 + ds].u[0] = *(const uint2*)vp;
        vfr[c * 2 + ds].u[1] = *(const uint2*)(vp + 16);
      }
    __builtin_amdgcn_sched_barrier(0);
#pragma unroll
    for (int kk = 0; kk < 4; ++kk) {
      S0 = __builtin_amdgcn_mfma_f32_32x32x16_bf16(kf[2 * kk], qf[kk], S0, 0, 0, 0);
      S1 = __builtin_amdgcn_mfma_f32_32x32x16_bf16(kf[2 * kk + 1], qf[kk], S1, 0, 0, 0);
    }
    const int j = TILEJ(tcur);
    if (window && j < SEQ) {
#pragma unroll
      for (int i = 0; i < 16; ++i) {
        const int kp = j + crow(i, h);
        int d0 = kp - qpos; d0 = d0 < 0 ? -d0 : d0;
        int d1 = kp + 32 - qpos; d1 = d1 < 0 ? -d1 : d1;
        S0[i] = d0 <= 128 ? S0[i] : -1e30f;
        S1[i] = d1 <= 128 ? S1[i] : -1e30f;
      }
    }
    if (FIXED) {
      float rs = 0.f;
#pragma unroll
      for (int i = 0; i < 16; ++i) {
        S0[i] = __builtin_amdgcn_exp2f(S0[i]);
        S1[i] = __builtin_amdgcn_exp2f(S1[i]);
        rs += S0[i] + S1[i];
      }
      l_run += rs;
    } else {
      float mx = S0[0];
#pragma unroll
      for (int i = 1; i < 16; ++i) mx = fmaxf(mx, S0[i]);
#pragma unroll
      for (int i = 0; i < 16; ++i) mx = fmaxf(mx, S1[i]);
      mx = fmaxf(mx, __shfl_xor(mx, 32, 64));
      const float mnew = fmaxf(m_run, mx);
      const float alpha = __builtin_amdgcn_exp2f(m_run - mnew);
      float rs = 0.f;
#pragma unroll
      for (int i = 0; i < 16; ++i) {
        S0[i] = __builtin_amdgcn_exp2f(S0[i] - mnew);
        S1[i] = __builtin_amdgcn_exp2f(S1[i] - mnew);
        rs += S0[i] + S1[i];
      }
      rs += __shfl_xor(rs, 32, 64);
      l_run = l_run * alpha + rs;
      m_run = mnew;
#pragma unroll
      for (int i = 0; i < 16; ++i) { O0[i] *= alpha; O1[i] *= alpha; }
    }
#pragma unroll
    for (int c = 0; c < 4; ++c) {
      union { unsigned u[4]; bf16x8 v; } pf;
      if (c < 2) {
#pragma unroll
        for (int e = 0; e < 4; ++e) pf.u[e] = pack2(S0[(c & 1) * 8 + 2 * e], S0[(c & 1) * 8 + 2 * e + 1]);
      } else {
#pragma unroll
        for (int e = 0; e < 4; ++e) pf.u[e] = pack2(S1[(c & 1) * 8 + 2 * e], S1[(c & 1) * 8 + 2 * e + 1]);
      }
      O0 = __builtin_amdgcn_mfma_f32_32x32x16_bf16(vfr[c * 2].v, pf.v, O0, 0, 0, 0);
      O1 = __builtin_amdgcn_mfma_f32_32x32x16_bf16(vfr[c * 2 + 1].v, pf.v, O1, 0, 0, 0);
    }

    }
    {
      const int tcur = ti + 1;
      const char* kb = Kl + s1 * 9216;
      const char* vb = Vl + s1 * 8704;
    f32x16 S0, S1;
    const float sinit = FIXED ? -m_run : 0.f;
#pragma unroll
    for (int i = 0; i < 16; ++i) { S0[i] = sinit; S1[i] = sinit; }
    bf16x8 kf[8];
    union { uint2 u[2]; bf16x8 v; } vfr[8];
#pragma unroll
    for (int kk = 0; kk < 4; ++kk) {
      kf[2 * kk] = *(const bf16x8*)(kb + q31 * 144 + kk * 32 + h * 16);
      kf[2 * kk + 1] = *(const bf16x8*)(kb + (32 + q31) * 144 + kk * 32 + h * 16);
    }
#pragma unroll
    for (int c = 0; c < 4; ++c)
#pragma unroll
      for (int ds = 0; ds < 2; ++ds) {
        const char* vp = vb + (ds * 32 + q31) * 136 + (16 * c + h * 4) * 2;
        vfr[c * 2 + ds].u[0] = *(const uint2*)vp;
        vfr[c * 2 + ds].u[1] = *(const uint2*)(vp + 16);
      }
    __builtin_amdgcn_sched_barrier(0);
#pragma unroll
    for (int kk = 0; kk < 4; ++kk) {
      S0 = __builtin_amdgcn_mfma_f32_32x32x16_bf16(kf[2 * kk], qf[kk], S0, 0, 0, 0);
      S1 = __builtin_amdgcn_mfma_f32_32x32x16_bf16(kf[2 * kk + 1], qf[kk], S1, 0, 0, 0);
    }
    const int j = TILEJ(tcur);
    if (window && j < SEQ) {
#pragma unroll
      for (int i = 0; i < 16; ++i) {
        const int kp = j + crow(i, h);
        int d0 = kp - qpos; d0 = d0 < 0 ? -d0 : d0;
        int d1 = kp + 32 - qpos; d1 = d1 < 0 ? -d1 : d1;
        S0[i] = d0 <= 128 ? S0[i] : -1e30f;
        S1[i] = d1 <= 128 ? S1[i] : -1e30f;
      }
    }
    if (FIXED) {
      float rs = 0.f;
#pragma unroll
      for (int i = 0; i < 16; ++i) {
        S0[i] = __builtin_amdgcn_exp2f(S0[i]);
        S1[i] = __builtin_amdgcn_exp2f(S1[i]);
        rs += S0[i] + S1[i];
      }
      l_run += rs;
    } else {
      float mx = S0[0];
#pragma unroll
      for (int i = 1; i < 16; ++i) mx = fmaxf(mx, S0[i]);
#pragma unroll
      for (int i = 0; i < 16; ++i) mx = fmaxf(mx, S1[i]);
      mx = fmaxf(mx, __shfl_xor(mx, 32, 64));
      const float mnew = fmaxf(m_run, mx);
      const float alpha = __builtin_amdgcn_exp2f(m_run - mnew);
      float rs = 0.f;
#pragma unroll
      for (int i = 0; i < 16; ++i) {
        S0[i] = __builtin_amdgcn_exp2f(S0[i] - mnew);
        S1[i] = __builtin_amdgcn_exp2f(S1[i] - mnew);
        rs += S0[i] + S1[i];
      }
      rs += __shfl_xor(rs, 32, 64);
      l_run = l_run * alpha + rs;
      m_run = mnew;
#pragma unroll
      for (int i = 0; i < 16; ++i) { O0[i] *= alpha; O1[i] *= alpha; }
    }
#pragma unroll
    for (int c = 0; c < 4; ++c) {
      union { unsigned u[4]; bf16x8 v; } pf;
      if (c < 2) {
#pragma unroll
        for (int e = 0; e < 4; ++e) pf.u[e] = pack2(S0[(c & 1) * 8 + 2 * e], S0[(c & 1) * 8 + 2 * e + 1]);
      } else {
#pragma unroll
        for (int e = 0; e < 4; ++e) pf.u[e] = pack2(S1[(c & 1) * 8 + 2 * e], S1[(c & 1) * 8 + 2 * e + 1]);
      }
      O0 = __builtin_amdgcn_mfma_f32_32x32x16_bf16(vfr[c * 2].v, pf.v, O0, 0, 0, 0);
      O1 = __builtin_amdgcn_mfma_f32_32x32x16_bf16(vfr[c * 2 + 1].v, pf.v, O1, 0, 0, 0);
    }

      if (ti + 2 < ntiles) { ASWRITE(rkA, rvA, s2); ASWRITE(rkB, rvB, s2 + 1); }
      __syncthreads();
    }
    s0 = s2;
  }
#undef TILEJ
#undef AGLOAD
#undef ASWRITE
  if (FIXED) l_run += __shfl_xor(l_run, 32, 64);
  const float inv = 1.f / l_run;
  bf16_t* op = p.HO + (size_t)(qrow0 + qw * 32 + q31) * HS + grp * 256 + head * 64 + h * 4;
#pragma unroll
  for (int gi = 0; gi < 4; ++gi) {
    uint2 w;
    w.x = pack2(O0[gi * 4 + 0] * inv, O0[gi * 4 + 1] * inv);
    w.y = pack2(O0[gi * 4 + 2] * inv, O0[gi * 4 + 3] * inv);
    *(uint2*)(op + gi * 8) = w;
    w.x = pack2(O1[gi * 4 + 0] * inv, O1[gi * 4 + 1] * inv);
    w.y = pack2(O1[gi * 4 + 2] * inv, O1[gi * 4 + 3] * inv);
    *(uint2*)(op + 32 + gi * 8) = w;
  }
}

#define XP(i) ((i) + ((i) >> 5))
DI float2 c_add(float2 a, float2 b) { return make_float2(a.x + b.x, a.y + b.y); }
DI float2 c_sub(float2 a, float2 b) { return make_float2(a.x - b.x, a.y - b.y); }
DI float2 c_mul(float2 a, float2 w) { return make_float2(a.x * w.x - a.y * w.y, a.x * w.y + a.y * w.x); }
DI float2 c_mni(float2 a) { return make_float2(a.y, -a.x); }
DI float2 c_pi(float2 a) { return make_float2(-a.y, a.x); }
constexpr float RS2 = 0.70710678118654752f;
DI void fft_bottom_r2(float2* X, int lg) {
  const int n2 = 1 << (lg - 1);
  for (int j = tidx(); j < n2; j += NTHR) {
    const float2 a = X[XP(2 * j)], b = X[XP(2 * j + 1)];
    X[XP(2 * j)] = c_add(a, b);
    X[XP(2 * j + 1)] = c_sub(a, b);
  }
  __syncthreads();
}
DI void fft_dif(float2* X, int lg) {
  const int n8 = 1 << (lg - 3);
  int s = lg - 1;
  for (; s >= 2; s -= 3) {
    const int q = 1 << (s - 2);
    const float inv = 1.0f / (float)(8 * q);
    for (int j = tidx(); j < n8; j += NTHR) {
      const int p = j & (q - 1);
      const int i0 = ((j >> (s - 2)) << (s + 1)) + p;
      float2 v[8];
#pragma unroll
      for (int k = 0; k < 8; ++k) v[k] = X[XP(i0 + k * q)];
      const float r = (float)p * inv;
      const float2 W = make_float2(cos_rev(r), -sin_rev(r));
      const float2 W2 = make_float2(W.x * W.x - W.y * W.y, 2.f * W.x * W.y);
      const float2 W4 = make_float2(W2.x * W2.x - W2.y * W2.y, 2.f * W2.x * W2.y);
      float2 y[8];
#pragma unroll
      for (int k = 0; k < 4; ++k) {
        y[k] = c_add(v[k], v[k + 4]);
        const float2 d = c_mul(c_sub(v[k], v[k + 4]), W);
        y[k + 4] = k == 0 ? d : (k == 1 ? make_float2((d.x + d.y) * RS2, (d.y - d.x) * RS2)
                                        : (k == 2 ? c_mni(d) : make_float2((d.y - d.x) * RS2, -(d.x + d.y) * RS2)));
      }
      float2 z[8];
#pragma unroll
      for (int b = 0; b < 8; b += 4) {
        z[b] = c_add(y[b], y[b + 2]);
        z[b + 2] = c_mul(c_sub(y[b], y[b + 2]), W2);
        z[b + 1] = c_add(y[b + 1], y[b + 3]);
        z[b + 3] = c_mni(c_mul(c_sub(y[b + 1], y[b + 3]), W2));
      }
#pragma unroll
      for (int b = 0; b < 8; b += 2) {
        X[XP(i0 + b * q)] = c_add(z[b], z[b + 1]);
        X[XP(i0 + (b + 1) * q)] = c_mul(c_sub(z[b], z[b + 1]), W4);
      }
    }
    __syncthreads();
  }
  if (s == 1) {
    const int n4 = 1 << (lg - 2);
    for (int j = tidx(); j < n4; j += NTHR) {
      const float2 x0 = X[XP(4 * j)], x1 = X[XP(4 * j + 1)], x2 = X[XP(4 * j + 2)], x3 = X[XP(4 * j + 3)];
      const float2 y0 = c_add(x0, x2), y2 = c_sub(x0, x2), y1 = c_add(x1, x3), y3 = c_mni(c_sub(x1, x3));
      X[XP(4 * j)] = c_add(y0, y1); X[XP(4 * j + 1)] = c_sub(y0, y1); X[XP(4 * j + 2)] = c_add(y2, y3); X[XP(4 * j + 3)] = c_sub(y2, y3);
    }
    __syncthreads();
  } else if (s == 0) {
    fft_bottom_r2(X, lg);
  }
}
DI void fft_dit_inv(float2* X, int lg) {
  const int n8 = 1 << (lg - 3);
  const int rem = lg % 3;
  int s = 0;
  if (rem == 1) { fft_bottom_r2(X, lg); s = 1; }
  else if (rem == 2) {
    const int n4 = 1 << (lg - 2);
    for (int j = tidx(); j < n4; j += NTHR) {
      const float2 x0 = X[XP(4 * j)], x1 = X[XP(4 * j + 1)], x2 = X[XP(4 * j + 2)], x3 = X[XP(4 * j + 3)];
      const float2 y0 = c_add(x0, x1), y1 = c_sub(x0, x1), y2 = c_add(x2, x3), y3 = c_pi(c_sub(x2, x3));
      X[XP(4 * j)] = c_add(y0, y2); X[XP(4 * j + 2)] = c_sub(y0, y2); X[XP(4 * j + 1)] = c_add(y1, y3); X[XP(4 * j + 3)] = c_sub(y1, y3);
    }
    __syncthreads();
    s = 2;
  }
  for (; s + 2 < lg; s += 3) {
    const int q = 1 << s;
    const float inv = 1.0f / (float)(8 * q);
    for (int j = tidx(); j < n8; j += NTHR) {
      const int p = j & (q - 1);
      const int i0 = ((j >> s) << (s + 3)) + p;
      float2 o[8];
#pragma unroll
      for (int k = 0; k < 8; ++k) o[k] = X[XP(i0 + k * q)];
      const float r = (float)p * inv;
      const float2 W = make_float2(cos_rev(r), sin_rev(r));
      const float2 W2 = make_float2(W.x * W.x - W.y * W.y, 2.f * W.x * W.y);
      const float2 W4 = make_float2(W2.x * W2.x - W2.y * W2.y, 2.f * W2.x * W2.y);
      float2 z[8];
#pragma unroll
      for (int b = 0; b < 8; b += 2) {
        const float2 t = c_mul(o[b + 1], W4);
        z[b] = c_add(o[b], t); z[b + 1] = c_sub(o[b], t);
      }
      float2 y[8];
#pragma unroll
      for (int b = 0; b < 8; b += 4) {
        const float2 t = c_mul(z[b + 2], W2);
        y[b] = c_add(z[b], t); y[b + 2] = c_sub(z[b], t);
        const float2 u = c_pi(c_mul(z[b + 3], W2));
        y[b + 1] = c_add(z[b + 1], u); y[b + 3] = c_sub(z[b + 1], u);
      }
#pragma unroll
      for (int k = 0; k < 4; ++k) {
        const float2 d = c_mul(y[k + 4], W);
        const float2 t = k == 0 ? d : (k == 1 ? make_float2((d.x - d.y) * RS2, (d.x + d.y) * RS2)
                                              : (k == 2 ? c_pi(d) : make_float2(-(d.x + d.y) * RS2, (d.x - d.y) * RS2)));
        X[XP(i0 + k * q)] = c_add(y[k], t);
        X[XP(i0 + (k + 4) * q)] = c_sub(y[k], t);
      }
    }
    __syncthreads();
  }
}

DI float conv3(const float* z, int t, int Ls, float w0, float w1, float w2, float bias) {
  const float zm = t > 0 ? z[t - 1] : 0.f, zc = z[t], zp = t < Ls - 1 ? z[t + 1] : 0.f;
  return w0 * zm + w1 * zc + w2 * zp + bias;
}

DI void hyena_item(const Params& p, int l, float2* X, int bp, int c, bool lat) {
  const int Ls = lat ? SEQ : CL, lg = lat ? 14 : 9, N = 2 * Ls;
  const float* zb0 = lat ? p.ZT + (size_t)(2 * bp) * 1024 * SEQ : p.ZTc + (size_t)(2 * bp) * 1024 * CL;
  const float* zb1 = zb0 + (size_t)1024 * Ls;
  const float* cw = p.hy_conv_w + (size_t)l * 3 * 768;
  const float* cb = p.hy_conv_b + (size_t)l * 768;
  const float w00 = cw[c], w01 = cw[768 + c], w02 = cw[1536 + c], b0 = cb[c];
  const float w10 = cw[256 + c], w11 = cw[768 + 256 + c], w12 = cw[1536 + 256 + c], b1 = cb[256 + c];
  const float w20 = cw[512 + c], w21 = cw[768 + 512 + c], w22 = cw[1536 + 512 + c], b2 = cb[512 + c];
  const float* x0a = zb0 + (size_t)c * Ls; const float* x1a = zb0 + (size_t)(256 + c) * Ls; const float* va = zb0 + (size_t)(512 + c) * Ls;
  const float* x0b = zb1 + (size_t)c * Ls; const float* x1b = zb1 + (size_t)(256 + c) * Ls; const float* vb = zb1 + (size_t)(512 + c) * Ls;
#pragma unroll 4
  for (int t = tidx(); t < Ls; t += NTHR) {
    const float ua = conv3(x1a, t, Ls, w10, w11, w12, b1) * conv3(va, t, Ls, w20, w21, w22, b2);
    const float ub = conv3(x1b, t, Ls, w10, w11, w12, b1) * conv3(vb, t, Ls, w20, w21, w22, b2);
    X[XP(t)] = make_float2(ua, ub);
    X[XP(Ls + t)] = make_float2(0.f, 0.f);
  }
  __syncthreads();
  fft_dif(X, lg);
  const float2* Kh = lat ? p.Khat + (size_t)(l * 256 + c) * (2 * SEQ) : p.Khatc + (size_t)(l * 256 + c) * (2 * CL);
#pragma unroll 8
  for (int i = tidx(); i < N; i += NTHR) {
    const float2 a = X[XP(i)], k = Kh[i];
    X[XP(i)] = make_float2(a.x * k.x - a.y * k.y, a.x * k.y + a.y * k.x);
  }
  __syncthreads();
  fft_dit_inv(X, lg);
  const float invN = 1.f / (float)N, skip = p.hy_skip[l * 256 + c];
  const size_t rba = lat ? (size_t)(2 * bp) * SEQ : (size_t)T + (size_t)(2 * bp) * CL;
  const size_t rbb = rba + Ls;
#pragma unroll 4
  for (int t = tidx(); t < Ls; t += NTHR) {
    const float2 y = X[XP(t)];
    const float ua = conv3(x1a, t, Ls, w10, w11, w12, b1) * conv3(va, t, Ls, w20, w21, w22, b2);
    const float ub = conv3(x1b, t, Ls, w10, w11, w12, b1) * conv3(vb, t, Ls, w20, w21, w22, b2);
    const float oa = (y.x * invN + skip * ua) * conv3(x0a, t, Ls, w00, w01, w02, b0);
    const float ob = (y.y * invN + skip * ub) * conv3(x0b, t, Ls, w00, w01, w02, b0);
    p.HO[(rba + t) * HS + 512 + c] = f2bf(oa);
    p.HO[(rbb + t) * HS + 512 + c] = f2bf(ob);
  }
  __syncthreads();
}

DI void fnet_item(const Params& p, float2* X, int b, int g, int m, bool lat) {
  const int Ls = lat ? SEQ : CL, lg = lat ? 13 : 8;
  const float* zb = lat ? p.ZT + (size_t)b * 1024 * SEQ : p.ZTc + (size_t)b * 1024 * CL;
  const float* re = zb + (size_t)(768 + g * 64 + m) * Ls;
  const bool hasim = (m >= 1 && m <= 31);
  const float* im = zb + (size_t)(768 + g * 64 + 32 + (hasim ? m : 0)) * Ls;
#pragma unroll 8
  for (int t = tidx(); t < Ls; t += NTHR) X[XP(t)] = make_float2(re[t], hasim ? im[t] : 0.f);
  __syncthreads();
  fft_dif(X, lg);
  const float s = rsqrtf((float)Ls * 64.f);
  const size_t rb = lat ? (size_t)b * SEQ : (size_t)T + (size_t)b * CL;
#pragma unroll 4
  for (int i = tidx(); i < Ls; i += NTHR) {
    const int k = (int)(__brev((unsigned)i) >> (32 - lg));
    const bf16_t v = f2bf(X[XP(i)].x * s);
    p.F[(rb + k) * 256 + g * 64 + m] = v;
    if (hasim) p.F[(rb + ((Ls - k) & (Ls - 1))) * 256 + g * 64 + 64 - m] = v;
  }
  __syncthreads();
}

DI void mixers_phase(const Params& p, int l, char* lds) {
  float2* X = (float2*)lds;
  const int xcd = blockIdx.x & 7;
#pragma unroll 1
  for (int it = 0;; ++it) {
    const int loc = xcd_local(it, l == DEPTH - 1 ? 256 : 264);
    if (loc < 0) break;
    int grp, pair, qrow0, qpos0, jfirst, nloc;
    bool window = false;
    if (loc < 256) {
      grp = loc < 128 ? 1 : 0;
      const int q = loc & 127, qb = q & 63;
      pair = 2 * xcd + (q >> 6);
      qpos0 = qb * 128;
      qrow0 = (pair >> 1) * SEQ + qpos0;
      if (grp) { jfirst = 0; nloc = 128; }
      else {
        const int fb = qb > 0 ? qb - 1 : 0, lb = qb < 63 ? qb + 1 : 63;
        jfirst = fb * 128; nloc = (lb - fb + 1) * 2; window = true;
      }
    } else {
      const int q = loc - 256;
      grp = q >> 2;
      pair = 2 * xcd + ((q >> 1) & 1);
      qpos0 = (q & 1) * 128;
      qrow0 = T + (pair >> 1) * CL + qpos0;
      jfirst = 0; nloc = 0;
    }
    if (grp) attn_item<true>(p, l, lds, grp, pair >> 1, pair & 1, qrow0, qpos0, jfirst, nloc, false);
    else attn_item<false>(p, l, lds, grp, pair >> 1, pair & 1, qrow0, qpos0, jfirst, nloc, window);
  }
#pragma unroll 1
  for (int it = 0;; ++it) {
    int loc = xcd_local(it, l == DEPTH - 1 ? 128 : 256);
    if (loc < 0) break;
    loc &= 255;
    hyena_item(p, l, X, (loc >> 5) & 3, xcd * 32 + (loc & 31), loc < 128);
  }
#pragma unroll 1
  for (int it = 0;; ++it) {
    int loc = xcd_local(it, l == DEPTH - 1 ? 132 : 264);
    if (loc < 0) break;
    if (loc >= 264) loc -= 264;
    const int q = loc < 132 ? loc : loc - 132;
    fnet_item(p, X, xcd, q / 33, q % 33, loc < 132);
  }
}

DI void row_pass(const Params& p, int l, int mode) {
  const int lane = tidx() & 63, wave = tidx() >> 6;
  const int nrows = (l == DEPTH - 1 && mode) ? T : MROWS;
  const bool first = (l == 0 && mode <= 1);
  const float* xl = first ? p.x : p.out;
  const float* xc = first ? p.ctx : p.cx;
  int ml = l, sho = 0, sco = 1024;
  if (mode == 1) { sho = 3072; sco = 4096; }
  if (mode == 2) ml = l + 1;
  const bool has_h = ml < DEPTH;
  const int stride = gridDim.x * 8;
  float4 LG[4], LB[4], GT[4], SH[4], SC[4];
#pragma unroll
  for (int j = 0; j < 4; ++j) {
    const int col = lane * 4 + 256 * j;
    LG[j] = mode ? *(const float4*)((mode == 1 ? p.ln1_g : p.ln2_g) + (size_t)l * D + col) : make_float4(0.f, 0.f, 0.f, 0.f);
    LB[j] = mode ? *(const float4*)((mode == 1 ? p.ln1_b : p.ln2_b) + (size_t)l * D + col) : make_float4(0.f, 0.f, 0.f, 0.f);
    GT[j] = SH[j] = SC[j] = make_float4(0.f, 0.f, 0.f, 0.f);
  }
  int mr_cur = -1;
  int r = blockIdx.x * 8 + wave;
  float4 xv[4];
  uint2 yv[4];
#define ROWLOAD(XV, YV, rr)                                                                       \
  {                                                                                               \
    const float* xs_ = (rr) < T ? xl + (size_t)(rr) * D : xc + (size_t)((rr) - T) * D;            \
    _Pragma("unroll") for (int j = 0; j < 4; ++j) XV[j] = *(const float4*)(xs_ + lane * 4 + 256 * j); \
    if (mode) { const bf16_t* yr_ = p.Y + (size_t)(rr) * D;                                       \
      _Pragma("unroll") for (int j = 0; j < 4; ++j) YV[j] = *(const uint2*)(yr_ + lane * 4 + 256 * j); } \
  }
  if (r < nrows) ROWLOAD(xv, yv, r);
#pragma unroll 1
  for (; r < nrows; r += stride) {
    float4 xn[4];
    uint2 yn[4];
    const int rn = r + stride;
    if (rn < nrows) ROWLOAD(xn, yn, rn);
    const bool lat = r < T;
    const int mr = lat ? (r >> 13) : 8;
    if (mr != mr_cur) {
      mr_cur = mr;
      const float* md = p.mod + ((size_t)l * 9 + mr) * 6144;
      const float* md2 = p.mod + ((size_t)(has_h ? ml : l) * 9 + mr) * 6144;
#pragma unroll
      for (int j = 0; j < 4; ++j) {
        const int col = lane * 4 + 256 * j;
        if (mode) GT[j] = *(const float4*)(md + (mode == 1 ? 2048 : 5120) + col);
        SH[j] = *(const float4*)(md2 + sho + col);
        SC[j] = *(const float4*)(md2 + sco + col);
      }
    }
    float v[16];
#pragma unroll
    for (int j = 0; j < 4; ++j) { v[4 * j] = xv[j].x; v[4 * j + 1] = xv[j].y; v[4 * j + 2] = xv[j].z; v[4 * j + 3] = xv[j].w; }
    if (mode) {
      float s = 0.f;
#pragma unroll
      for (int j = 0; j < 4; ++j) {
        v[4 * j] = ALPHA * v[4 * j] + GT[j].x * bf2f(yv[j].x & 0xffffu);
        v[4 * j + 1] = ALPHA * v[4 * j + 1] + GT[j].y * bf2f(yv[j].x >> 16);
        v[4 * j + 2] = ALPHA * v[4 * j + 2] + GT[j].z * bf2f(yv[j].y & 0xffffu);
        v[4 * j + 3] = ALPHA * v[4 * j + 3] + GT[j].w * bf2f(yv[j].y >> 16);
        s += v[4 * j] + v[4 * j + 1] + v[4 * j + 2] + v[4 * j + 3];
      }
      const float mu = wave_sum(s) * (1.f / D);
      float q = 0.f;
#pragma unroll
      for (int i = 0; i < 16; ++i) { const float d = v[i] - mu; q += d * d; }
      const float rstd = rsqrtf(wave_sum(q) * (1.f / D) + 1e-6f);
      float* xd = lat ? p.out + (size_t)r * D : p.cx + (size_t)(r - T) * D;
#pragma unroll
      for (int j = 0; j < 4; ++j) {
        const int col = lane * 4 + 256 * j;
        v[4 * j] = (v[4 * j] - mu) * rstd * LG[j].x + LB[j].x;
        v[4 * j + 1] = (v[4 * j + 1] - mu) * rstd * LG[j].y + LB[j].y;
        v[4 * j + 2] = (v[4 * j + 2] - mu) * rstd * LG[j].z + LB[j].z;
        v[4 * j + 3] = (v[4 * j + 3] - mu) * rstd * LG[j].w + LB[j].w;
        *(float4*)(xd + col) = make_float4(v[4 * j], v[4 * j + 1], v[4 * j + 2], v[4 * j + 3]);
      }
    }
    if (has_h) {
      float s = 0.f;
#pragma unroll
      for (int i = 0; i < 16; ++i) s += v[i];
      const float mu = wave_sum(s) * (1.f / D);
      float q = 0.f;
#pragma unroll
      for (int i = 0; i < 16; ++i) { const float d = v[i] - mu; q += d * d; }
      const float rstd = rsqrtf(wave_sum(q) * (1.f / D) + 1e-6f);
      bf16_t* hr = p.HO + (size_t)r * HS;
#pragma unroll
      for (int j = 0; j < 4; ++j) {
        const int col = lane * 4 + 256 * j;
        uint2 w;
        w.x = pack2((v[4 * j] - mu) * rstd * (1.f + SC[j].x) + SH[j].x, (v[4 * j + 1] - mu) * rstd * (1.f + SC[j].y) + SH[j].y);
        w.y = pack2((v[4 * j + 2] - mu) * rstd * (1.f + SC[j].z) + SH[j].z, (v[4 * j + 3] - mu) * rstd * (1.f + SC[j].w) + SH[j].w);
        *(uint2*)(hr + col) = w;
      }
    }
#pragma unroll
    for (int j = 0; j < 4; ++j) { xv[j] = xn[j]; yv[j] = yn[j]; }
  }
#undef ROWLOAD
}

DI void merge_norm_phase(const Params& p, int nrows) {
  const int lane = tidx() & 63, wave = tidx() >> 6;
#pragma unroll 1
  for (int r0 = (blockIdx.x * 8 + wave) * 4; r0 < nrows; r0 += gridDim.x * 32) {
    uint4 a[4], b[4];
#pragma unroll
    for (int k = 0; k < 4; ++k) {
      const int r = r0 + k < nrows ? r0 + k : nrows - 1;
      const bf16_t* hr = p.HO + (size_t)r * HS + lane * 16;
      a[k] = *(const uint4*)hr; b[k] = *(const uint4*)(hr + 8);
    }
#pragma unroll
    for (int k = 0; k < 4; ++k) {
      if (r0 + k >= nrows) break;
      bf16_t* hr = p.HO + (size_t)(r0 + k) * HS + lane * 16;
      unsigned u[8] = {a[k].x, a[k].y, a[k].z, a[k].w, b[k].x, b[k].y, b[k].z, b[k].w};
      float f[16];
      float ss = 0.f;
#pragma unroll
      for (int i = 0; i < 8; ++i) { f[2 * i] = bf2f(u[i] & 0xffffu); f[2 * i + 1] = bf2f(u[i] >> 16); ss += f[2 * i] * f[2 * i] + f[2 * i + 1] * f[2 * i + 1]; }
      ss = row16_sum(ss);
      const float rs = rsqrtf(ss * (1.f / 256.f) + 1e-6f);
#pragma unroll
      for (int i = 0; i < 8; ++i) u[i] = pack2(f[2 * i] * rs, f[2 * i + 1] * rs);
      *(uint4*)hr = make_uint4(u[0], u[1], u[2], u[3]);
      *(uint4*)(hr + 8) = make_uint4(u[4], u[5], u[6], u[7]);
    }
  }
}

DI void conv_tile(float* lds, const float* src, int ldsrc, bf16_t* dst, int ldd, int k0, int n0, const float* rowscale) {
  const int tid = tidx();
#pragma unroll
  for (int i = 0; i < 8; ++i) {
    const int idx = tid + NTHR * i, kk = idx >> 6, nn = idx & 63;
    float v = src[(size_t)(k0 + kk) * ldsrc + n0 + nn];
    if (rowscale) v *= rowscale[k0 + kk];
    lds[kk * 65 + nn] = v;
  }
  __syncthreads();
#pragma unroll
  for (int i = 0; i < 4; ++i) {
    const int pidx = tid + NTHR * i, nn = pidx >> 5, kp = pidx & 31;
    *(unsigned*)(dst + (size_t)(n0 + nn) * ldd + k0 + 2 * kp) = pack2(lds[(2 * kp) * 65 + nn], lds[(2 * kp + 1) * 65 + nn]);
  }
  __syncthreads();
}
DI void fold_tile(float* lds, const float* src, bf16_t* dst, int k0, int g) {
  const int tid = tidx();
  float* cs = lds + 64 * 65;
  float* sn = cs + 64;
#pragma unroll
  for (int i = 0; i < 8; ++i) {
    const int idx = tid + NTHR * i, kk = idx >> 6, nn = idx & 63;
    lds[kk * 65 + nn] = src[(size_t)(k0 + kk) * DP + 1792 + g * 64 + nn];
  }
  if (tid < 64) { cs[tid] = cos_rev((float)tid * (1.f / 64.f)); sn[tid] = sin_rev((float)tid * (1.f / 64.f)); }
  __syncthreads();
#pragma unroll 1
  for (int i = 0; i < 4; ++i) {
    const int pidx = tid + NTHR * i, mp = pidx >> 5, kp = pidx & 31;
    float a0 = 0.f, a1 = 0.f;
    const int mm = mp <= 32 ? mp : mp - 32;
#pragma unroll 4
    for (int j = 0; j < 64; ++j) {
      const int ph = (mm * j) & 63;
      const float cm = mp <= 32 ? cs[ph] : -sn[ph];
      a0 += lds[(2 * kp) * 65 + j] * cm;
      a1 += lds[(2 * kp + 1) * 65 + j] * cm;
    }
    *(unsigned*)(dst + (size_t)(1792 + g * 64 + mp) * HS + k0 + 2 * kp) = pack2(a0, a1);
  }
  __syncthreads();
}
DI void convert_phase(const Params& p, float* lds) {
  constexpr int PER = 2848;
  for (int job = blockIdx.x; job < PER * DEPTH; job += gridDim.x) {
    const int l = job / PER;
    int j = job - l * PER;
    if (j >= 448 && j < 512) {
      j -= 448;
      fold_tile(lds, p.w_in + (size_t)l * D * DP, p.Win + (size_t)l * DP * HS, (j & 15) * 64, j >> 4);
      continue;
    }
    const float* src; bf16_t* dst; int ldsrc, ldd, k0, n0; const float* rs = nullptr;
    if (j < 448) {
      src = p.w_in + (size_t)l * D * DP; ldsrc = DP; dst = p.Win + (size_t)l * DP * HS; ldd = HS; k0 = (j / 28) * 64; n0 = (j % 28) * 64;
    } else if (j < 768) {
      j -= 512;
      src = p.w_out + (size_t)l * D * D; ldsrc = D; dst = p.Wout + (size_t)l * D * HS; ldd = HS; k0 = (j >> 4) * 64; n0 = (j & 15) * 64;
      rs = p.out_norm_g + l * D;
    } else if (j < 2144) {
      j -= 768;
      src = p.ffn_w_up + (size_t)l * D * DFF2; ldsrc = DFF2; dst = p.Wup + (size_t)l * 2 * DFFP * HS; ldd = HS; k0 = (j / 86) * 64; n0 = (j % 86) * 64;
      if (n0 >= DFF) { src += DFF; dst += (size_t)DFFP * HS; n0 -= DFF; ldsrc = DFF2; }
    } else if (j < 2832) {
      j -= 2144;
      src = p.ffn_w_down + (size_t)l * DFF * D; ldsrc = D; dst = p.Wdn + (size_t)l * D * DFFP; ldd = DFFP; k0 = (j >> 4) * 64; n0 = (j & 15) * 64;
    } else {
      j -= 2832;
      src = p.fnet_w + (size_t)l * 256 * 256; ldsrc = 256; dst = p.Wfn + (size_t)l * 256 * 256; ldd = 256; k0 = (j >> 2) * 64; n0 = (j & 3) * 64;
    }
    conv_tile(lds, src, ldsrc, dst, ldd, k0, n0, rs);
  }
}
DI void pad_phase(const Params& p) {
  const int gtid = blockIdx.x * NTHR + tidx(), gn = gridDim.x * NTHR;
  for (int idx = gtid; idx < DEPTH * 2 * 64 * D; idx += gn) {
    const int k = idx & (D - 1), r = (idx >> 10) & 63, h = (idx >> 16) & 1, l = idx >> 17;
    p.Wup[((size_t)l * 2 * DFFP + (size_t)h * DFFP + DFF + r) * HS + k] = 0;
  }
  for (int idx = gtid; idx < DEPTH * D * 64; idx += gn) {
    const int k = idx & 63, r = idx >> 6;
    p.Wdn[(size_t)r * DFFP + DFF + k] = 0;
  }
  for (int idx = gtid; idx < DEPTH * 2 * DFFP; idx += gn) {
    const int c = idx % DFFP, h = (idx / DFFP) & 1, l = idx / (2 * DFFP);
    const bool ok = c < DFF;
    p.bupP[idx] = ok ? p.ffn_b_up[(size_t)l * DFF2 + h * DFF + c] : 0.f;
    p.cbP[idx] = ok ? p.ffn_conv_b[(size_t)l * DFF2 + h * DFF + c] : 0.f;
#pragma unroll
    for (int tap = 0; tap < 3; ++tap)
      p.cwP[(size_t)l * 6 * DFFP + (size_t)(tap * 2 + h) * DFFP + c] = ok ? p.ffn_conv_w[((size_t)l * 3 + tap) * DFF2 + h * DFF + c] : 0.f;
  }
}
DI void mod_phase(const Params& p, float* lds) {
  float* s = lds;
  float* part = lds + 9216;
  const int tid = tidx(), col = tid & 63, ks = tid >> 6;
  for (int item = blockIdx.x; item < DEPTH * 96; item += gridDim.x) {
    const int l = item / 96, n0 = (item % 96) * 64;
    for (int idx = tid; idx < 9 * 1024; idx += NTHR) {
      const int r = idx >> 10, k = idx & 1023;
      s[idx] = siluf(r < 8 ? p.c[r * D + k] : p.c_ctx[k]);
    }
    __syncthreads();
    float acc[9];
#pragma unroll
    for (int r = 0; r < 9; ++r) acc[r] = 0.f;
    const float* w = p.w_ada + (size_t)l * D * 6144 + n0 + col;
    for (int k = ks * 128; k < ks * 128 + 128; ++k) {
      const float wv = w[(size_t)k * 6144];
#pragma unroll
      for (int r = 0; r < 9; ++r) acc[r] += s[r * 1024 + k] * wv;
    }
#pragma unroll
    for (int r = 0; r < 9; ++r) part[(ks * 9 + r) * 64 + col] = acc[r];
    __syncthreads();
    for (int idx = tid; idx < 576; idx += NTHR) {
      const int r = idx >> 6, cc = idx & 63;
      float a = p.b_ada[l * 6144 + n0 + cc];
#pragma unroll
      for (int q = 0; q < 8; ++q) a += part[(q * 9 + r) * 64 + cc];
      p.mod[((size_t)l * 9 + r) * 6144 + n0 + cc] = a;
    }
    __syncthreads();
  }
}
DI void hy_mlp_item(const Params& p, float* lds, int l, int tt, bool lat) {
  const int Ls = lat ? SEQ : CL, t0 = tt * 32, tid = tidx();
  float* feat = lds;
  float* h1 = lds + 544;
  float* h2 = h1 + 2048;
  float* outl = h2 + 2048;
  for (int idx = tid; idx < 32 * 17; idx += NTHR) {
    const int t = idx / 17, f = idx % 17;
    const float tg = (float)(t0 + t);
    float v;
    if (f == 0) v = tg / (float)(Ls - 1);
    else {
      const int jb = (f - 1) & 7;
      const float band = 1e-4f + (float)jb * ((7.f - 1e-4f) / 7.f);
      const float rev = tg * band / (float)Ls;
      v = f <= 8 ? cos_rev(rev) : -sin_rev(rev);
    }
    feat[idx] = v;
  }
  __syncthreads();
  const float* w1 = p.hy_f_w1 + (size_t)l * 17 * 64;
  const float* w2 = p.hy_f_w2 + (size_t)l * 64 * 64;
  const float* w3 = p.hy_f_w3 + (size_t)l * 64 * 512;
#pragma unroll
  for (int i = 0; i < 4; ++i) {
    const int idx = tid + NTHR * i, t = idx >> 6, n = idx & 63;
    float a = p.hy_f_b1[l * 64 + n];
    for (int f = 0; f < 17; ++f) a += feat[t * 17 + f] * w1[f * 64 + n];
    h1[idx] = sin_rev(p.hy_f_freq[l * 64 + n] * a * INV2PI);
  }
  __syncthreads();
#pragma unroll
  for (int i = 0; i < 4; ++i) {
    const int idx = tid + NTHR * i, t = idx >> 6, n = idx & 63;
    float a = p.hy_f_b2[l * 64 + n];
    for (int k = 0; k < 64; ++k) a += h1[t * 64 + k] * w2[k * 64 + n];
    h2[n * 32 + t] = sin_rev(p.hy_f_freq[l * 64 + n] * a * INV2PI);
  }
  __syncthreads();
  {
    const int n = tid, c = n & 255;
    float acc[32];
#pragma unroll
    for (int t = 0; t < 32; ++t) acc[t] = 0.f;
#pragma unroll 2
    for (int k = 0; k < 64; ++k) {
      const float wv = w3[k * 512 + n];
#pragma unroll
      for (int t4 = 0; t4 < 8; ++t4) {
        const float4 hv = *(const float4*)(h2 + k * 32 + t4 * 4);
        acc[4 * t4] += hv.x * wv; acc[4 * t4 + 1] += hv.y * wv; acc[4 * t4 + 2] += hv.z * wv; acc[4 * t4 + 3] += hv.w * wv;
      }
    }
    const float mind = -3.0701134573253946f, maxd = -15.350567286626973f;
    const float delta = fabsf(mind + (maxd - mind) * ((float)c / 255.f));
#pragma unroll
    for (int t = 0; t < 32; ++t) {
      const float tn = (float)(t0 + t) / (float)(Ls - 1);
      outl[n * 33 + t] = acc[t] * __expf(-tn * delta);
    }
  }
  __syncthreads();
  const int N2 = 2 * Ls;
  float* kv = lat ? p.kvec + (size_t)l * 256 * (2 * SEQ) : p.kvecc + (size_t)l * 256 * (2 * CL);
  for (int idx = tid; idx < 512 * 32; idx += NTHR) {
    const int n = idx >> 5, t = idx & 31, c = n & 255, dir = n >> 8, tg = t0 + t;
    float val = outl[n * 33 + t];
    if (dir == 0) {
      if (tg == 0) val += outl[(256 + c) * 33];
      kv[(size_t)c * N2 + tg] = val;
    } else {
      if (tg == 0) kv[(size_t)c * N2 + Ls] = 0.f;
      else kv[(size_t)c * N2 + N2 - tg] = val;
    }
  }
  __syncthreads();
}
DI void khat_item(const Params& p, float2* X, int l, int c, bool lat) {
  const int Ls = lat ? SEQ : CL, lg = lat ? 14 : 9, N = 2 * Ls;
  const float* kv = lat ? p.kvec + (size_t)(l * 256 + c) * N : p.kvecc + (size_t)(l * 256 + c) * N;
  float2* Kh = lat ? p.Khat + (size_t)(l * 256 + c) * N : p.Khatc + (size_t)(l * 256 + c) * N;
#pragma unroll 8
  for (int i = tidx(); i < N; i += NTHR) X[XP(i)] = make_float2(kv[i], kv[N + i]);
  __syncthreads();
  fft_dif(X, lg);
#pragma unroll 4
  for (int i = tidx(); i < N; i += NTHR) {
    const int k = (int)(__brev((unsigned)i) >> (32 - lg));
    const int ip = (int)(__brev((unsigned)((N - k) & (N - 1))) >> (32 - lg));
    const float2 z = X[XP(i)], w = X[XP(ip)];
    Kh[i] = make_float2(0.5f * (z.x + w.x), 0.5f * (z.y - w.y));
    Kh[N + i] = make_float2(0.5f * (z.y + w.y), -0.5f * (z.x - w.x));
  }
  __syncthreads();
}

DI void grid_barrier(unsigned* bar, unsigned n) {
  asm volatile("s_waitcnt vmcnt(0) lgkmcnt(0)" ::: "memory");
  __syncthreads();
  if (threadIdx.x == 0) {
    const unsigned G = gridDim.x;
    __builtin_amdgcn_fence(__ATOMIC_RELEASE, "agent");
    if ((G & 7u) == 0u) {
      const unsigned x = blockIdx.x & 7u, per = G >> 3;
      unsigned* cnt = bar + 64 * (1 + x);
      unsigned* rel = bar + 64 * (9 + x);
      const unsigned old = __hip_atomic_fetch_add(cnt, 1u, __ATOMIC_RELAXED, __HIP_MEMORY_SCOPE_AGENT);
      if (old + 1u == n * per) {
        __hip_atomic_fetch_add(bar, 1u, __ATOMIC_RELAXED, __HIP_MEMORY_SCOPE_AGENT);
        while (__hip_atomic_load(bar, __ATOMIC_RELAXED, __HIP_MEMORY_SCOPE_AGENT) < n * 8u) __builtin_amdgcn_s_sleep(1);
        __hip_atomic_store(rel, n, __ATOMIC_RELAXED, __HIP_MEMORY_SCOPE_AGENT);
      } else {
        while (__hip_atomic_load(rel, __ATOMIC_RELAXED, __HIP_MEMORY_SCOPE_AGENT) < n) __builtin_amdgcn_s_sleep(1);
      }
    } else {
      __hip_atomic_fetch_add(bar, 1u, __ATOMIC_RELAXED, __HIP_MEMORY_SCOPE_AGENT);
      while (__hip_atomic_load(bar, __ATOMIC_RELAXED, __HIP_MEMORY_SCOPE_AGENT) < n * G) __builtin_amdgcn_s_sleep(1);
    }
    __builtin_amdgcn_fence(__ATOMIC_ACQUIRE, "agent");
  }
  __syncthreads();
}

__global__ void __launch_bounds__(NTHR) fwd_megakernel(Params p) {
  extern __shared__ __attribute__((aligned(16))) char lds[];
  cg::grid_group grid = cg::this_grid();
  float* ldsf = (float*)lds;
#pragma unroll 1
  for (int ph2 = 0; ph2 < 2 * (2 + 9 * DEPTH); ++ph2) {
    const int ph = ph2 >> 1;
    int l = 0, kind = ph;
    if (ph >= 2) { l = (ph - 2) / 9; kind = 3 + (ph - 2) % 9; }
    if ((ph2 & 1) && !(l == 0 && ((PROBE_DUP >> kind) & 1))) continue;
    if (kind == 0) {
      convert_phase(p, ldsf);
      pad_phase(p);
      mod_phase(p, ldsf);
#pragma unroll 1
      for (int item = blockIdx.x; item < DEPTH * 264; item += gridDim.x) {
        const int ll = item / 264, r = item % 264;
        hy_mlp_item(p, ldsf, ll, r < 256 ? r : r - 256, r < 256);
      }
    } else if (kind == 1) {
#pragma unroll 1
      for (int item = blockIdx.x; item < 2 * DEPTH * 128; item += gridDim.x)
        khat_item(p, (float2*)lds, (item >> 7) & 3, (item & 127) * 2, item < DEPTH * 128);
    }
    if (kind == 0) {
    } else if (kind == 1 || kind == 8 || kind == 11) {
      row_pass(p, l, kind == 1 ? 0 : (kind == 8 ? 1 : 2));
    } else if (kind == 3) {
      inproj_phase(p, l, lds);
    } else if (kind == 4) {
      mixers_phase(p, l, lds);
    } else if (kind == 6) {
      merge_norm_phase(p, l == DEPTH - 1 ? T : MROWS);
    } else if (kind == 9) {
      ffn_up_phase(p, l, lds);
    } else {
      const bf16_t* A; const bf16_t* Wt; const float* bias; bf16_t* out; int lda, ldw, K, NTn, ocol0;
      if (kind == 5) { A = p.F; lda = 256; Wt = p.Wfn + (size_t)l * 256 * 256; ldw = 256; K = 256; NTn = 1; bias = p.fnet_b + l * 256; out = p.HO; ocol0 = 768; }
      else if (kind == 7) { A = p.HO; lda = HS; Wt = p.Wout + (size_t)l * D * HS; ldw = HS; K = D; NTn = 4; bias = p.b_out + l * D; out = p.Y; ocol0 = 0; }
      else { A = p.ACT; lda = DFFP; Wt = p.Wdn + (size_t)l * D * DFFP; ldw = DFFP; K = DFFP; NTn = 4; bias = p.ffn_b_down + l * D; out = p.Y; ocol0 = 0; }
      gemm_plain_phase(lds, A, lda, Wt, ldw, K, l == DEPTH - 1 ? T / 256 : MROWS / 256, NTn, bias, out, kind == 5 ? HS : D, ocol0);
    }
    if (ph == 0) grid.sync();
    else grid_barrier(p.bar, (unsigned)ph);
  }
}

extern "C" void kernel_launch(void* const* d_in, const int* in_sizes, int n_in, void* d_out, int out_size, void* d_ws,
                              size_t ws_size, hipStream_t stream) {
  Params p{};
  const float** pf = (const float**)&p;
  for (int i = 0; i < 34; ++i) pf[i] = (const float*)d_in[i];
  p.out = (float*)d_out;
  char* w = (char*)d_ws;
  size_t off = 8192;
  p.bar = (unsigned*)d_ws;
  (void)hipMemsetAsync(d_ws, 0, 8192, stream);
  auto take = [&](size_t bytes) { char* r = w + off; off += (bytes + 255) & ~(size_t)255; return r; };
  p.Win = (bf16_t*)take((size_t)DEPTH * DP * HS * 2);
  p.Wout = (bf16_t*)take((size_t)DEPTH * D * HS * 2);
  p.Wup = (bf16_t*)take((size_t)DEPTH * 2 * DFFP * HS * 2);
  p.Wdn = (bf16_t*)take((size_t)DEPTH * D * DFFP * 2);
  p.bupP = (float*)take((size_t)DEPTH * 2 * DFFP * 4);
  p.cwP = (float*)take((size_t)DEPTH * 6 * DFFP * 4);
  p.cbP = (float*)take((size_t)DEPTH * 2 * DFFP * 4);
  p.Wfn = (bf16_t*)take((size_t)DEPTH * 256 * 256 * 2);
  p.mod = (float*)take((size_t)DEPTH * 9 * 6144 * 4);
  p.Khat = (float2*)take((size_t)DEPTH * 256 * 2 * SEQ * 8);
  p.Khatc = (float2*)take((size_t)DEPTH * 256 * 2 * CL * 8);
  p.cx = (float*)take((size_t)TC * D * 4);
  p.HO = (bf16_t*)take((size_t)(MROWS + 256) * HS * 2);
  p.Y = (bf16_t*)take((size_t)MROWS * D * 2);
  const size_t r0 = off;
  p.Zq = (bf16_t*)take((size_t)MROWS * HS * 2);
  p.ZT = (float*)take((size_t)NB * 1024 * SEQ * 4);
  p.ZTc = (float*)take((size_t)NB * 1024 * CL * 4);
  p.VT = (bf16_t*)take((size_t)2 * NB * 2 * 64 * LV * 2);
  p.F = (bf16_t*)take((size_t)MROWS * 256 * 2);
  const size_t r1 = off;
  p.ACT = (bf16_t*)(w + r0);
  p.kvec = (float*)(w + r0);
  p.kvecc = (float*)(w + r0 + (size_t)DEPTH * 256 * 2 * SEQ * 4);
  const size_t act_end = r0 + (size_t)MROWS * DFFP * 2;
  if (act_end > off) off = act_end;
  (void)r1;
  if (off > ws_size) fprintf(stderr, "workspace too small: need %zu have %zu\n", off, ws_size);
  static int grid_blocks = 0;
  if (!grid_blocks) {
    (void)hipFuncSetAttribute((const void*)fwd_megakernel, hipFuncAttributeMaxDynamicSharedMemorySize, (int)LDS_BYTES);
    int dev = 0, cus = 0, per_cu = 0;
    (void)hipGetDevice(&dev);
    (void)hipDeviceGetAttribute(&cus, hipDeviceAttributeMultiprocessorCount, dev);
    (void)hipOccupancyMaxActiveBlocksPerMultiprocessor(&per_cu, fwd_megakernel, NTHR, LDS_BYTES);
    if (per_cu > 1) per_cu = 1;
    grid_blocks = cus * per_cu;
  }
  void* args[] = {&p};
  hipError_t e = hipLaunchCooperativeKernel((void*)fwd_megakernel, dim3(grid_blocks), dim3(NTHR), args, LDS_BYTES, stream);
  if (e != hipSuccess) fprintf(stderr, "cooperative launch failed: %s (grid %d)\n", hipGetErrorString(e), grid_blocks);
}
```

```cpp
#include <hip/hip_runtime.h>
#include <hip/hip_cooperative_groups.h>
#include <stdint.h>
#include <cstdio>
namespace cg = cooperative_groups;

typedef unsigned short bf16_t;
typedef short bf16x8 __attribute__((ext_vector_type(8)));
typedef float f32x4 __attribute__((ext_vector_type(4)));
typedef float f32x16 __attribute__((ext_vector_type(16)));
typedef __bf16 bf2_t __attribute__((ext_vector_type(2)));
typedef float f2_t __attribute__((ext_vector_type(2)));

#define DI __device__ __forceinline__
typedef unsigned u32x2 __attribute__((ext_vector_type(2)));

constexpr int D = 1024, NB = 8, SEQ = 8192, DEPTH = 4, CL = 256;
constexpr int T = NB * SEQ, TC = NB * CL, MROWS = T + TC;
constexpr int DP = 2048, DFF = 2752, DFF2 = 5504, DFFP = 2816;
constexpr int LV = SEQ + CL + 64;
constexpr int HS = 1088;
constexpr int NTHR = 512;
constexpr float ALPHA = 1.681792830507429f;
constexpr float LOG2E = 1.4426950408889634f;
constexpr float INV2PI = 0.15915494309189535f;
constexpr size_t LDS_BYTES = 135168;
#ifndef PROBE_MIX
#define PROBE_MIX 0
#endif
#ifndef PROBE_DUP
#define PROBE_DUP 0x000
#endif

struct Params {
  const float *x, *c, *ctx, *c_ctx, *w_ada, *b_ada, *w_in, *sink_a, *q_norm_g, *k_norm_g,
      *hy_conv_w, *hy_conv_b, *hy_f_w1, *hy_f_b1, *hy_f_freq, *hy_f_w2, *hy_f_b2, *hy_f_w3, *hy_skip,
      *fnet_w, *fnet_b, *out_norm_g, *w_out, *b_out, *ln1_g, *ln1_b, *ffn_w_up, *ffn_b_up, *ffn_conv_w, *ffn_conv_b,
      *ffn_w_down, *ffn_b_down, *ln2_g, *ln2_b;
  float* out;
  bf16_t *Win, *Wout, *Wup, *Wdn, *Wfn;
  float* mod;
  float2 *Khat, *Khatc;
  float* cx;
  bf16_t *HO, *Y, *Zq;
  float *ZT, *ZTc;
  bf16_t *VT, *F;
  float *kvec, *kvecc;
  bf16_t* ACT;
  float *bupP, *cwP, *cbP;
  unsigned* bar;
};

DI int tidx() { int t = threadIdx.x; asm volatile("" : "+v"(t)); return t; }
DI unsigned pack2(float a, float b) {
  f2_t v = {a, b};
  bf2_t r = __builtin_convertvector(v, bf2_t);
  return __builtin_bit_cast(unsigned, r);
}
DI bf16_t f2bf(float a) { return (bf16_t)(pack2(a, 0.f) & 0xffffu); }
DI float bf2f(unsigned h) { return __uint_as_float(h << 16); }
DI float sin_rev(float r) { return __builtin_amdgcn_sinf(r); }
DI float cos_rev(float r) { return __builtin_amdgcn_cosf(r); }
#define dpp_f(v, ctrl, row_mask) __builtin_bit_cast(float, __builtin_amdgcn_update_dpp(0, __builtin_bit_cast(int, (float)(v)), (ctrl), (row_mask), 0xf, false))
DI float row16_sum(float v) {
  v += dpp_f(v, 0xB1, 0xf);
  v += dpp_f(v, 0x4E, 0xf);
  v += dpp_f(v, 0x141, 0xf);
  v += dpp_f(v, 0x140, 0xf);
  return v;
}
DI float wave_sum(float v) {
  v = row16_sum(v);
  v += dpp_f(v, 0x142, 0xa);
  v += dpp_f(v, 0x143, 0xc);
  return __builtin_bit_cast(float, __builtin_amdgcn_readlane(__builtin_bit_cast(int, v), 63));
}
DI float siluf(float x) { return x * __builtin_amdgcn_rcpf(1.f + __builtin_amdgcn_exp2f(-1.4426950408889634f * x)); }

DI int grid8() { return (int)(gridDim.x & ~7u); }
DI int xcd_local(int it, int per_xcd) {
  const int G8 = grid8();
  if ((int)blockIdx.x >= G8) return -1;
  const int loc = it * (G8 >> 3) + ((int)blockIdx.x >> 3);
  return loc < per_xcd ? loc : -1;
}
DI bool tile_map(int it, int MT, int NTn, int& mt, int& nt) {
  const int G8 = grid8();
  if ((int)blockIdx.x >= G8) return false;
  const int xcd = blockIdx.x & 7, slot = blockIdx.x >> 3, SL = G8 >> 3;
  const int MTx = (MT - xcd + 7) >> 3;
  const int q = it * SL + slot;
  if (q >= MTx * NTn) return false;
  const int gm = q / (4 * NTn), rem = q - gm * 4 * NTn;
  int gsz = MTx - 4 * gm;
  if (gsz > 4) gsz = 4;
  nt = rem / gsz;
  mt = xcd + 8 * (gm * 4 + rem % gsz);
  return true;
}

typedef __attribute__((address_space(3))) unsigned char lds_uc;
constexpr int HTB = 16384;
DI int lds_byte(int r, int c) {
  const int st = (r >> 4) * 2 + (c >> 5), rr = r & 15, cc = c & 31, ob = rr * 64 + cc * 2;
  return st * 1024 + (ob ^ (((ob >> 9) & 1) << 5));
}
DI void stage_rc(int b, int& R, int& C) {
  const int st = b >> 10, sb = b & 1023, swz = sb ^ (((sb >> 9) & 1) << 5);
  R = (st >> 1) * 16 + (swz >> 6);
  C = (st & 1) * 32 + ((swz & 63) >> 1);
}
struct PgUnit { const char* A; const char* B; int mt, nt; };
struct PgDesc { size_t a_h, b_h; int nk; unsigned voffA, voffB; size_t dA, dB; };
#define PG_WAIT_V(n) asm volatile("s_waitcnt vmcnt(" #n ")" ::: "memory")
#define PG_WAIT_L(n) asm volatile("s_waitcnt lgkmcnt(" #n ")" ::: "memory")
#define PG_BAR __builtin_amdgcn_s_barrier()
#define PG_SCHED __builtin_amdgcn_sched_barrier(0)

template <class Src, class Epi>
DI void pgemm(char* lds_, const PgDesc& d, const Src& src, const Epi& epi) {
  lds_uc* lds = (lds_uc*)lds_;
  const int tid = tidx(), wid = __builtin_amdgcn_readfirstlane(tid >> 6), lane = tid & 63, wr = wid >> 2, wc = wid & 3, fr = lane & 15, fq = lane >> 4;
  const int nt = d.nk;
  const size_t kstep = 128, ah = d.a_h, bh = d.b_h, voffA_d = d.dA, voffB_d = d.dB;
  const unsigned voffA = d.voffA, voffB = d.voffB;
  const unsigned ldsw = (unsigned)wid * 1024u;
  const int aoff = lds_byte(wr * 64 + fr, fq * 8), boff = lds_byte(wc * 32 + fr, fq * 8);
#define PG_SA(b, h) (((b) * 2 + (h)) * HTB)
#define PG_SB(b, h) ((4 + (b) * 2 + (h)) * HTB)
#define PG_STAGE(bufoff, gbase, voff) do { _Pragma("unroll") for (int _i = 0; _i < 2; ++_i) \
    __builtin_amdgcn_global_load_lds((const unsigned*)((const char*)(gbase) + (size_t)_i * voff##_d + voff), (__attribute__((address_space(3))) unsigned*)(lds + (bufoff) + ldsw + _i * 8192), 16, 0, 0); } while (0)
#define PG_LDA(dst, b, h) do { _Pragma("unroll") for (int m = 0; m < 4; ++m) _Pragma("unroll") for (int k = 0; k < 2; ++k) dst[m][k] = *(const __attribute__((address_space(3))) bf16x8*)(lds + PG_SA(b, h) + aoff + m * 2048 + k * 1024); } while (0)
#define PG_LDB(dst, b, h) do { _Pragma("unroll") for (int n = 0; n < 2; ++n) _Pragma("unroll") for (int k = 0; k < 2; ++k) dst[n][k] = *(const __attribute__((address_space(3))) bf16x8*)(lds + PG_SB(b, h) + boff + n * 2048 + k * 1024); } while (0)
#define PG_MMA(ai, bj, At, Bt) do { __builtin_amdgcn_s_setprio(1); _Pragma("unroll") for (int m = 0; m < 4; ++m) _Pragma("unroll") for (int n = 0; n < 2; ++n) _Pragma("unroll") for (int k = 0; k < 2; ++k) \
    acc[ai][bj][m][n] = __builtin_amdgcn_mfma_f32_16x16x32_bf16(Bt[n][k], At[m][k], acc[ai][bj][m][n], 0, 0, 0); __builtin_amdgcn_s_setprio(0); } while (0)
  PgUnit cur, nxt;
  int ui = 0;
  if (!src.next(0, cur)) return;
  f32x4 acc[2][2][4][2];
#pragma unroll
  for (int a = 0; a < 2; ++a)
#pragma unroll
    for (int b = 0; b < 2; ++b)
#pragma unroll
      for (int m = 0; m < 4; ++m)
#pragma unroll
        for (int n = 0; n < 2; ++n) acc[a][b][m][n] = (f32x4){0.f, 0.f, 0.f, 0.f};
  bf16x8 At[4][2], B0[2][2], B1[2][2];
  const char* cA = cur.A;
  const char* cB = cur.B;
  PG_WAIT_V(0);
  PG_STAGE(PG_SB(0, 0), cB, voffB); PG_STAGE(PG_SA(0, 0), cA, voffA); PG_STAGE(PG_SB(0, 1), cB + bh, voffB); PG_STAGE(PG_SA(0, 1), cA + ah, voffA);
  if (wr == 1) PG_BAR;
  PG_WAIT_V(4); PG_BAR;
  PG_STAGE(PG_SB(1, 0), cB + kstep, voffB); PG_STAGE(PG_SA(1, 0), cA + kstep, voffA); PG_STAGE(PG_SB(1, 1), cB + bh + kstep, voffB);
  PG_WAIT_V(6); PG_BAR;
  for (;;) {
    const bool has_next = src.next(ui + 1, nxt);
    const char* nA = has_next ? nxt.A : cA;
    const char* nB = has_next ? nxt.B : cB;
    for (int t = 0; t < nt; t += 2) {
      const bool last = (t == nt - 2);
      const char* a1 = cA + (size_t)(t + 1) * kstep;
      const char* a2 = last ? nA : cA + (size_t)(t + 2) * kstep;
      const char* b2 = last ? nB : cB + (size_t)(t + 2) * kstep;
      const char* a3 = a2 + kstep;
      const char* b3 = b2 + kstep;
      PG_LDB(B0, 0, 0); PG_SCHED; PG_LDA(At, 0, 0); PG_STAGE(PG_SA(1, 1), a1 + ah, voffA);
      PG_WAIT_L(8); PG_BAR; PG_WAIT_L(0); PG_MMA(0, 0, At, B0); PG_BAR; PG_SCHED;
      PG_LDB(B1, 0, 1); PG_STAGE(PG_SB(0, 0), b2, voffB);
      PG_BAR; PG_WAIT_L(0); PG_MMA(0, 1, At, B1); PG_BAR;
      PG_LDA(At, 0, 1); PG_STAGE(PG_SA(0, 0), a2, voffA);
      PG_BAR; PG_WAIT_L(0); PG_MMA(1, 0, At, B0); PG_BAR; PG_SCHED;
      PG_STAGE(PG_SB(0, 1), b2 + bh, voffB);
      PG_WAIT_V(6); PG_BAR; PG_MMA(1, 1, At, B1); PG_BAR;
      PG_LDB(B0, 1, 0); PG_SCHED; PG_LDA(At, 1, 0); PG_STAGE(PG_SA(0, 1), a2 + ah, voffA);
      PG_WAIT_L(8); PG_BAR; PG_WAIT_L(0); PG_MMA(0, 0, At, B0); PG_BAR; PG_SCHED;
      PG_LDB(B1, 1, 1); PG_STAGE(PG_SB(1, 0), b3, voffB);
      PG_BAR; PG_WAIT_L(0); PG_MMA(0, 1, At, B1); PG_BAR;
      PG_LDA(At, 1, 1); PG_STAGE(PG_SA(1, 0), a3, voffA);
      PG_BAR; PG_WAIT_L(0); PG_MMA(1, 0, At, B0); PG_BAR; PG_SCHED;
      PG_STAGE(PG_SB(1, 1), b3 + bh, voffB);
      PG_WAIT_V(6); PG_BAR; PG_MMA(1, 1, At, B1); PG_BAR;
    }
    epi(acc, cur, wr, wc, fr, fq);
    if (!has_next) break;
#pragma unroll
    for (int a = 0; a < 2; ++a)
#pragma unroll
      for (int b = 0; b < 2; ++b)
#pragma unroll
        for (int m = 0; m < 4; ++m)
#pragma unroll
          for (int n = 0; n < 2; ++n) acc[a][b][m][n] = (f32x4){0.f, 0.f, 0.f, 0.f};
    cur = nxt; cA = nA; cB = nB; ++ui;
  }
  PG_WAIT_V(0);
  if (wr == 0) PG_BAR;
  PG_BAR;
#undef PG_SA
#undef PG_SB
#undef PG_STAGE
#undef PG_LDA
#undef PG_LDB
#undef PG_MMA
}

struct PlainSrc {
  const bf16_t* A; const bf16_t* Wt; int lda, ldw, MT, NTn;
  DI bool next(int i, PgUnit& u) const {
    if (!tile_map(i, MT, NTn, u.mt, u.nt)) return false;
    u.A = (const char*)(A + (size_t)u.mt * 256 * lda);
    u.B = (const char*)(Wt + (size_t)u.nt * 256 * ldw);
    return true;
  }
};
struct PlainEpi {
  const float* bias; bf16_t* out; int ldo, ocol0;
  DI void operator()(f32x4 (&acc)[2][2][4][2], const PgUnit& u, int wr, int wc, int fr, int fq) const {
    asm volatile("" : "+v"(fr), "+v"(fq));
#pragma unroll
    for (int bj = 0; bj < 2; ++bj)
#pragma unroll
      for (int n = 0; n < 2; ++n) {
        const int col = u.nt * 256 + bj * 128 + wc * 32 + n * 16 + fq * 4;
        const float4 bv = *(const float4*)(bias + col);
#pragma unroll
        for (int ai = 0; ai < 2; ++ai)
#pragma unroll
          for (int m = 0; m < 4; ++m) {
            const int row = u.mt * 256 + ai * 128 + wr * 64 + m * 16 + fr;
            uint2 w;
            w.x = pack2(acc[ai][bj][m][n][0] + bv.x, acc[ai][bj][m][n][1] + bv.y);
            w.y = pack2(acc[ai][bj][m][n][2] + bv.z, acc[ai][bj][m][n][3] + bv.w);
            *(uint2*)(out + (size_t)row * ldo + ocol0 + col) = w;
          }
      }
  }
};
DI void gemm_plain_phase(char* lds, const bf16_t* A, int lda, const bf16_t* Wt, int ldw, int K, int MT, int NTn, const float* bias,
                         bf16_t* out, int ldo, int ocol0) {
  PgDesc d;
  d.a_h = (size_t)128 * lda * 2; d.b_h = (size_t)128 * ldw * 2; d.nk = K / 64;
  {
    int R, C;
    stage_rc(tidx() * 16, R, C);
    d.voffA = (unsigned)(R * lda + C) * 2u; d.dA = (size_t)64 * lda * 2;
    d.voffB = (unsigned)(R * ldw + C) * 2u; d.dB = (size_t)64 * ldw * 2;
  }
  PlainSrc src{A, Wt, lda, ldw, MT, NTn};
  PlainEpi epi{bias, out, ldo, ocol0};
  pgemm(lds, d, src, epi);
}

struct InprojSrc {
  const bf16_t* A; const bf16_t* Wt;
  DI bool next(int i, PgUnit& u) const {
    if (!tile_map(i, MROWS / 256, DP / 256, u.mt, u.nt)) return false;
    u.A = (const char*)(A + (size_t)u.mt * 256 * HS);
    u.B = (const char*)(Wt + (size_t)u.nt * 256 * HS);
    return true;
  }
};
struct InprojEpi {
  const Params* pp; int l;
  DI void operator()(f32x4 (&acc)[2][2][4][2], const PgUnit& u, int wr, int wc, int fr, int fq) const {
    asm volatile("" : "+v"(fr), "+v"(fq));
    const Params& p = *pp;
    const int mt = u.mt, hs = u.nt * 4 + wc;
    const bool isctx = mt >= 256;
    int b, t0;
    if (!isctx) { const int row0 = mt * 256; b = row0 >> 13; t0 = row0 & (SEQ - 1); }
    else { b = mt - 256; t0 = 0; }
    const int rb = wr * 64 + fr;
    if (hs < 6 || (hs >= 8 && hs < 14)) {
      const bool isB = hs >= 8;
      const int hh = isB ? hs - 8 : hs;
      const bool isq = hh < 4;
      if (isB) {
        const float* gp = (isq ? p.q_norm_g : p.k_norm_g) + l * 64 + fq * 4;
        const float4 g00 = *(const float4*)(gp), g01 = *(const float4*)(gp + 16), g10 = *(const float4*)(gp + 32), g11 = *(const float4*)(gp + 48);
#pragma unroll
        for (int ai = 0; ai < 2; ++ai)
#pragma unroll
          for (int m = 0; m < 4; ++m) {
            float ss = 0.f;
#pragma unroll
            for (int bj = 0; bj < 2; ++bj)
#pragma unroll
              for (int n = 0; n < 2; ++n)
#pragma unroll
                for (int j = 0; j < 4; ++j) ss += acc[ai][bj][m][n][j] * acc[ai][bj][m][n][j];
            ss += __shfl_xor(ss, 16, 64); ss += __shfl_xor(ss, 32, 64);
            const float r = rsqrtf(ss * (1.f / 64.f) + 1e-6f);
            acc[ai][0][m][0] *= (f32x4){g00.x * r, g00.y * r, g00.z * r, g00.w * r};
            acc[ai][0][m][1] *= (f32x4){g01.x * r, g01.y * r, g01.z * r, g01.w * r};
            acc[ai][1][m][0] *= (f32x4){g10.x * r, g10.y * r, g10.z * r, g10.w * r};
            acc[ai][1][m][1] *= (f32x4){g11.x * r, g11.y * r, g11.z * r, g11.w * r};
            __builtin_amdgcn_sched_barrier(0);
          }
      }
      if (!isctx) {
        float inv[4];
#pragma unroll
        for (int j = 0; j < 4; ++j) inv[j] = exp2f(-(float)(fq * 4 + j) * (13.287712379549449f / 16.f)) * INV2PI;
#pragma unroll
        for (int ai = 0; ai < 2; ++ai)
#pragma unroll
          for (int m = 0; m < 4; ++m) {
            const int t = t0 + ai * 128 + rb + m * 16;
            const float p0 = (float)(t >> 6), p1 = (float)(t & 63);
#pragma unroll
            for (int j = 0; j < 4; ++j) {
              const float a0 = p0 * inv[j], a1 = p1 * inv[j];
              const float c0 = cos_rev(a0), s0 = sin_rev(a0), c1 = cos_rev(a1), s1 = sin_rev(a1);
              const float x1 = acc[ai][0][m][0][j], x2 = acc[ai][0][m][1][j], y1 = acc[ai][1][m][0][j], y2 = acc[ai][1][m][1][j];
              acc[ai][0][m][0][j] = x1 * c0 - x2 * s0; acc[ai][0][m][1][j] = x2 * c0 + x1 * s0;
              acc[ai][1][m][0][j] = y1 * c1 - y2 * s1; acc[ai][1][m][1][j] = y2 * c1 + y1 * s1;
            }
            __builtin_amdgcn_sched_barrier(0);
          }
      }
      const float sc = isq ? 0.125f * LOG2E : 1.f;
#pragma unroll
      for (int ai = 0; ai < 2; ++ai)
#pragma unroll
        for (int m = 0; m < 4; ++m) {
          bf16_t* zr = p.Zq + (size_t)(mt * 256 + ai * 128 + rb + m * 16) * HS + hs * 64 + fq * 4;
#pragma unroll
          for (int bj = 0; bj < 2; ++bj)
#pragma unroll
            for (int n = 0; n < 2; ++n) {
              uint2 w;
              w.x = pack2(acc[ai][bj][m][n][0] * sc, acc[ai][bj][m][n][1] * sc);
              w.y = pack2(acc[ai][bj][m][n][2] * sc, acc[ai][bj][m][n][3] * sc);
              *(uint2*)(zr + bj * 32 + n * 16) = w;
            }
        }
    } else if (hs < 16) {
      const int grp = hs >= 14 ? 1 : 0, kvh = hs & 1;
      bf16_t* vb = p.VT + (size_t)((grp * 8 + b) * 2 + kvh) * 64 * LV + (isctx ? SEQ : 0) + t0 + rb;
#pragma unroll
      for (int bj = 0; bj < 2; ++bj)
#pragma unroll
        for (int n = 0; n < 2; ++n)
#pragma unroll
          for (int j = 0; j < 4; ++j) {
            bf16_t* vd = vb + (size_t)(bj * 32 + n * 16 + fq * 4 + j) * LV;
#pragma unroll
            for (int ai = 0; ai < 2; ++ai)
#pragma unroll
              for (int m = 0; m < 4; ++m) vd[ai * 128 + m * 16] = f2bf(acc[ai][bj][m][n][j]);
          }
    } else {
      const int colb = hs * 64 - 1024;
      const int Ls = isctx ? CL : SEQ;
      float* zb = (isctx ? p.ZTc + (size_t)b * 1024 * CL : p.ZT + (size_t)b * 1024 * SEQ) + t0 + rb;
#pragma unroll
      for (int bj = 0; bj < 2; ++bj)
#pragma unroll
        for (int n = 0; n < 2; ++n)
#pragma unroll
          for (int j = 0; j < 4; ++j) {
            float* zd = zb + (size_t)(colb + bj * 32 + n * 16 + fq * 4 + j) * Ls;
#pragma unroll
            for (int ai = 0; ai < 2; ++ai)
#pragma unroll
              for (int m = 0; m < 4; ++m) zd[ai * 128 + m * 16] = acc[ai][bj][m][n][j];
          }
    }
  }
};
DI void inproj_phase(const Params& p, int l, char* lds) {
  PgDesc d;
  d.a_h = (size_t)128 * HS * 2; d.b_h = (size_t)32 * HS * 2; d.nk = D / 64;
  {
    int R, C;
    stage_rc(tidx() * 16, R, C);
    d.voffA = (unsigned)(R * HS + C) * 2u; d.dA = (size_t)64 * HS * 2;
    d.voffB = (unsigned)(((R >> 5) * 64 + (R & 31)) * HS + C) * 2u; d.dB = (size_t)128 * HS * 2;
  }
  InprojSrc src{p.HO, p.Win + (size_t)l * DP * HS};
  InprojEpi epi{&p, l};
  pgemm(lds, d, src, epi);
}

DI float dpp_ror1(float v) { return __builtin_bit_cast(float, __builtin_amdgcn_update_dpp(0, __builtin_bit_cast(int, v), 0x121, 0xf, 0xf, false)); }
DI float dpp_rol1(float v) { return __builtin_bit_cast(float, __builtin_amdgcn_update_dpp(0, __builtin_bit_cast(int, v), 0x12f, 0xf, 0xf, false)); }
DI float row_prev(float prevreg, float cur) {
  return __builtin_bit_cast(float, __builtin_amdgcn_update_dpp(__builtin_bit_cast(int, dpp_ror1(prevreg)), __builtin_bit_cast(int, cur), 0x111, 0xf, 0xf, false));
}
DI float row_next(float nextreg, float cur) {
  return __builtin_bit_cast(float, __builtin_amdgcn_update_dpp(__builtin_bit_cast(int, dpp_rol1(nextreg)), __builtin_bit_cast(int, cur), 0x101, 0xf, 0xf, false));
}
constexpr int FUP_MT = 8 * 33 + 8 * 2, FUP_NT = DFFP / 128;
DI void ffn_tile(int mt, int& Ls, int& rowbase, int& ti) {
  if (mt < 264) { const int b = mt / 33; ti = mt - b * 33; Ls = SEQ; rowbase = b * SEQ; }
  else { const int q = mt - 264; const int b = q >> 1; ti = q & 1; Ls = CL; rowbase = T + b * CL; }
}
struct FfnUpSrc {
  const bf16_t* A; const bf16_t* Wt; int MT;
  DI bool next(int i, PgUnit& u) const {
    if (!tile_map(i, MT, FUP_NT, u.mt, u.nt)) return false;
    int Ls, rowbase, ti;
    ffn_tile(u.mt, Ls, rowbase, ti);
    u.A = (const char*)(A + ((long)rowbase + 252 * ti - 1) * HS);
    u.B = (const char*)(Wt + (size_t)u.nt * 128 * HS);
    return true;
  }
};
struct FfnUpEpi {
  const float *bup, *cw, *cb; bf16_t* act;
  DI void operator()(f32x4 (&acc)[2][2][4][2], const PgUnit& u, int wr, int wc, int fr, int fq) const {
    asm volatile("" : "+v"(fr), "+v"(fq));
    int Ls, rowbase, ti;
    ffn_tile(u.mt, Ls, rowbase, ti);
    const int tw = 252 * ti - 1 + 126 * wr;
    bf16_t* ob = act + (size_t)rowbase * DFFP;
#pragma unroll
    for (int n = 0; n < 2; ++n)
#pragma unroll
      for (int jp = 0; jp < 2; ++jp) {
        int col = u.nt * 128 + wc * 32 + n * 16 + fq * 4 + jp * 2;
        asm volatile("" : "+v"(col) :: "memory");
        float oo[8][2];
#pragma unroll
        for (int jj = 0; jj < 2; ++jj) {
          const int j = jp * 2 + jj, c = col + jj;
          {
            const float bu = bup[c], w0 = cw[c], w1 = cw[2 * DFFP + c], w2 = cw[4 * DFFP + c], bb = cb[c];
            float ua[8];
#pragma unroll
            for (int q = 0; q < 8; ++q) {
              const int t = tw + fr * 8 + q;
              ua[q] = (t >= 0 && t < Ls) ? acc[q >> 2][0][q & 3][n][j] + bu : 0.f;
            }
            const float upl = __builtin_bit_cast(float, __builtin_amdgcn_update_dpp(0, __builtin_bit_cast(int, ua[7]), 0x111, 0xf, 0xf, false));
            const float dnl = __builtin_bit_cast(float, __builtin_amdgcn_update_dpp(0, __builtin_bit_cast(int, ua[0]), 0x101, 0xf, 0xf, false));
#pragma unroll
            for (int q = 0; q < 8; ++q) {
              const float up = q > 0 ? ua[q > 0 ? q - 1 : 0] : upl;
              const float dn = q < 7 ? ua[q < 7 ? q + 1 : 7] : dnl;
              oo[q][jj] = siluf(w0 * up + w1 * ua[q] + w2 * dn + bb);
            }
          }
          {
            const float bu = bup[DFFP + c], w0 = cw[DFFP + c], w1 = cw[3 * DFFP + c], w2 = cw[5 * DFFP + c], bb = cb[DFFP + c];
            float ug[8];
#pragma unroll
            for (int q = 0; q < 8; ++q) {
              const int t = tw + fr * 8 + q;
              ug[q] = (t >= 0 && t < Ls) ? acc[q >> 2][1][q & 3][n][j] + bu : 0.f;
            }
            const float upl = __builtin_bit_cast(float, __builtin_amdgcn_update_dpp(0, __builtin_bit_cast(int, ug[7]), 0x111, 0xf, 0xf, false));
            const float dnl = __builtin_bit_cast(float, __builtin_amdgcn_update_dpp(0, __builtin_bit_cast(int, ug[0]), 0x101, 0xf, 0xf, false));
#pragma unroll
            for (int q = 0; q < 8; ++q) {
              const float up = q > 0 ? ug[q > 0 ? q - 1 : 0] : upl;
              const float dn = q < 7 ? ug[q < 7 ? q + 1 : 7] : dnl;
              oo[q][jj] *= (w0 * up + w1 * ug[q] + w2 * dn + bb);
            }
          }
        }
#pragma unroll
        for (int q = 0; q < 8; ++q) {
          const int lr = fr * 8 + q;
          const int t = tw + lr;
          if (lr >= 1 && lr <= 126 && t < Ls) *(unsigned*)(ob + (size_t)t * DFFP + col) = pack2(oo[q][0], oo[q][1]);
        }
        __builtin_amdgcn_sched_barrier(0);
      }
  }
};
DI void ffn_up_phase(const Params& p, int l, char* lds) {
  PgDesc d;
  d.a_h = (size_t)4 * HS * 2; d.b_h = (size_t)DFFP * HS * 2; d.nk = D / 64;
  {
    int R, C;
    stage_rc(tidx() * 16, R, C);
    d.voffA = (unsigned)(((R & 15) * 8 + (R >> 4)) * HS + C) * 2u; d.dA = (size_t)126 * HS * 2;
    d.voffB = (unsigned)(R * HS + C) * 2u; d.dB = (size_t)64 * HS * 2;
  }
  FfnUpSrc src{p.HO, p.Wup + (size_t)l * 2 * DFFP * HS, l == DEPTH - 1 ? 264 : FUP_MT};
  FfnUpEpi epi{p.bupP + (size_t)l * 2 * DFFP, p.cwP + (size_t)l * 6 * DFFP, p.cbP + (size_t)l * 2 * DFFP, p.ACT};
  pgemm(lds, d, src, epi);
}

DI int crow(int i, int h) { return (i & 3) + 8 * (i >> 2) + 4 * h; }
template <bool FIXED>
DI void attn_item(const Params& p, int l, char* lds, int grp, int b, int kvh, int qrow0, int qpos0, int jfirst, int nloc,
                  bool window) {
  const int tid = tidx(), lane = tid & 63, wave = tid >> 6, g = wave >> 2, qw = wave & 3;
  const int q31 = lane & 31, h = lane >> 5;
  const int head = kvh * 2 + g;
  const int qcol = (grp ? 512 : 0) + head * 64, kcol = (grp ? 768 : 256) + kvh * 64;
  const bf16_t* Zq = p.Zq;
  bf16x8 qf[4];
  {
    const bf16_t* qp = Zq + (size_t)(qrow0 + qw * 32 + q31) * HS + qcol + h * 8;
#pragma unroll
    for (int kk = 0; kk < 4; ++kk) qf[kk] = *(const bf16x8*)(qp + kk * 16);
  }
  const bf16_t* vt = p.VT + (size_t)((grp * 8 + b) * 2 + kvh) * 64 * LV;
  float m_run, l_run;
  if (grp == 0) { m_run = p.sink_a[l * 4 + head] * LOG2E; l_run = 1.f; }
  else { m_run = -1e30f; l_run = 0.f; }
  if (FIXED) {
    float gq = fabsf(p.q_norm_g[l * 64 + lane]), gk = fabsf(p.k_norm_g[l * 64 + lane]);
#pragma unroll
    for (int m = 32; m >= 1; m >>= 1) { gq = fmaxf(gq, __shfl_xor(gq, m, 64)); gk = fmaxf(gk, __shfl_xor(gk, m, 64)); }
    m_run = 8.f * LOG2E * gq * gk * 1.001f + 0.01f;
  }
  f32x16 O0, O1;
#pragma unroll
  for (int i = 0; i < 16; ++i) { O0[i] = 0.f; O1[i] = 0.f; }
  const int ntiles = nloc + 4;
  const int srow = tid >> 3, sch = tid & 7;
  char* Kl = lds;
  char* Vl = lds + 4 * 9216;
  uint4 rkA, rvA, rkB, rvB;
#define TILEJ(ti) ((ti) < nloc ? jfirst + (ti) * 64 : SEQ + ((ti) - nloc) * 64)
#define AGLOAD(rk, rv, ti)                                                                                 \
  {                                                                                                        \
    const int j_ = TILEJ(ti);                                                                              \
    const int key_ = j_ + srow;                                                                            \
    const size_t krow_ = key_ < SEQ ? (size_t)b * SEQ + key_ : (size_t)T + (size_t)b * CL + (key_ - SEQ);  \
    rk = *(const uint4*)(Zq + krow_ * HS + kcol + sch * 8);                                                \
    rv = *(const uint4*)(vt + (size_t)srow * LV + j_ + sch * 8);                                           \
  }
#define ASWRITE(rk, rv, slot)                                                                              \
  {                                                                                                        \
    *(uint4*)(Kl + (slot) * 9216 + srow * 144 + sch * 16) = rk;                                            \
    uint2* vp_ = (uint2*)(Vl + (slot) * 8704 + srow * 136 + sch * 16);                                     \
    vp_[0] = make_uint2(rv.x, rv.y);                                                                       \
    vp_[1] = make_uint2(rv.z, rv.w);                                                                       \
  }
  AGLOAD(rkA, rvA, 0);
  AGLOAD(rkB, rvB, 1);
  ASWRITE(rkA, rvA, 0);
  ASWRITE(rkB, rvB, 1);
  __syncthreads();
  const int qpos = qpos0 + qw * 32 + q31;
  int s0 = 0;
#pragma unroll 1
  for (int ti = 0; ti < ntiles; ti += 2) {
    const int s1 = s0 + 1, s2 = 2 - s0;
    if (ti + 2 < ntiles) { AGLOAD(rkA, rvA, ti + 2); AGLOAD(rkB, rvB, ti + 3); }
    {
      const int tcur = ti;
      const char* kb = Kl + s0 * 9216;
      const char* vb = Vl + s0 * 8704;
    f32x16 S0, S1;
    const float sinit = FIXED ? -m_run : 0.f;
#pragma unroll
    for (int i = 0; i < 16; ++i) { S0[i] = sinit; S1[i] = sinit; }
    bf16x8 kf[8];
    union { uint2 u[2]; bf16x8 v; } vfr[8];
#pragma unroll
    for (int kk = 0; kk < 4; ++kk) {
      kf[2 * kk] = *(const bf16x8*)(kb + q31 * 144 + kk * 32 + h * 16);
      kf[2 * kk + 1] = *(const bf16x8*)(kb + (32 + q31) * 144 + kk * 32 + h * 16);
    }
#pragma unroll
    for (int c = 0; c < 4; ++c)
#pragma unroll
      for (int ds = 0; ds < 2; ++ds) {
        const char* vp = vb + (ds * 32 + q31) * 136 + (16 * c + h * 4) * 2;
        vfr[c * 2 + ds].u[0] = *(const uint2*)vp;
        vfr[c * 2 + ds].u[1] = *(const uint2*)(vp + 16);
      }
    __builtin_amdgcn_sched_barrier(0);
#pragma unroll
    for (int kk = 0; kk < 4; ++kk) {
      S0 = __builtin_amdgcn_mfma_f32_32x32x16_bf16(kf[2 * kk], qf[kk], S0, 0, 0, 0);
      S1 = __builtin_amdgcn_mfma_f32_32x32x16_bf16(kf[2 * kk + 1], qf[kk], S1, 0, 0, 0);
    }
    const int j = TILEJ(tcur);
    if (window && j < SEQ) {
#pragma unroll
      for (int i = 0; i < 16; ++i) {
        const int kp = j + crow(i, h);
        int d0 = kp - qpos; d0 = d0 < 0 ? -d0 : d0;
        int d1 = kp + 32 - qpos; d1 = d1 < 0 ? -d1 : d1;
        S0[i] = d0 <= 128 ? S0[i] : -1e30f;
        S1[i] = d1 <= 128 ? S1[i] : -1e30f;
      }
    }
    if (FIXED) {
      float rs = 0.f;
#pragma unroll
      for (int i = 0; i < 16; ++i) {
        S0[i] = __builtin_amdgcn_exp2f(S0[i]);
        S1[i] = __builtin_amdgcn_exp2f(S1[i]);
        rs += S0[i] + S1[i];
      }
      l_run += rs;
    } else {
      float mx = S0[0];
#pragma unroll
      for (int i = 1; i < 16; ++i) mx = fmaxf(mx, S0[i]);
#pragma unroll
      for (int i = 0; i < 16; ++i) mx = fmaxf(mx, S1[i]);
      mx = fmaxf(mx, __shfl_xor(mx, 32, 64));
      const float mnew = fmaxf(m_run, mx);
      const float alpha = __builtin_amdgcn_exp2f(m_run - mnew);
      float rs = 0.f;
#pragma unroll
      for (int i = 0; i < 16; ++i) {
        S0[i] = __builtin_amdgcn_exp2f(S0[i] - mnew);
        S1[i] = __builtin_amdgcn_exp2f(S1[i] - mnew);
        rs += S0[i] + S1[i];
      }
      rs += __shfl_xor(rs, 32, 64);
      l_run = l_run * alpha + rs;
      m_run = mnew;
#pragma unroll
      for (int i = 0; i < 16; ++i) { O0[i] *= alpha; O1[i] *= alpha; }
    }
#pragma unroll
    for (int c = 0; c < 4; ++c) {
      union { unsigned u[4]; bf16x8 v; } pf;
      if (c < 2) {
#pragma unroll
        for (int e = 0; e < 4; ++e) pf.u[e] = pack2(S0[(c & 1) * 8 + 2 * e], S0[(c & 1) * 8 + 2 * e + 1]);
      } else {
#pragma unroll
        for (int e = 0; e < 4; ++e) pf.u[e] = pack2(S1[(c & 1) * 8 + 2 * e], S1[(c & 1) * 8 + 2 * e + 1]);
      }
      O0 = __builtin_amdgcn_mfma_f32_32x32x16_bf16(vfr[c * 2].v, pf.v, O0, 0, 0, 0);
      O1 = __builtin_amdgcn_mfma_f32_32x32x16_bf16(vfr[c * 2 + 1].v, pf.v, O1, 0, 0, 0);
    }

    }
    {
      const int tcur = ti + 1;
      const char* kb = Kl + s1 * 9216;
      const char* vb = Vl + s1 * 8704;
    f32x16 S0, S1;
    const float sinit = FIXED ? -m_run : 0.f;
#pragma unroll
    for (int i = 0; i < 16; ++i) { S0[i] = sinit; S1[i] = sinit; }
    bf16x8 kf[8];
    union { uint2 u[2]; bf16x8 v; } vfr[8];
#pragma unroll
    for (int kk = 0; kk < 4; ++kk) {
      kf[2 * kk] = *(const bf16x8*)(kb + q31 * 144 + kk * 32 + h * 16);
      kf[2 * kk + 1] = *(const bf16x8*)(kb + (32 + q31) * 144 + kk * 32 + h * 16);
    }
#pragma unroll
    for (int c = 0; c < 4; ++c)
#pragma unroll
      for (int ds = 0; ds < 2; ++ds) {
        const char* vp = vb + (ds * 32 + q31) * 136 + (16 * c + h * 4) * 2;
        vfr[c * 2 + ds].u[0] = *(const uint2*)vp;
        vfr[c * 2 + ds].u[1] = *(const uint2*)(vp + 16);
      }
    __builtin_amdgcn_sched_barrier(0);
#pragma unroll
    for (int kk = 0; kk < 4; ++kk) {
      S0 = __builtin_amdgcn_mfma_f32_32x32x16_bf16(kf[2 * kk], qf[kk], S0, 0, 0, 0);
      S1 = __builtin_amdgcn_mfma_f32_32x32x16_bf16(kf[2 * kk + 1], qf[kk], S1, 0, 0, 0);
    }
    const int j = TILEJ(tcur);
    if (window && j < SEQ) {
#pragma unroll
      for (int i = 0; i < 16; ++i) {
        const int kp = j + crow(i, h);
        int d0 = kp - qpos; d0 = d0 < 0 ? -d0 : d0;
        int d1 = kp + 32 - qpos; d1 = d1 < 0 ? -d1 : d1;
        S0[i] = d0 <= 128 ? S0[i] : -1e30f;
        S1[i] = d1 <= 128 ? S1[i] : -1e30f;
      }
    }
    if (FIXED) {
      float rs = 0.f;
#pragma unroll
      for (int i = 0; i < 16; ++i) {
        S0[i] = __builtin_amdgcn_exp2f(S0[i]);
        S1[i] = __builtin_amdgcn_exp2f(S1[i]);
        rs += S0[i] + S1[i];
      }
      l_run += rs;
    } else {
      float mx = S0[0];
#pragma unroll
      for (int i = 1; i < 16; ++i) mx = fmaxf(mx, S0[i]);
#pragma unroll
      for (int i = 0; i < 16; ++i) mx = fmaxf(mx, S1[i]);
      mx = fmaxf(mx, __shfl_xor(mx, 32, 64));
      const float mnew = fmaxf(m_run, mx);
      const float alpha = __builtin_amdgcn_exp2f(m_run - mnew);
      float rs = 0.f;
#pragma unroll
      for (int i = 0; i < 16; ++i) {
        S0[i] = __builtin_amdgcn_exp2f(S0[i] - mnew);
        S1[i] = __builtin_amdgcn_exp2f(S1[i] - mnew);
        rs += S0[i] + S1[i];
      }
      rs += __shfl_xor(rs, 32, 64);
      l_run = l_run * alpha + rs;
      m_run = mnew;
#pragma unroll
      for (int i = 0; i < 16; ++i) { O0[i] *= alpha; O1[i] *= alpha; }
    }
#pragma unroll
    for (int c = 0; c < 4; ++c) {
      union { unsigned u[4]; bf16x8 v; } pf;
      if (c < 2) {
#pragma unroll
        for (int e = 0; e < 4; ++e) pf.u[e] = pack2(S0[(c & 1) * 8 + 2 * e], S0[(c & 1) * 8 + 2 * e + 1]);
      } else {
#pragma unroll
        for (int e = 0; e < 4; ++e) pf.u[e] = pack2(S1[(c & 1) * 8 + 2 * e], S1[(c & 1) * 8 + 2 * e + 1]);
      }
      O0 = __builtin_amdgcn_mfma_f32_32x32x16_bf16(vfr[c * 2].v, pf.v, O0, 0, 0, 0);
      O1 = __builtin_amdgcn_mfma_f32_32x32x16_bf16(vfr[c * 2 + 1].v, pf.v, O1, 0, 0, 0);
    }

      if (ti + 2 < ntiles) { ASWRITE(rkA, rvA, s2); ASWRITE(rkB, rvB, s2 + 1); }
      __syncthreads();
    }
    s0 = s2;
  }
#undef TILEJ
#undef AGLOAD
#undef ASWRITE
  if (FIXED) l_run += __shfl_xor(l_run, 32, 64);
  const float inv = 1.f / l_run;
  bf16_t* op = p.HO + (size_t)(qrow0 + qw * 32 + q31) * HS + grp * 256 + head * 64 + h * 4;
#pragma unroll
  for (int gi = 0; gi < 4; ++gi) {
    uint2 w;
    w.x = pack2(O0[gi * 4 + 0] * inv, O0[gi * 4 + 1] * inv);
    w.y = pack2(O0[gi * 4 + 2] * inv, O0[gi * 4 + 3] * inv);
    *(uint2*)(op + gi * 8) = w;
    w.x = pack2(O1[gi * 4 + 0] * inv, O1[gi * 4 + 1] * inv);
    w.y = pack2(O1[gi * 4 + 2] * inv, O1[gi * 4 + 3] * inv);
    *(uint2*)(op + 32 + gi * 8) = w;
  }
}

DI float2 c_add(float2 a, float2 b) { return make_float2(a.x + b.x, a.y + b.y); }
DI float2 c_sub(float2 a, float2 b) { return make_float2(a.x - b.x, a.y - b.y); }
DI float2 c_mul(float2 a, float2 w) { return make_float2(a.x * w.x - a.y * w.y, a.x * w.y + a.y * w.x); }
DI float2 c_mni(float2 a) { return make_float2(a.y, -a.x); }
DI float2 c_pi(float2 a) { return make_float2(-a.y, a.x); }
constexpr float RS2 = 0.70710678118654752f;
DI void fft_bottom_r2(float2* X, int lg) {
  const int n2 = 1 << (lg - 1);
  for (int j = tidx(); j < n2; j += NTHR) {
    const float2 a = X[2 * j], b = X[2 * j + 1];
    X[2 * j] = c_add(a, b);
    X[2 * j + 1] = c_sub(a, b);
  }
  __syncthreads();
}
DI void fft_dif(float2* X, int lg) {
  const int n8 = 1 << (lg - 3);
  int s = lg - 1;
  for (; s >= 2; s -= 3) {
    const int q = 1 << (s - 2);
    const float inv = 1.0f / (float)(8 * q);
    for (int j = tidx(); j < n8; j += NTHR) {
      const int p = j & (q - 1);
      const int i0 = ((j >> (s - 2)) << (s + 1)) + p;
      float2 v[8];
#pragma unroll
      for (int k = 0; k < 8; ++k) v[k] = X[i0 + k * q];
      const float r = (float)p * inv;
      const float2 W = make_float2(cos_rev(r), -sin_rev(r));
      const float2 W2 = make_float2(W.x * W.x - W.y * W.y, 2.f * W.x * W.y);
      const float2 W4 = make_float2(W2.x * W2.x - W2.y * W2.y, 2.f * W2.x * W2.y);
      float2 y[8];
#pragma unroll
      for (int k = 0; k < 4; ++k) {
        y[k] = c_add(v[k], v[k + 4]);
        const float2 d = c_mul(c_sub(v[k], v[k + 4]), W);
        y[k + 4] = k == 0 ? d : (k == 1 ? make_float2((d.x + d.y) * RS2, (d.y - d.x) * RS2)
                                        : (k == 2 ? c_mni(d) : make_float2((d.y - d.x) * RS2, -(d.x + d.y) * RS2)));
      }
      float2 z[8];
#pragma unroll
      for (int b = 0; b < 8; b += 4) {
        z[b] = c_add(y[b], y[b + 2]);
        z[b + 2] = c_mul(c_sub(y[b], y[b + 2]), W2);
        z[b + 1] = c_add(y[b + 1], y[b + 3]);
        z[b + 3] = c_mni(c_mul(c_sub(y[b + 1], y[b + 3]), W2));
      }
#pragma unroll
      for (int b = 0; b < 8; b += 2) {
        X[i0 + b * q] = c_add(z[b], z[b + 1]);
        X[i0 + (b + 1) * q] = c_mul(c_sub(z[b], z[b + 1]), W4);
      }
    }
    __syncthreads();
  }
  if (s == 1) {
    const int n4 = 1 << (lg - 2);
    for (int j = tidx(); j < n4; j += NTHR) {
      const float2 x0 = X[4 * j], x1 = X[4 * j + 1], x2 = X[4 * j + 2], x3 = X[4 * j + 3];
      const float2 y0 = c_add(x0, x2), y2 = c_sub(x0, x2), y1 = c_add(x1, x3), y3 = c_mni(c_sub(x1, x3));
      X[4 * j] = c_add(y0, y1); X[4 * j + 1] = c_sub(y0, y1); X[4 * j + 2] = c_add(y2, y3); X[4 * j + 3] = c_sub(y2, y3);
    }
    __syncthreads();
  } else if (s == 0) {
    fft_bottom_r2(X, lg);
  }
}
DI void fft_dit_inv(float2* X, int lg) {
  const int n8 = 1 << (lg - 3);
  const int rem = lg % 3;
  int s = 0;
  if (rem == 1) { fft_bottom_r2(X, lg); s = 1; }
  else if (rem == 2) {
    const int n4 = 1 << (lg - 2);
    for (int j = tidx(); j < n4; j += NTHR) {
      const float2 x0 = X[4 * j], x1 = X[4 * j + 1], x2 = X[4 * j + 2], x3 = X[4 * j + 3];
      const float2 y0 = c_add(x0, x1), y1 = c_sub(x0, x1), y2 = c_add(x2, x3), y3 = c_pi(c_sub(x2, x3));
      X[4 * j] = c_add(y0, y2); X[4 * j + 2] = c_sub(y0, y2); X[4 * j + 1] = c_add(y1, y3); X[4 * j + 3] = c_sub(y1, y3);
    }
    __syncthreads();
    s = 2;
  }
  for (; s + 2 < lg; s += 3) {
    const int q = 1 << s;
    const float inv = 1.0f / (float)(8 * q);
    for (int j = tidx(); j < n8; j += NTHR) {
      const int p = j & (q - 1);
      const int i0 = ((j >> s) << (s + 3)) + p;
      float2 o[8];
#pragma unroll
      for (int k = 0; k < 8; ++k) o[k] = X[i0 + k * q];
      const float r = (float)p * inv;
      const float2 W = make_float2(cos_rev(r), sin_rev(r));
      const float2 W2 = make_float2(W.x * W.x - W.y * W.y, 2.f * W.x * W.y);
      const float2 W4 = make_float2(W2.x * W2.x - W2.y * W2.y, 2.f * W2.x * W2.y);
      float2 z[8];
#pragma unroll
      for (int b = 0; b < 8; b += 2) {
        const float2 t = c_mul(o[b + 1], W4);
        z[b] = c_add(o[b], t); z[b + 1] = c_sub(o[b], t);
      }
      float2 y[8];
#pragma unroll
      for (int b = 0; b < 8; b += 4) {
        const float2 t = c_mul(z[b + 2], W2);
        y[b] = c_add(z[b], t); y[b + 2] = c_sub(z[b], t);
        const float2 u = c_pi(c_mul(z[b + 3], W2));
        y[b + 1] = c_add(z[b + 1], u); y[b + 3] = c_sub(z[b + 1], u);
      }
#pragma unroll
      for (int k = 0; k < 4; ++k) {
        const float2 d = c_mul(y[k + 4], W);
        const float2 t = k == 0 ? d : (k == 1 ? make_float2((d.x - d.y) * RS2, (d.x + d.y) * RS2)
                                              : (k == 2 ? c_pi(d) : make_float2(-(d.x + d.y) * RS2, (d.x - d.y) * RS2)));
        X[i0 + k * q] = c_add(y[k], t);
        X[i0 + (k + 4) * q] = c_sub(y[k], t);
      }
    }
    __syncthreads();
  }
}

DI float conv3(const float* z, int t, int Ls, float w0, float w1, float w2, float bias) {
  const float zm = t > 0 ? z[t - 1] : 0.f, zc = z[t], zp = t < Ls - 1 ? z[t + 1] : 0.f;
  return w0 * zm + w1 * zc + w2 * zp + bias;
}

DI void hyena_item(const Params& p, int l, float2* X, int bp, int c, bool lat) {
  const int Ls = lat ? SEQ : CL, lg = lat ? 14 : 9, N = 2 * Ls;
  const float* zb0 = lat ? p.ZT + (size_t)(2 * bp) * 1024 * SEQ : p.ZTc + (size_t)(2 * bp) * 1024 * CL;
  const float* zb1 = zb0 + (size_t)1024 * Ls;
  const float* cw = p.hy_conv_w + (size_t)l * 3 * 768;
  const float* cb = p.hy_conv_b + (size_t)l * 768;
  const float w00 = cw[c], w01 = cw[768 + c], w02 = cw[1536 + c], b0 = cb[c];
  const float w10 = cw[256 + c], w11 = cw[768 + 256 + c], w12 = cw[1536 + 256 + c], b1 = cb[256 + c];
  const float w20 = cw[512 + c], w21 = cw[768 + 512 + c], w22 = cw[1536 + 512 + c], b2 = cb[512 + c];
  const float* x0a = zb0 + (size_t)c * Ls; const float* x1a = zb0 + (size_t)(256 + c) * Ls; const float* va = zb0 + (size_t)(512 + c) * Ls;
  const float* x0b = zb1 + (size_t)c * Ls; const float* x1b = zb1 + (size_t)(256 + c) * Ls; const float* vb = zb1 + (size_t)(512 + c) * Ls;
#pragma unroll 4
  for (int t = tidx(); t < Ls; t += NTHR) {
    const float ua = conv3(x1a, t, Ls, w10, w11, w12, b1) * conv3(va, t, Ls, w20, w21, w22, b2);
    const float ub = conv3(x1b, t, Ls, w10, w11, w12, b1) * conv3(vb, t, Ls, w20, w21, w22, b2);
    X[t] = make_float2(ua, ub);
    X[Ls + t] = make_float2(0.f, 0.f);
  }
  __syncthreads();
  fft_dif(X, lg);
  const float2* Kh = lat ? p.Khat + (size_t)(l * 256 + c) * (2 * SEQ) : p.Khatc + (size_t)(l * 256 + c) * (2 * CL);
#pragma unroll 8
  for (int i = tidx(); i < N; i += NTHR) {
    const float2 a = X[i], k = Kh[i];
    X[i] = make_float2(a.x * k.x - a.y * k.y, a.x * k.y + a.y * k.x);
  }
  __syncthreads();
  fft_dit_inv(X, lg);
  const float invN = 1.f / (float)N, skip = p.hy_skip[l * 256 + c];
  const size_t rba = lat ? (size_t)(2 * bp) * SEQ : (size_t)T + (size_t)(2 * bp) * CL;
  const size_t rbb = rba + Ls;
#pragma unroll 4
  for (int t = tidx(); t < Ls; t += NTHR) {
    const float2 y = X[t];
    const float ua = conv3(x1a, t, Ls, w10, w11, w12, b1) * conv3(va, t, Ls, w20, w21, w22, b2);
    const float ub = conv3(x1b, t, Ls, w10, w11, w12, b1) * conv3(vb, t, Ls, w20, w21, w22, b2);
    const float oa = (y.x * invN + skip * ua) * conv3(x0a, t, Ls, w00, w01, w02, b0);
    const float ob = (y.y * invN + skip * ub) * conv3(x0b, t, Ls, w00, w01, w02, b0);
    p.HO[(rba + t) * HS + 512 + c] = f2bf(oa);
    p.HO[(rbb + t) * HS + 512 + c] = f2bf(ob);
  }
  __syncthreads();
}

DI void fnet_item(const Params& p, float2* X, int b, int g, int m, bool lat) {
  const int Ls = lat ? SEQ : CL, lg = lat ? 13 : 8;
  const float* zb = lat ? p.ZT + (size_t)b * 1024 * SEQ : p.ZTc + (size_t)b * 1024 * CL;
  const float* re = zb + (size_t)(768 + g * 64 + m) * Ls;
  const bool hasim = (m >= 1 && m <= 31);
  const float* im = zb + (size_t)(768 + g * 64 + 32 + (hasim ? m : 0)) * Ls;
#pragma unroll 8
  for (int t = tidx(); t < Ls; t += NTHR) X[t] = make_float2(re[t], hasim ? im[t] : 0.f);
  __syncthreads();
  fft_dif(X, lg);
  const float s = rsqrtf((float)Ls * 64.f);
  const size_t rb = lat ? (size_t)b * SEQ : (size_t)T + (size_t)b * CL;
#pragma unroll 4
  for (int i = tidx(); i < Ls; i += NTHR) {
    const int k = (int)(__brev((unsigned)i) >> (32 - lg));
    const bf16_t v = f2bf(X[i].x * s);
    p.F[(rb + k) * 256 + g * 64 + m] = v;
    if (hasim) p.F[(rb + ((Ls - k) & (Ls - 1))) * 256 + g * 64 + 64 - m] = v;
  }
  __syncthreads();
}

DI void mixers_phase(const Params& p, int l, char* lds) {
  float2* X = (float2*)lds;
  const int xcd = blockIdx.x & 7;
#pragma unroll 1
  for (int it = 0;; ++it) {
    const int loc = xcd_local(it, l == DEPTH - 1 ? 256 : 264);
    if (loc < 0) break;
    int grp, pair, qrow0, qpos0, jfirst, nloc;
    bool window = false;
    if (loc < 256) {
      grp = loc < 128 ? 1 : 0;
      const int q = loc & 127, qb = q & 63;
      pair = 2 * xcd + (q >> 6);
      qpos0 = qb * 128;
      qrow0 = (pair >> 1) * SEQ + qpos0;
      if (grp) { jfirst = 0; nloc = 128; }
      else {
        const int fb = qb > 0 ? qb - 1 : 0, lb = qb < 63 ? qb + 1 : 63;
        jfirst = fb * 128; nloc = (lb - fb + 1) * 2; window = true;
      }
    } else {
      const int q = loc - 256;
      grp = q >> 2;
      pair = 2 * xcd + ((q >> 1) & 1);
      qpos0 = (q & 1) * 128;
      qrow0 = T + (pair >> 1) * CL + qpos0;
      jfirst = 0; nloc = 0;
    }
    if (grp) attn_item<true>(p, l, lds, grp, pair >> 1, pair & 1, qrow0, qpos0, jfirst, nloc, false);
    else attn_item<false>(p, l, lds, grp, pair >> 1, pair & 1, qrow0, qpos0, jfirst, nloc, window);
  }
#pragma unroll 1
  for (int it = 0;; ++it) {
    int loc = xcd_local(it, l == DEPTH - 1 ? 128 : 256);
    if (loc < 0) break;
    loc &= 255;
    hyena_item(p, l, X, (loc >> 5) & 3, xcd * 32 + (loc & 31), loc < 128);
  }
#pragma unroll 1
  for (int it = 0;; ++it) {
    int loc = xcd_local(it, l == DEPTH - 1 ? 132 : 264);
    if (loc < 0) break;
    if (loc >= 264) loc -= 264;
    const int q = loc < 132 ? loc : loc - 132;
    fnet_item(p, X, xcd, q / 33, q % 33, loc < 132);
  }
}

DI void row_pass(const Params& p, int l, int mode) {
  const int lane = tidx() & 63, wave = tidx() >> 6;
  const int nrows = (l == DEPTH - 1 && mode) ? T : MROWS;
  const bool first = (l == 0 && mode <= 1);
  const float* xl = first ? p.x : p.out;
  const float* xc = first ? p.ctx : p.cx;
  int ml = l, sho = 0, sco = 1024;
  if (mode == 1) { sho = 3072; sco = 4096; }
  if (mode == 2) ml = l + 1;
  const bool has_h = ml < DEPTH;
  const int stride = gridDim.x * 8;
  float4 LG[4], LB[4], GT[4], SH[4], SC[4];
#pragma unroll
  for (int j = 0; j < 4; ++j) {
    const int col = lane * 4 + 256 * j;
    LG[j] = mode ? *(const float4*)((mode == 1 ? p.ln1_g : p.ln2_g) + (size_t)l * D + col) : make_float4(0.f, 0.f, 0.f, 0.f);
    LB[j] = mode ? *(const float4*)((mode == 1 ? p.ln1_b : p.ln2_b) + (size_t)l * D + col) : make_float4(0.f, 0.f, 0.f, 0.f);
    GT[j] = SH[j] = SC[j] = make_float4(0.f, 0.f, 0.f, 0.f);
  }
  int mr_cur = -1;
  int r = blockIdx.x * 8 + wave;
  float4 xv[4];
  uint2 yv[4];
#define ROWLOAD(XV, YV, rr)                                                                       \
  {                                                                                               \
    const float* xs_ = (rr) < T ? xl + (size_t)(rr) * D : xc + (size_t)((rr) - T) * D;            \
    _Pragma("unroll") for (int j = 0; j < 4; ++j) { const f32x4 t_ = __builtin_nontemporal_load((const f32x4*)(xs_ + lane * 4 + 256 * j)); XV[j] = make_float4(t_.x, t_.y, t_.z, t_.w); } \
    if (mode) { const bf16_t* yr_ = p.Y + (size_t)(rr) * D;                                       \
      _Pragma("unroll") for (int j = 0; j < 4; ++j) { const u32x2 t_ = __builtin_nontemporal_load((const u32x2*)(yr_ + lane * 4 + 256 * j)); YV[j] = make_uint2(t_.x, t_.y); } } \
  }
  if (r < nrows) ROWLOAD(xv, yv, r);
#pragma unroll 1
  for (; r < nrows; r += stride) {
    float4 xn[4];
    uint2 yn[4];
    const int rn = r + stride;
    if (rn < nrows) ROWLOAD(xn, yn, rn);
    const bool lat = r < T;
    const int mr = lat ? (r >> 13) : 8;
    if (mr != mr_cur) {
      mr_cur = mr;
      const float* md = p.mod + ((size_t)l * 9 + mr) * 6144;
      const float* md2 = p.mod + ((size_t)(has_h ? ml : l) * 9 + mr) * 6144;
#pragma unroll
      for (int j = 0; j < 4; ++j) {
        const int col = lane * 4 + 256 * j;
        if (mode) GT[j] = *(const float4*)(md + (mode == 1 ? 2048 : 5120) + col);
        SH[j] = *(const float4*)(md2 + sho + col);
        SC[j] = *(const float4*)(md2 + sco + col);
      }
    }
    float v[16];
#pragma unroll
    for (int j = 0; j < 4; ++j) { v[4 * j] = xv[j].x; v[4 * j + 1] = xv[j].y; v[4 * j + 2] = xv[j].z; v[4 * j + 3] = xv[j].w; }
    if (mode) {
      float s = 0.f;
#pragma unroll
      for (int j = 0; j < 4; ++j) {
        v[4 * j] = ALPHA * v[4 * j] + GT[j].x * bf2f(yv[j].x & 0xffffu);
        v[4 * j + 1] = ALPHA * v[4 * j + 1] + GT[j].y * bf2f(yv[j].x >> 16);
        v[4 * j + 2] = ALPHA * v[4 * j + 2] + GT[j].z * bf2f(yv[j].y & 0xffffu);
        v[4 * j + 3] = ALPHA * v[4 * j + 3] + GT[j].w * bf2f(yv[j].y >> 16);
        s += v[4 * j] + v[4 * j + 1] + v[4 * j + 2] + v[4 * j + 3];
      }
      const float mu = wave_sum(s) * (1.f / D);
      float q = 0.f;
#pragma unroll
      for (int i = 0; i < 16; ++i) { const float d = v[i] - mu; q += d * d; }
      const float rstd = rsqrtf(wave_sum(q) * (1.f / D) + 1e-6f);
      float* xd = lat ? p.out + (size_t)r * D : p.cx + (size_t)(r - T) * D;
#pragma unroll
      for (int j = 0; j < 4; ++j) {
        const int col = lane * 4 + 256 * j;
        v[4 * j] = (v[4 * j] - mu) * rstd * LG[j].x + LB[j].x;
        v[4 * j + 1] = (v[4 * j + 1] - mu) * rstd * LG[j].y + LB[j].y;
        v[4 * j + 2] = (v[4 * j + 2] - mu) * rstd * LG[j].z + LB[j].z;
        v[4 * j + 3] = (v[4 * j + 3] - mu) * rstd * LG[j].w + LB[j].w;
        *(float4*)(xd + col) = make_float4(v[4 * j], v[4 * j + 1], v[4 * j + 2], v[4 * j + 3]);
      }
    }
    if (has_h) {
      float s = 0.f;
#pragma unroll
      for (int i = 0; i < 16; ++i) s += v[i];
      const float mu = wave_sum(s) * (1.f / D);
      float q = 0.f;
#pragma unroll
      for (int i = 0; i < 16; ++i) { const float d = v[i] - mu; q += d * d; }
      const float rstd = rsqrtf(wave_sum(q) * (1.f / D) + 1e-6f);
      bf16_t* hr = p.HO + (size_t)r * HS;
#pragma unroll
      for (int j = 0; j < 4; ++j) {
        const int col = lane * 4 + 256 * j;
        uint2 w;
        w.x = pack2((v[4 * j] - mu) * rstd * (1.f + SC[j].x) + SH[j].x, (v[4 * j + 1] - mu) * rstd * (1.f + SC[j].y) + SH[j].y);
        w.y = pack2((v[4 * j + 2] - mu) * rstd * (1.f + SC[j].z) + SH[j].z, (v[4 * j + 3] - mu) * rstd * (1.f + SC[j].w) + SH[j].w);
        *(uint2*)(hr + col) = w;
      }
    }
#pragma unroll
    for (int j = 0; j < 4; ++j) { xv[j] = xn[j]; yv[j] = yn[j]; }
  }
#undef ROWLOAD
}

DI void merge_norm_phase(const Params& p, int nrows) {
  const int lane = tidx() & 63, wave = tidx() >> 6;
#pragma unroll 1
  for (int r0 = (blockIdx.x * 8 + wave) * 4; r0 < nrows; r0 += gridDim.x * 32) {
    uint4 a[4], b[4];
#pragma unroll
    for (int k = 0; k < 4; ++k) {
      const int r = r0 + k < nrows ? r0 + k : nrows - 1;
      const bf16_t* hr = p.HO + (size_t)r * HS + lane * 16;
      a[k] = *(const uint4*)hr; b[k] = *(const uint4*)(hr + 8);
    }
#pragma unroll
    for (int k = 0; k < 4; ++k) {
      if (r0 + k >= nrows) break;
      bf16_t* hr = p.HO + (size_t)(r0 + k) * HS + lane * 16;
      unsigned u[8] = {a[k].x, a[k].y, a[k].z, a[k].w, b[k].x, b[k].y, b[k].z, b[k].w};
      float f[16];
      float ss = 0.f;
#pragma unroll
      for (int i = 0; i < 8; ++i) { f[2 * i] = bf2f(u[i] & 0xffffu); f[2 * i + 1] = bf2f(u[i] >> 16); ss += f[2 * i] * f[2 * i] + f[2 * i + 1] * f[2 * i + 1]; }
      ss = row16_sum(ss);
      const float rs = rsqrtf(ss * (1.f / 256.f) + 1e-6f);
#pragma unroll
      for (int i = 0; i < 8; ++i) u[i] = pack2(f[2 * i] * rs, f[2 * i + 1] * rs);
      *(uint4*)hr = make_uint4(u[0], u[1], u[2], u[3]);
      *(uint4*)(hr + 8) = make_uint4(u[4], u[5], u[6], u[7]);
    }
  }
}

DI void conv_tile(float* lds, const float* src, int ldsrc, bf16_t* dst, int ldd, int k0, int n0, const float* rowscale) {
  const int tid = tidx();
#pragma unroll
  for (int i = 0; i < 8; ++i) {
    const int idx = tid + NTHR * i, kk = idx >> 6, nn = idx & 63;
    float v = src[(size_t)(k0 + kk) * ldsrc + n0 + nn];
    if (rowscale) v *= rowscale[k0 + kk];
    lds[kk * 65 + nn] = v;
  }
  __syncthreads();
#pragma unroll
  for (int i = 0; i < 4; ++i) {
    const int pidx = tid + NTHR * i, nn = pidx >> 5, kp = pidx & 31;
    *(unsigned*)(dst + (size_t)(n0 + nn) * ldd + k0 + 2 * kp) = pack2(lds[(2 * kp) * 65 + nn], lds[(2 * kp + 1) * 65 + nn]);
  }
  __syncthreads();
}
DI void fold_tile(float* lds, const float* src, bf16_t* dst, int k0, int g) {
  const int tid = tidx();
  float* cs = lds + 64 * 65;
  float* sn = cs + 64;
#pragma unroll
  for (int i = 0; i < 8; ++i) {
    const int idx = tid + NTHR * i, kk = idx >> 6, nn = idx & 63;
    lds[kk * 65 + nn] = src[(size_t)(k0 + kk) * DP + 1792 + g * 64 + nn];
  }
  if (tid < 64) { cs[tid] = cos_rev((float)tid * (1.f / 64.f)); sn[tid] = sin_rev((float)tid * (1.f / 64.f)); }
  __syncthreads();
#pragma unroll 1
  for (int i = 0; i < 4; ++i) {
    const int pidx = tid + NTHR * i, mp = pidx >> 5, kp = pidx & 31;
    float a0 = 0.f, a1 = 0.f;
    const int mm = mp <= 32 ? mp : mp - 32;
#pragma unroll 4
    for (int j = 0; j < 64; ++j) {
      const int ph = (mm * j) & 63;
      const float cm = mp <= 32 ? cs[ph] : -sn[ph];
      a0 += lds[(2 * kp) * 65 + j] * cm;
      a1 += lds[(2 * kp + 1) * 65 + j] * cm;
    }
    *(unsigned*)(dst + (size_t)(1792 + g * 64 + mp) * HS + k0 + 2 * kp) = pack2(a0, a1);
  }
  __syncthreads();
}
DI void convert_phase(const Params& p, float* lds) {
  constexpr int PER = 2848;
  for (int job = blockIdx.x; job < PER * DEPTH; job += gridDim.x) {
    const int l = job / PER;
    int j = job - l * PER;
    if (j >= 448 && j < 512) {
      j -= 448;
      fold_tile(lds, p.w_in + (size_t)l * D * DP, p.Win + (size_t)l * DP * HS, (j & 15) * 64, j >> 4);
      continue;
    }
    const float* src; bf16_t* dst; int ldsrc, ldd, k0, n0; const float* rs = nullptr;
    if (j < 448) {
      src = p.w_in + (size_t)l * D * DP; ldsrc = DP; dst = p.Win + (size_t)l * DP * HS; ldd = HS; k0 = (j / 28) * 64; n0 = (j % 28) * 64;
    } else if (j < 768) {
      j -= 512;
      src = p.w_out + (size_t)l * D * D; ldsrc = D; dst = p.Wout + (size_t)l * D * HS; ldd = HS; k0 = (j >> 4) * 64; n0 = (j & 15) * 64;
      rs = p.out_norm_g + l * D;
    } else if (j < 2144) {
      j -= 768;
      src = p.ffn_w_up + (size_t)l * D * DFF2; ldsrc = DFF2; dst = p.Wup + (size_t)l * 2 * DFFP * HS; ldd = HS; k0 = (j / 86) * 64; n0 = (j % 86) * 64;
      if (n0 >= DFF) { src += DFF; dst += (size_t)DFFP * HS; n0 -= DFF; ldsrc = DFF2; }
    } else if (j < 2832) {
      j -= 2144;
      src = p.ffn_w_down + (size_t)l * DFF * D; ldsrc = D; dst = p.Wdn + (size_t)l * D * DFFP; ldd = DFFP; k0 = (j >> 4) * 64; n0 = (j & 15) * 64;
    } else {
      j -= 2832;
      src = p.fnet_w + (size_t)l * 256 * 256; ldsrc = 256; dst = p.Wfn + (size_t)l * 256 * 256; ldd = 256; k0 = (j >> 2) * 64; n0 = (j & 3) * 64;
    }
    conv_tile(lds, src, ldsrc, dst, ldd, k0, n0, rs);
  }
}
DI void pad_phase(const Params& p) {
  const int gtid = blockIdx.x * NTHR + tidx(), gn = gridDim.x * NTHR;
  for (int idx = gtid; idx < DEPTH * 2 * 64 * D; idx += gn) {
    const int k = idx & (D - 1), r = (idx >> 10) & 63, h = (idx >> 16) & 1, l = idx >> 17;
    p.Wup[((size_t)l * 2 * DFFP + (size_t)h * DFFP + DFF + r) * HS + k] = 0;
  }
  for (int idx = gtid; idx < DEPTH * D * 64; idx += gn) {
    const int k = idx & 63, r = idx >> 6;
    p.Wdn[(size_t)r * DFFP + DFF + k] = 0;
  }
  for (int idx = gtid; idx < DEPTH * 2 * DFFP; idx += gn) {
    const int c = idx % DFFP, h = (idx / DFFP) & 1, l = idx / (2 * DFFP);
    const bool ok = c < DFF;
    p.bupP[idx] = ok ? p.ffn_b_up[(size_t)l * DFF2 + h * DFF + c] : 0.f;
    p.cbP[idx] = ok ? p.ffn_conv_b[(size_t)l * DFF2 + h * DFF + c] : 0.f;
#pragma unroll
    for (int tap = 0; tap < 3; ++tap)
      p.cwP[(size_t)l * 6 * DFFP + (size_t)(tap * 2 + h) * DFFP + c] = ok ? p.ffn_conv_w[((size_t)l * 3 + tap) * DFF2 + h * DFF + c] : 0.f;
  }
}
DI void mod_phase(const Params& p, float* lds) {
  float* s = lds;
  float* part = lds + 9216;
  const int tid = tidx(), col = tid & 63, ks = tid >> 6;
  for (int item = blockIdx.x; item < DEPTH * 96; item += gridDim.x) {
    const int l = item / 96, n0 = (item % 96) * 64;
    for (int idx = tid; idx < 9 * 1024; idx += NTHR) {
      const int r = idx >> 10, k = idx & 1023;
      s[idx] = siluf(r < 8 ? p.c[r * D + k] : p.c_ctx[k]);
    }
    __syncthreads();
    float acc[9];
#pragma unroll
    for (int r = 0; r < 9; ++r) acc[r] = 0.f;
    const float* w = p.w_ada + (size_t)l * D * 6144 + n0 + col;
    for (int k = ks * 128; k < ks * 128 + 128; ++k) {
      const float wv = w[(size_t)k * 6144];
#pragma unroll
      for (int r = 0; r < 9; ++r) acc[r] += s[r * 1024 + k] * wv;
    }
#pragma unroll
    for (int r = 0; r < 9; ++r) part[(ks * 9 + r) * 64 + col] = acc[r];
    __syncthreads();
    for (int idx = tid; idx < 576; idx += NTHR) {
      const int r = idx >> 6, cc = idx & 63;
      float a = p.b_ada[l * 6144 + n0 + cc];
#pragma unroll
      for (int q = 0; q < 8; ++q) a += part[(q * 9 + r) * 64 + cc];
      p.mod[((size_t)l * 9 + r) * 6144 + n0 + cc] = a;
    }
    __syncthreads();
  }
}
DI void hy_mlp_item(const Params& p, float* lds, int l, int tt, bool lat) {
  const int Ls = lat ? SEQ : CL, t0 = tt * 32, tid = tidx();
  float* feat = lds;
  float* h1 = lds + 544;
  float* h2 = h1 + 2048;
  float* outl = h2 + 2048;
  for (int idx = tid; idx < 32 * 17; idx += NTHR) {
    const int t = idx / 17, f = idx % 17;
    const float tg = (float)(t0 + t);
    float v;
    if (f == 0) v = tg / (float)(Ls - 1);
    else {
      const int jb = (f - 1) & 7;
      const float band = 1e-4f + (float)jb * ((7.f - 1e-4f) / 7.f);
      const float rev = tg * band / (float)Ls;
      v = f <= 8 ? cos_rev(rev) : -sin_rev(rev);
    }
    feat[idx] = v;
  }
  __syncthreads();
  const float* w1 = p.hy_f_w1 + (size_t)l * 17 * 64;
  const float* w2 = p.hy_f_w2 + (size_t)l * 64 * 64;
  const float* w3 = p.hy_f_w3 + (size_t)l * 64 * 512;
#pragma unroll
  for (int i = 0; i < 4; ++i) {
    const int idx = tid + NTHR * i, t = idx >> 6, n = idx & 63;
    float a = p.hy_f_b1[l * 64 + n];
    for (int f = 0; f < 17; ++f) a += feat[t * 17 + f] * w1[f * 64 + n];
    h1[idx] = sin_rev(p.hy_f_freq[l * 64 + n] * a * INV2PI);
  }
  __syncthreads();
#pragma unroll
  for (int i = 0; i < 4; ++i) {
    const int idx = tid + NTHR * i, t = idx >> 6, n = idx & 63;
    float a = p.hy_f_b2[l * 64 + n];
    for (int k = 0; k < 64; ++k) a += h1[t * 64 + k] * w2[k * 64 + n];
    h2[n * 32 + t] = sin_rev(p.hy_f_freq[l * 64 + n] * a * INV2PI);
  }
  __syncthreads();
  {
    const int n = tid, c = n & 255;
    float acc[32];
#pragma unroll
    for (int t = 0; t < 32; ++t) acc[t] = 0.f;
#pragma unroll 2
    for (int k = 0; k < 64; ++k) {
      const float wv = w3[k * 512 + n];
#pragma unroll
      for (int t4 = 0; t4 < 8; ++t4) {
        const float4 hv = *(const float4*)(h2 + k * 32 + t4 * 4);
        acc[4 * t4] += hv.x * wv; acc[4 * t4 + 1] += hv.y * wv; acc[4 * t4 + 2] += hv.z * wv; acc[4 * t4 + 3] += hv.w * wv;
      }
    }
    const float mind = -3.0701134573253946f, maxd = -15.350567286626973f;
    const float delta = fabsf(mind + (maxd - mind) * ((float)c / 255.f));
#pragma unroll
    for (int t = 0; t < 32; ++t) {
      const float tn = (float)(t0 + t) / (float)(Ls - 1);
      outl[n * 33 + t] = acc[t] * __expf(-tn * delta);
    }
  }
  __syncthreads();
  const int N2 = 2 * Ls;
  float* kv = lat ? p.kvec + (size_t)l * 256 * (2 * SEQ) : p.kvecc + (size_t)l * 256 * (2 * CL);
  for (int idx = tid; idx < 512 * 32; idx += NTHR) {
    const int n = idx >> 5, t = idx & 31, c = n & 255, dir = n >> 8, tg = t0 + t;
    float val = outl[n * 33 + t];
    if (dir == 0) {
      if (tg == 0) val += outl[(256 + c) * 33];
      kv[(size_t)c * N2 + tg] = val;
    } else {
      if (tg == 0) kv[(size_t)c * N2 + Ls] = 0.f;
      else kv[(size_t)c * N2 + N2 - tg] = val;
    }
  }
  __syncthreads();
}
DI void khat_item(const Params& p, float2* X, int l, int c, bool lat) {
  const int Ls = lat ? SEQ : CL, lg = lat ? 14 : 9, N = 2 * Ls;
  const float* kv = lat ? p.kvec + (size_t)(l * 256 + c) * N : p.kvecc + (size_t)(l * 256 + c) * N;
  float2* Kh = lat ? p.Khat + (size_t)(l * 256 + c) * N : p.Khatc + (size_t)(l * 256 + c) * N;
#pragma unroll 8
  for (int i = tidx(); i < N; i += NTHR) X[i] = make_float2(kv[i], kv[N + i]);
  __syncthreads();
  fft_dif(X, lg);
#pragma unroll 4
  for (int i = tidx(); i < N; i += NTHR) {
    const int k = (int)(__brev((unsigned)i) >> (32 - lg));
    const int ip = (int)(__brev((unsigned)((N - k) & (N - 1))) >> (32 - lg));
    const float2 z = X[i], w = X[ip];
    Kh[i] = make_float2(0.5f * (z.x + w.x), 0.5f * (z.y - w.y));
    Kh[N + i] = make_float2(0.5f * (z.y + w.y), -0.5f * (z.x - w.x));
  }
  __syncthreads();
}

DI void grid_barrier(unsigned* bar, unsigned n) {
  asm volatile("s_waitcnt vmcnt(0) lgkmcnt(0)" ::: "memory");
  __syncthreads();
  if (threadIdx.x == 0) {
    const unsigned G = gridDim.x;
    __builtin_amdgcn_fence(__ATOMIC_RELEASE, "agent");
    if ((G & 7u) == 0u) {
      const unsigned x = blockIdx.x & 7u, per = G >> 3;
      unsigned* cnt = bar + 64 * (1 + x);
      unsigned* rel = bar + 64 * (9 + x);
      const unsigned old = __hip_atomic_fetch_add(cnt, 1u, __ATOMIC_RELAXED, __HIP_MEMORY_SCOPE_AGENT);
      if (old + 1u == n * per) {
        __hip_atomic_fetch_add(bar, 1u, __ATOMIC_RELAXED, __HIP_MEMORY_SCOPE_AGENT);
        while (__hip_atomic_load(bar, __ATOMIC_RELAXED, __HIP_MEMORY_SCOPE_AGENT) < n * 8u) __builtin_amdgcn_s_sleep(1);
        __hip_atomic_store(rel, n, __ATOMIC_RELAXED, __HIP_MEMORY_SCOPE_AGENT);
      } else {
        while (__hip_atomic_load(rel, __ATOMIC_RELAXED, __HIP_MEMORY_SCOPE_AGENT) < n) __builtin_amdgcn_s_sleep(1);
      }
    } else {
      __hip_atomic_fetch_add(bar, 1u, __ATOMIC_RELAXED, __HIP_MEMORY_SCOPE_AGENT);
      while (__hip_atomic_load(bar, __ATOMIC_RELAXED, __HIP_MEMORY_SCOPE_AGENT) < n * G) __builtin_amdgcn_s_sleep(1);
    }
    __builtin_amdgcn_fence(__ATOMIC_ACQUIRE, "agent");
  }
  __syncthreads();
}

__global__ void __launch_bounds__(NTHR) fwd_megakernel(Params p) {
  extern __shared__ __attribute__((aligned(16))) char lds[];
  cg::grid_group grid = cg::this_grid();
  float* ldsf = (float*)lds;
#pragma unroll 1
  for (int ph2 = 0; ph2 < 2 * (2 + 9 * DEPTH); ++ph2) {
    const int ph = ph2 >> 1;
    int l = 0, kind = ph;
    if (ph >= 2) { l = (ph - 2) / 9; kind = 3 + (ph - 2) % 9; }
    if ((ph2 & 1) && !(l == 0 && ((PROBE_DUP >> kind) & 1))) continue;
    if (kind == 0) {
      convert_phase(p, ldsf);
      pad_phase(p);
      mod_phase(p, ldsf);
#pragma unroll 1
      for (int item = blockIdx.x; item < DEPTH * 264; item += gridDim.x) {
        const int ll = item / 264, r = item % 264;
        hy_mlp_item(p, ldsf, ll, r < 256 ? r : r - 256, r < 256);
      }
    } else if (kind == 1) {
#pragma unroll 1
      for (int item = blockIdx.x; item < 2 * DEPTH * 128; item += gridDim.x)
        khat_item(p, (float2*)lds, (item >> 7) & 3, (item & 127) * 2, item < DEPTH * 128);
    }
    if (kind == 0) {
    } else if (kind == 1 || kind == 8 || kind == 11) {
      row_pass(p, l, kind == 1 ? 0 : (kind == 8 ? 1 : 2));
    } else if (kind == 3) {
      inproj_phase(p, l, lds);
    } else if (kind == 4) {
      mixers_phase(p, l, lds);
    } else if (kind == 6) {
      merge_norm_phase(p, l == DEPTH - 1 ? T : MROWS);
    } else if (kind == 9) {
      ffn_up_phase(p, l, lds);
    } else {
      const bf16_t* A; const bf16_t* Wt; const float* bias; bf16_t* out; int lda, ldw, K, NTn, ocol0;
      if (kind == 5) { A = p.F; lda = 256; Wt = p.Wfn + (size_t)l * 256 * 256; ldw = 256; K = 256; NTn = 1; bias = p.fnet_b + l * 256; out = p.HO; ocol0 = 768; }
      else if (kind == 7) { A = p.HO; lda = HS; Wt = p.Wout + (size_t)l * D * HS; ldw = HS; K = D; NTn = 4; bias = p.b_out + l * D; out = p.Y; ocol0 = 0; }
      else { A = p.ACT; lda = DFFP; Wt = p.Wdn + (size_t)l * D * DFFP; ldw = DFFP; K = DFFP; NTn = 4; bias = p.ffn_b_down + l * D; out = p.Y; ocol0 = 0; }
      gemm_plain_phase(lds, A, lda, Wt, ldw, K, l == DEPTH - 1 ? T / 256 : MROWS / 256, NTn, bias, out, kind == 5 ? HS : D, ocol0);
    }
    if (ph == 0) grid.sync();
    else grid_barrier(p.bar, (unsigned)ph);
  }
}

extern "C" void kernel_launch(void* const* d_in, const int* in_sizes, int n_in, void* d_out, int out_size, void* d_ws,
                              size_t ws_size, hipStream_t stream) {
  Params p{};
  const float** pf = (const float**)&p;
  for (int i = 0; i < 34; ++i) pf[i] = (const float*)d_in[i];
  p.out = (float*)d_out;
  char* w = (char*)d_ws;
  size_t off = 8192;
  p.bar = (unsigned*)d_ws;
  (void)hipMemsetAsync(d_ws, 0, 8192, stream);
  auto take = [&](size_t bytes) { char* r = w + off; off += (bytes + 255) & ~(size_t)255; return r; };
  p.Win = (bf16_t*)take((size_t)DEPTH * DP * HS * 2);
  p.Wout = (bf16_t*)take((size_t)DEPTH * D * HS * 2);
  p.Wup = (bf16_t*)take((size_t)DEPTH * 2 * DFFP * HS * 2);
  p.Wdn = (bf16_t*)take((size_t)DEPTH * D * DFFP * 2);
  p.bupP = (float*)take((size_t)DEPTH * 2 * DFFP * 4);
  p.cwP = (float*)take((size_t)DEPTH * 6 * DFFP * 4);
  p.cbP = (float*)take((size_t)DEPTH * 2 * DFFP * 4);
  p.Wfn = (bf16_t*)take((size_t)DEPTH * 256 * 256 * 2);
  p.mod = (float*)take((size_t)DEPTH * 9 * 6144 * 4);
  p.Khat = (float2*)take((size_t)DEPTH * 256 * 2 * SEQ * 8);
  p.Khatc = (float2*)take((size_t)DEPTH * 256 * 2 * CL * 8);
  p.cx = (float*)take((size_t)TC * D * 4);
  p.HO = (bf16_t*)take((size_t)(MROWS + 256) * HS * 2);
  p.Y = (bf16_t*)take((size_t)MROWS * D * 2);
  const size_t r0 = off;
  p.Zq = (bf16_t*)take((size_t)MROWS * HS * 2);
  p.ZT = (float*)take((size_t)NB * 1024 * SEQ * 4);
  p.ZTc = (float*)take((size_t)NB * 1024 * CL * 4);
  p.VT = (bf16_t*)take((size_t)2 * NB * 2 * 64 * LV * 2);
  p.F = (bf16_t*)take((size_t)MROWS * 256 * 2);
  const size_t r1 = off;
  p.ACT = (bf16_t*)(w + r0);
  p.kvec = (float*)(w + r0);
  p.kvecc = (float*)(w + r0 + (size_t)DEPTH * 256 * 2 * SEQ * 4);
  const size_t act_end = r0 + (size_t)MROWS * DFFP * 2;
  if (act_end > off) off = act_end;
  (void)r1;
  if (off > ws_size) fprintf(stderr, "workspace too small: need %zu have %zu\n", off, ws_size);
  static int grid_blocks = 0;
  if (!grid_blocks) {
    (void)hipFuncSetAttribute((const void*)fwd_megakernel, hipFuncAttributeMaxDynamicSharedMemorySize, (int)LDS_BYTES);
    int dev = 0, cus = 0, per_cu = 0;
    (void)hipGetDevice(&dev);
    (void)hipDeviceGetAttribute(&cus, hipDeviceAttributeMultiprocessorCount, dev);
    (void)hipOccupancyMaxActiveBlocksPerMultiprocessor(&per_cu, fwd_megakernel, NTHR, LDS_BYTES);
    if (per_cu > 1) per_cu = 1;
    grid_blocks = cus * per_cu;
  }
  void* args[] = {&p};
  hipError_t e = hipLaunchCooperativeKernel((void*)fwd_megakernel, dim3(grid_blocks), dim3(NTHR), args, LDS_BYTES, stream);
  if (e != hipSuccess) fprintf(stderr, "cooperative launch failed: %s (grid %d)\n", hipGetErrorString(e), grid_blocks);
}
```

```cpp
#include <hip/hip_runtime.h>
#include <hip/hip_cooperative_groups.h>
#include <stdint.h>
#include <cstdio>
namespace cg = cooperative_groups;

typedef unsigned short bf16_t;
typedef short bf16x8 __attribute__((ext_vector_type(8)));
typedef float f32x4 __attribute__((ext_vector_type(4)));
typedef float f32x16 __attribute__((ext_vector_type(16)));
typedef __bf16 bf2_t __attribute__((ext_vector_type(2)));
typedef float f2_t __attribute__((ext_vector_type(2)));

#define DI __device__ __forceinline__
typedef unsigned u32x2 __attribute__((ext_vector_type(2)));

constexpr int D = 1024, NB = 8, SEQ = 8192, DEPTH = 4, CL = 256;
constexpr int T = NB * SEQ, TC = NB * CL, MROWS = T + TC;
constexpr int DP = 2048, DFF = 2752, DFF2 = 5504, DFFP = 2816;
constexpr int LV = SEQ + CL + 64;
constexpr int HS = 1088;
constexpr int NTHR = 512;
constexpr float ALPHA = 1.681792830507429f;
constexpr float LOG2E = 1.4426950408889634f;
constexpr float INV2PI = 0.15915494309189535f;
constexpr size_t LDS_BYTES = 135168;
#ifndef PROBE_MIX
#define PROBE_MIX 0
#endif
#ifndef PROBE_DUP
#define PROBE_DUP 0x000
#endif

struct Params {
  const float *x, *c, *ctx, *c_ctx, *w_ada, *b_ada, *w_in, *sink_a, *q_norm_g, *k_norm_g,
      *hy_conv_w, *hy_conv_b, *hy_f_w1, *hy_f_b1, *hy_f_freq, *hy_f_w2, *hy_f_b2, *hy_f_w3, *hy_skip,
      *fnet_w, *fnet_b, *out_norm_g, *w_out, *b_out, *ln1_g, *ln1_b, *ffn_w_up, *ffn_b_up, *ffn_conv_w, *ffn_conv_b,
      *ffn_w_down, *ffn_b_down, *ln2_g, *ln2_b;
  float* out;
  bf16_t *Win, *Wout, *Wup, *Wdn, *Wfn;
  float* mod;
  float2 *Khat, *Khatc;
  float* cx;
  bf16_t *HO, *Y, *Zq;
  float *ZT, *ZTc;
  bf16_t *VT, *F;
  float *kvec, *kvecc;
  bf16_t* ACT;
  float *bupP, *cwP, *cbP;
  unsigned* bar;
};

DI int tidx() { int t = threadIdx.x; asm volatile("" : "+v"(t)); return t; }
DI unsigned pack2(float a, float b) {
  f2_t v = {a, b};
  bf2_t r = __builtin_convertvector(v, bf2_t);
  return __builtin_bit_cast(unsigned, r);
}
DI bf16_t f2bf(float a) { return (bf16_t)(pack2(a, 0.f) & 0xffffu); }
DI float bf2f(unsigned h) { return __uint_as_float(h << 16); }
DI float sin_rev(float r) { return __builtin_amdgcn_sinf(r); }
DI float cos_rev(float r) { return __builtin_amdgcn_cosf(r); }
#define dpp_f(v, ctrl, row_mask) __builtin_bit_cast(float, __builtin_amdgcn_update_dpp(0, __builtin_bit_cast(int, (float)(v)), (ctrl), (row_mask), 0xf, false))
DI float row16_sum(float v) {
  v += dpp_f(v, 0xB1, 0xf);
  v += dpp_f(v, 0x4E, 0xf);
  v += dpp_f(v, 0x141, 0xf);
  v += dpp_f(v, 0x140, 0xf);
  return v;
}
DI float wave_sum(float v) {
  v = row16_sum(v);
  v += dpp_f(v, 0x142, 0xa);
  v += dpp_f(v, 0x143, 0xc);
  return __builtin_bit_cast(float, __builtin_amdgcn_readlane(__builtin_bit_cast(int, v), 63));
}
DI float siluf(float x) { return x * __builtin_amdgcn_rcpf(1.f + __builtin_amdgcn_exp2f(-1.4426950408889634f * x)); }

DI int grid8() { return (int)(gridDim.x & ~7u); }
DI int xcd_local(int it, int per_xcd) {
  const int G8 = grid8();
  if ((int)blockIdx.x >= G8) return -1;
  const int loc = it * (G8 >> 3) + ((int)blockIdx.x >> 3);
  return loc < per_xcd ? loc : -1;
}
DI bool tile_map(int it, int MT, int NTn, int& mt, int& nt) {
  const int G8 = grid8();
  if ((int)blockIdx.x >= G8) return false;
  const int xcd = blockIdx.x & 7, slot = blockIdx.x >> 3, SL = G8 >> 3;
  const int MTx = (MT - xcd + 7) >> 3;
  const int q = it * SL + slot;
  if (q >= MTx * NTn) return false;
  const int gm = q / (4 * NTn), rem = q - gm * 4 * NTn;
  int gsz = MTx - 4 * gm;
  if (gsz > 4) gsz = 4;
  nt = rem / gsz;
  mt = xcd + 8 * (gm * 4 + rem % gsz);
  return true;
}

typedef __attribute__((address_space(3))) unsigned char lds_uc;
constexpr int HTB = 16384;
DI int lds_byte(int r, int c) {
  const int st = (r >> 4) * 2 + (c >> 5), rr = r & 15, cc = c & 31, ob = rr * 64 + cc * 2;
  return st * 1024 + (ob ^ (((ob >> 9) & 1) << 5));
}
DI void stage_rc(int b, int& R, int& C) {
  const int st = b >> 10, sb = b & 1023, swz = sb ^ (((sb >> 9) & 1) << 5);
  R = (st >> 1) * 16 + (swz >> 6);
  C = (st & 1) * 32 + ((swz & 63) >> 1);
}
struct PgUnit { const char* A; const char* B; int mt, nt; };
struct PgDesc { size_t a_h, b_h; int nk; unsigned voffA, voffB; size_t dA, dB; };
#define PG_WAIT_V(n) asm volatile("s_waitcnt vmcnt(" #n ")" ::: "memory")
#define PG_WAIT_L(n) asm volatile("s_waitcnt lgkmcnt(" #n ")" ::: "memory")
#define PG_BAR __builtin_amdgcn_s_barrier()
#define PG_SCHED __builtin_amdgcn_sched_barrier(0)

template <class Src, class Epi>
DI void pgemm(char* lds_, const PgDesc& d, const Src& src, const Epi& epi) {
  lds_uc* lds = (lds_uc*)lds_;
  const int tid = tidx(), wid = __builtin_amdgcn_readfirstlane(tid >> 6), lane = tid & 63, wr = wid >> 2, wc = wid & 3, fr = lane & 15, fq = lane >> 4;
  const int nt = d.nk;
  const size_t kstep = 128, ah = d.a_h, bh = d.b_h, voffA_d = d.dA, voffB_d = d.dB;
  const unsigned voffA = d.voffA, voffB = d.voffB;
  const unsigned ldsw = (unsigned)wid * 1024u;
  const int aoff = lds_byte(wr * 64 + fr, fq * 8), boff = lds_byte(wc * 32 + fr, fq * 8);
#define PG_SA(b, h) (((b) * 2 + (h)) * HTB)
#define PG_SB(b, h) ((4 + (b) * 2 + (h)) * HTB)
#define PG_STAGE(bufoff, gbase, voff) do { _Pragma("unroll") for (int _i = 0; _i < 2; ++_i) \
    __builtin_amdgcn_global_load_lds((const unsigned*)((const char*)(gbase) + (size_t)_i * voff##_d + voff), (__attribute__((address_space(3))) unsigned*)(lds + (bufoff) + ldsw + _i * 8192), 16, 0, 0); } while (0)
#define PG_LDA(dst, b, h) do { _Pragma("unroll") for (int m = 0; m < 4; ++m) _Pragma("unroll") for (int k = 0; k < 2; ++k) dst[m][k] = *(const __attribute__((address_space(3))) bf16x8*)(lds + PG_SA(b, h) + aoff + m * 2048 + k * 1024); } while (0)
#define PG_LDB(dst, b, h) do { _Pragma("unroll") for (int n = 0; n < 2; ++n) _Pragma("unroll") for (int k = 0; k < 2; ++k) dst[n][k] = *(const __attribute__((address_space(3))) bf16x8*)(lds + PG_SB(b, h) + boff + n * 2048 + k * 1024); } while (0)
#define PG_MMA(ai, bj, At, Bt) do { __builtin_amdgcn_s_setprio(1); _Pragma("unroll") for (int m = 0; m < 4; ++m) _Pragma("unroll") for (int n = 0; n < 2; ++n) _Pragma("unroll") for (int k = 0; k < 2; ++k) \
    acc[ai][bj][m][n] = __builtin_amdgcn_mfma_f32_16x16x32_bf16(Bt[n][k], At[m][k], acc[ai][bj][m][n], 0, 0, 0); __builtin_amdgcn_s_setprio(0); } while (0)
  PgUnit cur, nxt;
  int ui = 0;
  if (!src.next(0, cur)) return;
  f32x4 acc[2][2][4][2];
#pragma unroll
  for (int a = 0; a < 2; ++a)
#pragma unroll
    for (int b = 0; b < 2; ++b)
#pragma unroll
      for (int m = 0; m < 4; ++m)
#pragma unroll
        for (int n = 0; n < 2; ++n) acc[a][b][m][n] = (f32x4){0.f, 0.f, 0.f, 0.f};
  bf16x8 At[4][2], B0[2][2], B1[2][2];
  const char* cA = cur.A;
  const char* cB = cur.B;
  PG_WAIT_V(0);
  PG_STAGE(PG_SB(0, 0), cB, voffB); PG_STAGE(PG_SA(0, 0), cA, voffA); PG_STAGE(PG_SB(0, 1), cB + bh, voffB); PG_STAGE(PG_SA(0, 1), cA + ah, voffA);
  if (wr == 1) PG_BAR;
  PG_WAIT_V(4); PG_BAR;
  PG_STAGE(PG_SB(1, 0), cB + kstep, voffB); PG_STAGE(PG_SA(1, 0), cA + kstep, voffA); PG_STAGE(PG_SB(1, 1), cB + bh + kstep, voffB);
  PG_WAIT_V(6); PG_BAR;
  for (;;) {
    const bool has_next = src.next(ui + 1, nxt);
    const char* nA = has_next ? nxt.A : cA;
    const char* nB = has_next ? nxt.B : cB;
    for (int t = 0; t < nt; t += 2) {
      const bool last = (t == nt - 2);
      const char* a1 = cA + (size_t)(t + 1) * kstep;
      const char* a2 = last ? nA : cA + (size_t)(t + 2) * kstep;
      const char* b2 = last ? nB : cB + (size_t)(t + 2) * kstep;
      const char* a3 = a2 + kstep;
      const char* b3 = b2 + kstep;
      PG_LDB(B0, 0, 0); PG_SCHED; PG_LDA(At, 0, 0); PG_STAGE(PG_SA(1, 1), a1 + ah, voffA);
      PG_WAIT_L(8); PG_BAR; PG_WAIT_L(0); PG_MMA(0, 0, At, B0); PG_BAR; PG_SCHED;
      PG_LDB(B1, 0, 1); PG_STAGE(PG_SB(0, 0), b2, voffB);
      PG_BAR; PG_WAIT_L(0); PG_MMA(0, 1, At, B1); PG_BAR;
      PG_LDA(At, 0, 1); PG_STAGE(PG_SA(0, 0), a2, voffA);
      PG_BAR; PG_WAIT_L(0); PG_MMA(1, 0, At, B0); PG_BAR; PG_SCHED;
      PG_STAGE(PG_SB(0, 1), b2 + bh, voffB);
      PG_WAIT_V(6); PG_BAR; PG_MMA(1, 1, At, B1); PG_BAR;
      PG_LDB(B0, 1, 0); PG_SCHED; PG_LDA(At, 1, 0); PG_STAGE(PG_SA(0, 1), a2 + ah, voffA);
      PG_WAIT_L(8); PG_BAR; PG_WAIT_L(0); PG_MMA(0, 0, At, B0); PG_BAR; PG_SCHED;
      PG_LDB(B1, 1, 1); PG_STAGE(PG_SB(1, 0), b3, voffB);
      PG_BAR; PG_WAIT_L(0); PG_MMA(0, 1, At, B1); PG_BAR;
      PG_LDA(At, 1, 1); PG_STAGE(PG_SA(1, 0), a3, voffA);
      PG_BAR; PG_WAIT_L(0); PG_MMA(1, 0, At, B0); PG_BAR; PG_SCHED;
      PG_STAGE(PG_SB(1, 1), b3 + bh, voffB);
      PG_WAIT_V(6); PG_BAR; PG_MMA(1, 1, At, B1); PG_BAR;
    }
    epi(acc, cur, wr, wc, fr, fq);
    if (!has_next) break;
#pragma unroll
    for (int a = 0; a < 2; ++a)
#pragma unroll
      for (int b = 0; b < 2; ++b)
#pragma unroll
        for (int m = 0; m < 4; ++m)
#pragma unroll
          for (int n = 0; n < 2; ++n) acc[a][b][m][n] = (f32x4){0.f, 0.f, 0.f, 0.f};
    cur = nxt; cA = nA; cB = nB; ++ui;
  }
  PG_WAIT_V(0);
  if (wr == 0) PG_BAR;
  PG_BAR;
#undef PG_SA
#undef PG_SB
#undef PG_STAGE
#undef PG_LDA
#undef PG_LDB
#undef PG_MMA
}

struct PlainSrc {
  const bf16_t* A; const bf16_t* Wt; int lda, ldw, MT, NTn;
  DI bool next(int i, PgUnit& u) const {
    if (!tile_map(i, MT, NTn, u.mt, u.nt)) return false;
    u.A = (const char*)(A + (size_t)u.mt * 256 * lda);
    u.B = (const char*)(Wt + (size_t)u.nt * 256 * ldw);
    return true;
  }
};
struct PlainEpi {
  const float* bias; bf16_t* out; int ldo, ocol0;
  DI void operator()(f32x4 (&acc)[2][2][4][2], const PgUnit& u, int wr, int wc, int fr, int fq) const {
    asm volatile("" : "+v"(fr), "+v"(fq));
#pragma unroll
    for (int bj = 0; bj < 2; ++bj)
#pragma unroll
      for (int n = 0; n < 2; ++n) {
        const int col = u.nt * 256 + bj * 128 + wc * 32 + n * 16 + fq * 4;
        const float4 bv = *(const float4*)(bias + col);
#pragma unroll
        for (int ai = 0; ai < 2; ++ai)
#pragma unroll
          for (int m = 0; m < 4; ++m) {
            const int row = u.mt * 256 + ai * 128 + wr * 64 + m * 16 + fr;
            uint2 w;
            w.x = pack2(acc[ai][bj][m][n][0] + bv.x, acc[ai][bj][m][n][1] + bv.y);
            w.y = pack2(acc[ai][bj][m][n][2] + bv.z, acc[ai][bj][m][n][3] + bv.w);
            *(uint2*)(out + (size_t)row * ldo + ocol0 + col) = w;
          }
      }
  }
};
DI void gemm_plain_phase(char* lds, const bf16_t* A, int lda, const bf16_t* Wt, int ldw, int K, int MT, int NTn, const float* bias,
                         bf16_t* out, int ldo, int ocol0) {
  PgDesc d;
  d.a_h = (size_t)128 * lda * 2; d.b_h = (size_t)128 * ldw * 2; d.nk = K / 64;
  {
    int R, C;
    stage_rc(tidx() * 16, R, C);
    d.voffA = (unsigned)(R * lda + C) * 2u; d.dA = (size_t)64 * lda * 2;
    d.voffB = (unsigned)(R * ldw + C) * 2u; d.dB = (size_t)64 * ldw * 2;
  }
  PlainSrc src{A, Wt, lda, ldw, MT, NTn};
  PlainEpi epi{bias, out, ldo, ocol0};
  pgemm(lds, d, src, epi);
}

struct InprojSrc {
  const bf16_t* A; const bf16_t* Wt;
  DI bool next(int i, PgUnit& u) const {
    if (!tile_map(i, MROWS / 256, DP / 256, u.mt, u.nt)) return false;
    u.A = (const char*)(A + (size_t)u.mt * 256 * HS);
    u.B = (const char*)(Wt + (size_t)u.nt * 256 * HS);
    return true;
  }
};
struct InprojEpi {
  const Params* pp; int l;
  DI void operator()(f32x4 (&acc)[2][2][4][2], const PgUnit& u, int wr, int wc, int fr, int fq) const {
    asm volatile("" : "+v"(fr), "+v"(fq));
    const Params& p = *pp;
    const int mt = u.mt, hs = u.nt * 4 + wc;
    const bool isctx = mt >= 256;
    int b, t0;
    if (!isctx) { const int row0 = mt * 256; b = row0 >> 13; t0 = row0 & (SEQ - 1); }
    else { b = mt - 256; t0 = 0; }
    const int rb = wr * 64 + fr;
    if (hs < 6 || (hs >= 8 && hs < 14)) {
      const bool isB = hs >= 8;
      const int hh = isB ? hs - 8 : hs;
      const bool isq = hh < 4;
      if (isB) {
        const float* gp = (isq ? p.q_norm_g : p.k_norm_g) + l * 64 + fq * 4;
        const float4 g00 = *(const float4*)(gp), g01 = *(const float4*)(gp + 16), g10 = *(const float4*)(gp + 32), g11 = *(const float4*)(gp + 48);
#pragma unroll
        for (int ai = 0; ai < 2; ++ai)
#pragma unroll
          for (int m = 0; m < 4; ++m) {
            float ss = 0.f;
#pragma unroll
            for (int bj = 0; bj < 2; ++bj)
#pragma unroll
              for (int n = 0; n < 2; ++n)
#pragma unroll
                for (int j = 0; j < 4; ++j) ss += acc[ai][bj][m][n][j] * acc[ai][bj][m][n][j];
            ss += __shfl_xor(ss, 16, 64); ss += __shfl_xor(ss, 32, 64);
            const float r = rsqrtf(ss * (1.f / 64.f) + 1e-6f);
            acc[ai][0][m][0] *= (f32x4){g00.x * r, g00.y * r, g00.z * r, g00.w * r};
            acc[ai][0][m][1] *= (f32x4){g01.x * r, g01.y * r, g01.z * r, g01.w * r};
            acc[ai][1][m][0] *= (f32x4){g10.x * r, g10.y * r, g10.z * r, g10.w * r};
            acc[ai][1][m][1] *= (f32x4){g11.x * r, g11.y * r, g11.z * r, g11.w * r};
            __builtin_amdgcn_sched_barrier(0);
          }
      }
      if (!isctx) {
        float inv[4];
#pragma unroll
        for (int j = 0; j < 4; ++j) inv[j] = exp2f(-(float)(fq * 4 + j) * (13.287712379549449f / 16.f)) * INV2PI;
#pragma unroll
        for (int ai = 0; ai < 2; ++ai)
#pragma unroll
          for (int m = 0; m < 4; ++m) {
            const int t = t0 + ai * 128 + rb + m * 16;
            const float p0 = (float)(t >> 6), p1 = (float)(t & 63);
#pragma unroll
            for (int j = 0; j < 4; ++j) {
              const float a0 = p0 * inv[j], a1 = p1 * inv[j];
              const float c0 = cos_rev(a0), s0 = sin_rev(a0), c1 = cos_rev(a1), s1 = sin_rev(a1);
              const float x1 = acc[ai][0][m][0][j], x2 = acc[ai][0][m][1][j], y1 = acc[ai][1][m][0][j], y2 = acc[ai][1][m][1][j];
              acc[ai][0][m][0][j] = x1 * c0 - x2 * s0; acc[ai][0][m][1][j] = x2 * c0 + x1 * s0;
              acc[ai][1][m][0][j] = y1 * c1 - y2 * s1; acc[ai][1][m][1][j] = y2 * c1 + y1 * s1;
            }
            __builtin_amdgcn_sched_barrier(0);
          }
      }
      const float sc = isq ? 0.125f * LOG2E : 1.f;
#pragma unroll
      for (int ai = 0; ai < 2; ++ai)
#pragma unroll
        for (int m = 0; m < 4; ++m) {
          bf16_t* zr = p.Zq + (size_t)(mt * 256 + ai * 128 + rb + m * 16) * HS + hs * 64 + fq * 4;
#pragma unroll
          for (int bj = 0; bj < 2; ++bj)
#pragma unroll
            for (int n = 0; n < 2; ++n) {
              uint2 w;
              w.x = pack2(acc[ai][bj][m][n][0] * sc, acc[ai][bj][m][n][1] * sc);
              w.y = pack2(acc[ai][bj][m][n][2] * sc, acc[ai][bj][m][n][3] * sc);
              *(uint2*)(zr + bj * 32 + n * 16) = w;
            }
        }
    } else if (hs < 16) {
      const int grp = hs >= 14 ? 1 : 0, kvh = hs & 1;
      bf16_t* vb = p.VT + (size_t)((grp * 8 + b) * 2 + kvh) * 64 * LV + (isctx ? SEQ : 0) + t0 + rb;
#pragma unroll
      for (int bj = 0; bj < 2; ++bj)
#pragma unroll
        for (int n = 0; n < 2; ++n)
#pragma unroll
          for (int j = 0; j < 4; ++j) {
            bf16_t* vd = vb + (size_t)(bj * 32 + n * 16 + fq * 4 + j) * LV;
#pragma unroll
            for (int ai = 0; ai < 2; ++ai)
#pragma unroll
              for (int m = 0; m < 4; ++m) vd[ai * 128 + m * 16] = f2bf(acc[ai][bj][m][n][j]);
          }
    } else {
      const int colb = hs * 64 - 1024;
      const int Ls = isctx ? CL : SEQ;
      float* zb = (isctx ? p.ZTc + (size_t)b * 1024 * CL : p.ZT + (size_t)b * 1024 * SEQ) + t0 + rb;
#pragma unroll
      for (int bj = 0; bj < 2; ++bj)
#pragma unroll
        for (int n = 0; n < 2; ++n)
#pragma unroll
          for (int j = 0; j < 4; ++j) {
            float* zd = zb + (size_t)(colb + bj * 32 + n * 16 + fq * 4 + j) * Ls;
#pragma unroll
            for (int ai = 0; ai < 2; ++ai)
#pragma unroll
              for (int m = 0; m < 4; ++m) zd[ai * 128 + m * 16] = acc[ai][bj][m][n][j];
          }
    }
  }
};
DI void inproj_phase(const Params& p, int l, char* lds) {
  PgDesc d;
  d.a_h = (size_t)128 * HS * 2; d.b_h = (size_t)32 * HS * 2; d.nk = D / 64;
  {
    int R, C;
    stage_rc(tidx() * 16, R, C);
    d.voffA = (unsigned)(R * HS + C) * 2u; d.dA = (size_t)64 * HS * 2;
    d.voffB = (unsigned)(((R >> 5) * 64 + (R & 31)) * HS + C) * 2u; d.dB = (size_t)128 * HS * 2;
  }
  InprojSrc src{p.HO, p.Win + (size_t)l * DP * HS};
  InprojEpi epi{&p, l};
  pgemm(lds, d, src, epi);
}

DI float dpp_ror1(float v) { return __builtin_bit_cast(float, __builtin_amdgcn_update_dpp(0, __builtin_bit_cast(int, v), 0x121, 0xf, 0xf, false)); }
DI float dpp_rol1(float v) { return __builtin_bit_cast(float, __builtin_amdgcn_update_dpp(0, __builtin_bit_cast(int, v), 0x12f, 0xf, 0xf, false)); }
DI float row_prev(float prevreg, float cur) {
  return __builtin_bit_cast(float, __builtin_amdgcn_update_dpp(__builtin_bit_cast(int, dpp_ror1(prevreg)), __builtin_bit_cast(int, cur), 0x111, 0xf, 0xf, false));
}
DI float row_next(float nextreg, float cur) {
  return __builtin_bit_cast(float, __builtin_amdgcn_update_dpp(__builtin_bit_cast(int, dpp_rol1(nextreg)), __builtin_bit_cast(int, cur), 0x101, 0xf, 0xf, false));
}
constexpr int FUP_MT = 8 * 33 + 8 * 2, FUP_NT = DFFP / 128;
DI void ffn_tile(int mt, int& Ls, int& rowbase, int& ti) {
  if (mt < 264) { const int b = mt / 33; ti = mt - b * 33; Ls = SEQ; rowbase = b * SEQ; }
  else { const int q = mt - 264; const int b = q >> 1; ti = q & 1; Ls = CL; rowbase = T + b * CL; }
}
struct FfnUpSrc {
  const bf16_t* A; const bf16_t* Wt; int MT;
  DI bool next(int i, PgUnit& u) const {
    if (!tile_map(i, MT, FUP_NT, u.mt, u.nt)) return false;
    int Ls, rowbase, ti;
    ffn_tile(u.mt, Ls, rowbase, ti);
    u.A = (const char*)(A + ((long)rowbase + 252 * ti - 1) * HS);
    u.B = (const char*)(Wt + (size_t)u.nt * 128 * HS);
    return true;
  }
};
struct FfnUpEpi {
  const float *bup, *cw, *cb; bf16_t* act;
  DI void operator()(f32x4 (&acc)[2][2][4][2], const PgUnit& u, int wr, int wc, int fr, int fq) const {
    asm volatile("" : "+v"(fr), "+v"(fq));
    int Ls, rowbase, ti;
    ffn_tile(u.mt, Ls, rowbase, ti);
    const int tw = 252 * ti - 1 + 126 * wr;
    bf16_t* ob = act + (size_t)rowbase * DFFP;
#pragma unroll
    for (int n = 0; n < 2; ++n)
#pragma unroll
      for (int jp = 0; jp < 2; ++jp) {
        int col = u.nt * 128 + wc * 32 + n * 16 + fq * 4 + jp * 2;
        asm volatile("" : "+v"(col) :: "memory");
        float oo[8][2];
#pragma unroll
        for (int jj = 0; jj < 2; ++jj) {
          const int j = jp * 2 + jj, c = col + jj;
          {
            const float bu = bup[c], w0 = cw[c], w1 = cw[2 * DFFP + c], w2 = cw[4 * DFFP + c], bb = cb[c];
            float ua[8];
#pragma unroll
            for (int q = 0; q < 8; ++q) {
              const int t = tw + fr * 8 + q;
              ua[q] = (t >= 0 && t < Ls) ? acc[q >> 2][0][q & 3][n][j] + bu : 0.f;
            }
            const float upl = __builtin_bit_cast(float, __builtin_amdgcn_update_dpp(0, __builtin_bit_cast(int, ua[7]), 0x111, 0xf, 0xf, false));
            const float dnl = __builtin_bit_cast(float, __builtin_amdgcn_update_dpp(0, __builtin_bit_cast(int, ua[0]), 0x101, 0xf, 0xf, false));
#pragma unroll
            for (int q = 0; q < 8; ++q) {
              const float up = q > 0 ? ua[q > 0 ? q - 1 : 0] : upl;
              const float dn = q < 7 ? ua[q < 7 ? q + 1 : 7] : dnl;
              oo[q][jj] = siluf(w0 * up + w1 * ua[q] + w2 * dn + bb);
            }
          }
          {
            const float bu = bup[DFFP + c], w0 = cw[DFFP + c], w1 = cw[3 * DFFP + c], w2 = cw[5 * DFFP + c], bb = cb[DFFP + c];
            float ug[8];
#pragma unroll
            for (int q = 0; q < 8; ++q) {
              const int t = tw + fr * 8 + q;
              ug[q] = (t >= 0 && t < Ls) ? acc[q >> 2][1][q & 3][n][j] + bu : 0.f;
            }
            const float upl = __builtin_bit_cast(float, __builtin_amdgcn_update_dpp(0, __builtin_bit_cast(int, ug[7]), 0x111, 0xf, 0xf, false));
            const float dnl = __builtin_bit_cast(float, __builtin_amdgcn_update_dpp(0, __builtin_bit_cast(int, ug[0]), 0x101, 0xf, 0xf, false));
#pragma unroll
            for (int q = 0; q < 8; ++q) {
              const float up = q > 0 ? ug[q > 0 ? q - 1 : 0] : upl;
              const float dn = q < 7 ? ug[q < 7 ? q + 1 : 7] : dnl;
              oo[q][jj] *= (w0 * up + w1 * ug[q] + w2 * dn + bb);
            }
          }
        }
#pragma unroll
        for (int q = 0; q < 8; ++q) {
          const int lr = fr * 8 + q;
          const int t = tw + lr;
          if (lr >= 1 && lr <= 126 && t < Ls) *(unsigned*)(ob + (size_t)t * DFFP + col) = pack2(oo[q][0], oo[q][1]);
        }
        __builtin_amdgcn_sched_barrier(0);
      }
  }
};
DI void ffn_up_phase(const Params& p, int l, char* lds) {
  PgDesc d;
  d.a_h = (size_t)4 * HS * 2; d.b_h = (size_t)DFFP * HS * 2; d.nk = D / 64;
  {
    int R, C;
    stage_rc(tidx() * 16, R, C);
    d.voffA = (unsigned)(((R & 15) * 8 + (R >> 4)) * HS + C) * 2u; d.dA = (size_t)126 * HS * 2;
    d.voffB = (unsigned)(R * HS + C) * 2u; d.dB = (size_t)64 * HS * 2;
  }
  FfnUpSrc src{p.HO, p.Wup + (size_t)l * 2 * DFFP * HS, l == DEPTH - 1 ? 264 : FUP_MT};
  FfnUpEpi epi{p.bupP + (size_t)l * 2 * DFFP, p.cwP + (size_t)l * 6 * DFFP, p.cbP + (size_t)l * 2 * DFFP, p.ACT};
  pgemm(lds, d, src, epi);
}

DI int crow(int i, int h) { return (i & 3) + 8 * (i >> 2) + 4 * h; }
template <bool FIXED>
DI void attn_item(const Params& p, int l, char* lds, int grp, int b, int kvh, int qrow0, int qpos0, int jfirst, int nloc,
                  bool window) {
  const int tid = tidx(), lane = tid & 63, wave = tid >> 6, g = wave >> 2, qw = wave & 3;
  const int q31 = lane & 31, h = lane >> 5;
  const int head = kvh * 2 + g;
  const int qcol = (grp ? 512 : 0) + head * 64, kcol = (grp ? 768 : 256) + kvh * 64;
  const bf16_t* Zq = p.Zq;
  bf16x8 qf[4];
  {
    const bf16_t* qp = Zq + (size_t)(qrow0 + qw * 32 + q31) * HS + qcol + h * 8;
#pragma unroll
    for (int kk = 0; kk < 4; ++kk) qf[kk] = *(const bf16x8*)(qp + kk * 16);
  }
  const bf16_t* vt = p.VT + (size_t)((grp * 8 + b) * 2 + kvh) * 64 * LV;
  float m_run, l_run;
  if (grp == 0) { m_run = p.sink_a[l * 4 + head] * LOG2E; l_run = 1.f; }
  else { m_run = -1e30f; l_run = 0.f; }
  if (FIXED) {
    float gq = fabsf(p.q_norm_g[l * 64 + lane]), gk = fabsf(p.k_norm_g[l * 64 + lane]);
#pragma unroll
    for (int m = 32; m >= 1; m >>= 1) { gq = fmaxf(gq, __shfl_xor(gq, m, 64)); gk = fmaxf(gk, __shfl_xor(gk, m, 64)); }
    m_run = 8.f * LOG2E * gq * gk * 1.001f + 0.01f;
  }
  f32x16 O0, O1;
#pragma unroll
  for (int i = 0; i < 16; ++i) { O0[i] = 0.f; O1[i] = 0.f; }
  const int ntiles = nloc + 4;
  const int srow = tid >> 3, sch = tid & 7;
  char* Kl = lds;
  char* Vl = lds + 4 * 9216;
  uint4 rkA, rvA, rkB, rvB;
#define TILEJ(ti) ((ti) < nloc ? jfirst + (ti) * 64 : SEQ + ((ti) - nloc) * 64)
#define AGLOAD(rk, rv, ti)                                                                                 \
  {                                                                                                        \
    const int j_ = TILEJ(ti);                                                                              \
    const int key_ = j_ + srow;                                                                            \
    const size_t krow_ = key_ < SEQ ? (size_t)b * SEQ + key_ : (size_t)T + (size_t)b * CL + (key_ - SEQ);  \
    rk = *(const uint4*)(Zq + krow_ * HS + kcol + sch * 8);                                                \
    rv = *(const uint4*)(vt + (size_t)srow * LV + j_ + sch * 8);                                           \
  }
#define ASWRITE(rk, rv, slot)                                                                              \
  {                                                                                                        \
    *(uint4*)(Kl + (slot) * 9216 + srow * 144 + sch * 16) = rk;                                            \
    uint2* vp_ = (uint2*)(Vl + (slot) * 8704 + srow * 136 + sch * 16);                                     \
    vp_[0] = make_uint2(rv.x, rv.y);                                                                       \
    vp_[1] = make_uint2(rv.z, rv.w);                                                                       \
  }
  AGLOAD(rkA, rvA, 0);
  AGLOAD(rkB, rvB, 1);
  ASWRITE(rkA, rvA, 0);
  ASWRITE(rkB, rvB, 1);
  __syncthreads();
  const int qpos = qpos0 + qw * 32 + q31;
  int s0 = 0;
#pragma unroll 1
  for (int ti = 0; ti < ntiles; ti += 2) {
    const int s1 = s0 + 1, s2 = 2 - s0;
    if (ti + 2 < ntiles) { AGLOAD(rkA, rvA, ti + 2); AGLOAD(rkB, rvB, ti + 3); }
    {
      const int tcur = ti;
      const char* kb = Kl + s0 * 9216;
      const char* vb = Vl + s0 * 8704;
    f32x16 S0, S1;
    const float sinit = FIXED ? -m_run : 0.f;
#pragma unroll
    for (int i = 0; i < 16; ++i) { S0[i] = sinit; S1[i] = sinit; }
    bf16x8 kf[8];
    union { uint2 u[2]; bf16x8 v; } vfr[8];
#pragma unroll
    for (int kk = 0; kk < 4; ++kk) {
      kf[2 * kk] = *(const bf16x8*)(kb + q31 * 144 + kk * 32 + h * 16);
      kf[2 * kk + 1] = *(const bf16x8*)(kb + (32 + q31) * 144 + kk * 32 + h * 16);
    }
#pragma unroll
    for (int c = 0; c < 4; ++c)
#pragma unroll
      for (int ds = 0; ds < 2; ++ds) {
        const char* vp = vb + (ds * 32 + q31) * 136 + (16 * c + h * 4) * 2;
        vfr[c * 2 + ds].u[0] = *(const uint2*)vp;
        vfr[c * 2 + ds].u[1] = *(const uint2*)(vp + 16);
      }
    __builtin_amdgcn_sched_barrier(0);
#pragma unroll
    for (int kk = 0; kk < 4; ++kk) {
      S0 = __builtin_amdgcn_mfma_f32_32x32x16_bf16(kf[2 * kk], qf[kk], S0, 0, 0, 0);
      S1 = __builtin_amdgcn_mfma_f32_32x32x16_bf16(kf[2 * kk + 1], qf[kk], S1, 0, 0, 0);
    }
    const int j = TILEJ(tcur);
    if (window && j < SEQ) {
#pragma unroll
      for (int i = 0; i < 16; ++i) {
        const int kp = j + crow(i, h);
        int d0 = kp - qpos; d0 = d0 < 0 ? -d0 : d0;
        int d1 = kp + 32 - qpos; d1 = d1 < 0 ? -d1 : d1;
        S0[i] = d0 <= 128 ? S0[i] : -1e30f;
        S1[i] = d1 <= 128 ? S1[i] : -1e30f;
      }
    }
    if (FIXED) {
      float rs = 0.f;
#pragma unroll
      for (int i = 0; i < 16; ++i) {
        S0[i] = __builtin_amdgcn_exp2f(S0[i]);
        S1[i] = __builtin_amdgcn_exp2f(S1[i]);
        rs += S0[i] + S1[i];
      }
      l_run += rs;
    } else {
      float mx = S0[0];
#pragma unroll
      for (int i = 1; i < 16; ++i) mx = fmaxf(mx, S0[i]);
#pragma unroll
      for (int i = 0; i < 16; ++i) mx = fmaxf(mx, S1[i]);
      mx = fmaxf(mx, __shfl_xor(mx, 32, 64));
      const float mnew = fmaxf(m_run, mx);
      const float alpha = __builtin_amdgcn_exp2f(m_run - mnew);
      float rs = 0.f;
#pragma unroll
      for (int i = 0; i < 16; ++i) {
        S0[i] = __builtin_amdgcn_exp2f(S0[i] - mnew);
        S1[i] = __builtin_amdgcn_exp2f(S1[i] - mnew);
        rs += S0[i] + S1[i];
      }
      rs += __shfl_xor(rs, 32, 64);
      l_run = l_run * alpha + rs;
      m_run = mnew;
#pragma unroll
      for (int i = 0; i < 16; ++i) { O0[i] *= alpha; O1[i] *= alpha; }
    }
#pragma unroll
    for (int c = 0; c < 4; ++c) {
      union { unsigned u[4]; bf16x8 v; } pf;
      if (c < 2) {
#pragma unroll
        for (int e = 0; e < 4; ++e) pf.u[e] = pack2(S0[(c & 1) * 8 + 2 * e], S0[(c & 1) * 8 + 2 * e + 1]);
      } else {
#pragma unroll
        for (int e = 0; e < 4; ++e) pf.u[e] = pack2(S1[(c & 1) * 8 + 2 * e], S1[(c & 1) * 8 + 2 * e + 1]);
      }
      O0 = __builtin_amdgcn_mfma_f32_32x32x16_bf16(vfr[c * 2].v, pf.v, O0, 0, 0, 0);
      O1 = __builtin_amdgcn_mfma_f32_32x32x16_bf16(vfr[c * 2 + 1].v, pf.v, O1, 0, 0, 0);
    }

    }
    {
      const int tcur = ti + 1;
      const char* kb = Kl + s1 * 9216;
      const char* vb = Vl + s1 * 8704;
    f32x16 S0, S1;
    const float sinit = FIXED ? -m_run : 0.f;
#pragma unroll
    for (int i = 0; i < 16; ++i) { S0[i] = sinit; S1[i] = sinit; }
    bf16x8 kf[8];
    union { uint2 u[2]; bf16x8 v; } vfr[8];
#pragma unroll
    for (int kk = 0; kk < 4; ++kk) {
      kf[2 * kk] = *(const bf16x8*)(kb + q31 * 144 + kk * 32 + h * 16);
      kf[2 * kk + 1] = *(const bf16x8*)(kb + (32 + q31) * 144 + kk * 32 + h * 16);
    }
#pragma unroll
    for (int c = 0; c < 4; ++c)
#pragma unroll
      for (int ds = 0; ds < 2; ++ds) {
        const char* vp = vb + (ds * 32 + q31) * 136 + (16 * c + h * 4) * 2;
        vfr[c * 2 + ds].u[0] = *(const uint2*)vp;
        vfr[c * 2 + ds].u[1] = *(const uint2*)(vp + 16);
      }
    __builtin_amdgcn_sched_barrier(0);
#pragma unroll
    for (int kk = 0; kk < 4; ++kk) {
      S0 = __builtin_amdgcn_mfma_f32_32x32x16_bf16(kf[2 * kk], qf[kk], S0, 0, 0, 0);
      S1 = __builtin_amdgcn_mfma_f32_32x32x16_bf16(kf[2 * kk + 1], qf[kk], S1, 0, 0, 0);
    }
    const int j = TILEJ(tcur);
    if (window && j < SEQ) {
#pragma unroll
      for (int i = 0; i < 16; ++i) {
        const int kp = j + crow(i, h);
        int d0 = kp - qpos; d0 = d0 < 0 ? -d0 : d0;
        int d1 = kp + 32 - qpos; d1 = d1 < 0 ? -d1 : d1;
        S0[i] = d0 <= 128 ? S0[i] : -1e30f;
        S1[i] = d1 <= 128 ? S1[i] : -1e30f;
      }
    }
    if (FIXED) {
      float rs = 0.f;
#pragma unroll
      for (int i = 0; i < 16; ++i) {
        S0[i] = __builtin_amdgcn_exp2f(S0[i]);
        S1[i] = __builtin_amdgcn_exp2f(S1[i]);
        rs += S0[i] + S1[i];
      }
      l_run += rs;
    } else {
      float mx = S0[0];
#pragma unroll
      for (int i = 1; i < 16; ++i) mx = fmaxf(mx, S0[i]);
#pragma unroll
      for (int i = 0; i < 16; ++i) mx = fmaxf(mx, S1[i]);
      mx = fmaxf(mx, __shfl_xor(mx, 32, 64));
      const float mnew = fmaxf(m_run, mx);
      const float alpha = __builtin_amdgcn_exp2f(m_run - mnew);
      float rs = 0.f;
#pragma unroll
      for (int i = 0; i < 16; ++i) {
        S0[i] = __builtin_amdgcn_exp2f(S0[i] - mnew);
        S1[i] = __builtin_amdgcn_exp2f(S1[i] - mnew);
        rs += S0[i] + S1[i];
      }
      rs += __shfl_xor(rs, 32, 64);
      l_run = l_run * alpha + rs;
      m_run = mnew;
#pragma unroll
      for (int i = 0; i < 16; ++i) { O0[i] *= alpha; O1[i] *= alpha; }
    }
#pragma unroll
    for (int c = 0; c < 4; ++c) {
      union { unsigned u[4]; bf16x8 v; } pf;
      if (c < 2) {
#pragma unroll
        for (int e = 0; e < 4; ++e) pf.u[e] = pack2(S0[(c & 1) * 8 + 2 * e], S0[(c & 1) * 8 + 2 * e + 1]);
      } else {
#pragma unroll
        for (int e = 0; e < 4; ++e) pf.u[e] = pack2(S1[(c & 1) * 8 + 2 * e], S1[(c & 1) * 8 + 2 * e + 1]);
      }
      O0 = __builtin_amdgcn_mfma_f32_32x32x16_bf16(vfr[c * 2].v, pf.v, O0, 0, 0, 0);
      O1 = __builtin_amdgcn_mfma_f32_32x32x16_bf16(vfr[c * 2 + 1].v, pf.v, O1, 0, 0, 0);
    }

      if (ti + 2 < ntiles) { ASWRITE(rkA, rvA, s2); ASWRITE(rkB, rvB, s2 + 1); }
      __syncthreads();
    }
    s0 = s2;
  }
#undef TILEJ
#undef AGLOAD
#undef ASWRITE
  if (FIXED) l_run += __shfl_xor(l_run, 32, 64);
  const float inv = 1.f / l_run;
  bf16_t* op = p.HO + (size_t)(qrow0 + qw * 32 + q31) * HS + grp * 256 + head * 64 + h * 4;
#pragma unroll
  for (int gi = 0; gi < 4; ++gi) {
    uint2 w;
    w.x = pack2(O0[gi * 4 + 0] * inv, O0[gi * 4 + 1] * inv);
    w.y = pack2(O0[gi * 4 + 2] * inv, O0[gi * 4 + 3] * inv);
    *(uint2*)(op + gi * 8) = w;
    w.x = pack2(O1[gi * 4 + 0] * inv, O1[gi * 4 + 1] * inv);
    w.y = pack2(O1[gi * 4 + 2] * inv, O1[gi * 4 + 3] * inv);
    *(uint2*)(op + 32 + gi * 8) = w;
  }
}

DI float2 c_add(float2 a, float2 b) { return make_float2(a.x + b.x, a.y + b.y); }
DI float2 c_sub(float2 a, float2 b) { return make_float2(a.x - b.x, a.y - b.y); }
DI float2 c_mul(float2 a, float2 w) { return make_float2(a.x * w.x - a.y * w.y, a.x * w.y + a.y * w.x); }
DI float2 c_mni(float2 a) { return make_float2(a.y, -a.x); }
DI float2 c_pi(float2 a) { return make_float2(-a.y, a.x); }
constexpr float RS2 = 0.70710678118654752f;
DI void fft_bottom_r2(float2* X, int lg) {
  const int n2 = 1 << (lg - 1);
  for (int j = tidx(); j < n2; j += NTHR) {
    const float2 a = X[2 * j], b = X[2 * j + 1];
    X[2 * j] = c_add(a, b);
    X[2 * j + 1] = c_sub(a, b);
  }
  __syncthreads();
}
DI void fft_dif(float2* X, int lg) {
  const int n8 = 1 << (lg - 3);
  int s = lg - 1;
  for (; s >= 2; s -= 3) {
    const int q = 1 << (s - 2);
    const float inv = 1.0f / (float)(8 * q);
    for (int j = tidx(); j < n8; j += NTHR) {
      const int p = j & (q - 1);
      const int i0 = ((j >> (s - 2)) << (s + 1)) + p;
      float2 v[8];
#pragma unroll
      for (int k = 0; k < 8; ++k) v[k] = X[i0 + k * q];
      const float r = (float)p * inv;
      const float2 W = make_float2(cos_rev(r), -sin_rev(r));
      const float2 W2 = make_float2(W.x * W.x - W.y * W.y, 2.f * W.x * W.y);
      const float2 W4 = make_float2(W2.x * W2.x - W2.y * W2.y, 2.f * W2.x * W2.y);
      float2 y[8];
#pragma unroll
      for (int k = 0; k < 4; ++k) {
        y[k] = c_add(v[k], v[k + 4]);
        const float2 d = c_mul(c_sub(v[k], v[k + 4]), W);
        y[k + 4] = k == 0 ? d : (k == 1 ? make_float2((d.x + d.y) * RS2, (d.y - d.x) * RS2)
                                        : (k == 2 ? c_mni(d) : make_float2((d.y - d.x) * RS2, -(d.x + d.y) * RS2)));
      }
      float2 z[8];
#pragma unroll
      for (int b = 0; b < 8; b += 4) {
        z[b] = c_add(y[b], y[b + 2]);
        z[b + 2] = c_mul(c_sub(y[b], y[b + 2]), W2);
        z[b + 1] = c_add(y[b + 1], y[b + 3]);
        z[b + 3] = c_mni(c_mul(c_sub(y[b + 1], y[b + 3]), W2));
      }
#pragma unroll
      for (int b = 0; b < 8; b += 2) {
        X[i0 + b * q] = c_add(z[b], z[b + 1]);
        X[i0 + (b + 1) * q] = c_mul(c_sub(z[b], z[b + 1]), W4);
      }
    }
    __syncthreads();
  }
  if (s == 1) {
    const int n4 = 1 << (lg - 2);
    for (int j = tidx(); j < n4; j += NTHR) {
      const float2 x0 = X[4 * j], x1 = X[4 * j + 1], x2 = X[4 * j + 2], x3 = X[4 * j + 3];
      const float2 y0 = c_add(x0, x2), y2 = c_sub(x0, x2), y1 = c_add(x1, x3), y3 = c_mni(c_sub(x1, x3));
      X[4 * j] = c_add(y0, y1); X[4 * j + 1] = c_sub(y0, y1); X[4 * j + 2] = c_add(y2, y3); X[4 * j + 3] = c_sub(y2, y3);
    }
    __syncthreads();
  } else if (s == 0) {
    fft_bottom_r2(X, lg);
  }
}
DI void fft_dit_inv(float2* X, int lg) {
  const int n8 = 1 << (lg - 3);
  const int rem = lg % 3;
  int s = 0;
  if (rem == 1) { fft_bottom_r2(X, lg); s = 1; }
  else if (rem == 2) {
    const int n4 = 1 << (lg - 2);
    for (int j = tidx(); j < n4; j += NTHR) {
      const float2 x0 = X[4 * j], x1 = X[4 * j + 1], x2 = X[4 * j + 2], x3 = X[4 * j + 3];
      const float2 y0 = c_add(x0, x1), y1 = c_sub(x0, x1), y2 = c_add(x2, x3), y3 = c_pi(c_sub(x2, x3));
      X[4 * j] = c_add(y0, y2); X[4 * j + 2] = c_sub(y0, y2); X[4 * j + 1] = c_add(y1, y3); X[4 * j + 3] = c_sub(y1, y3);
    }
    __syncthreads();
    s = 2;
  }
  for (; s + 2 < lg; s += 3) {
    const int q = 1 << s;
    const float inv = 1.0f / (float)(8 * q);
    for (int j = tidx(); j < n8; j += NTHR) {
      const int p = j & (q - 1);
      const int i0 = ((j >> s) << (s + 3)) + p;
      float2 o[8];
#pragma unroll
      for (int k = 0; k < 8; ++k) o[k] = X[i0 + k * q];
      const float r = (float)p * inv;
      const float2 W = make_float2(cos_rev(r), sin_rev(r));
      const float2 W2 = make_float2(W.x * W.x - W.y * W.y, 2.f * W.x * W.y);
      const float2 W4 = make_float2(W2.x * W2.x - W2.y * W2.y, 2.f * W2.x * W2.y);
      float2 z[8];
#pragma unroll
      for (int b = 0; b < 8; b += 2) {
        const float2 t = c_mul(o[b + 1], W4);
        z[b] = c_add(o[b], t); z[b + 1] = c_sub(o[b], t);
      }
      float2 y[8];
#pragma unroll
      for (int b = 0; b < 8; b += 4) {
        const float2 t = c_mul(z[b + 2], W2);
        y[b] = c_add(z[b], t); y[b + 2] = c_sub(z[b], t);
        const float2 u = c_pi(c_mul(z[b + 3], W2));
        y[b + 1] = c_add(z[b + 1], u); y[b + 3] = c_sub(z[b + 1], u);
      }
#pragma unroll
      for (int k = 0; k < 4; ++k) {
        const float2 d = c_mul(y[k + 4], W);
        const float2 t = k == 0 ? d : (k == 1 ? make_float2((d.x - d.y) * RS2, (d.x + d.y) * RS2)
                                              : (k == 2 ? c_pi(d) : make_float2(-(d.x + d.y) * RS2, (d.x - d.y) * RS2)));
        X[i0 + k * q] = c_add(y[k], t);
        X[i0 + (k + 4) * q] = c_sub(y[k], t);
      }
    }
    __syncthreads();
  }
}

DI float conv3(const float* z, int t, int Ls, float w0, float w1, float w2, float bias) {
  const float zm = t > 0 ? z[t - 1] : 0.f, zc = z[t], zp = t < Ls - 1 ? z[t + 1] : 0.f;
  return w0 * zm + w1 * zc + w2 * zp + bias;
}

DI void hyena_item(const Params& p, int l, float2* X, int bp, int c, bool lat) {
  const int Ls = lat ? SEQ : CL, lg = lat ? 14 : 9, N = 2 * Ls;
  const float* zb0 = lat ? p.ZT + (size_t)(2 * bp) * 1024 * SEQ : p.ZTc + (size_t)(2 * bp) * 1024 * CL;
  const float* zb1 = zb0 + (size_t)1024 * Ls;
  const float* cw = p.hy_conv_w + (size_t)l * 3 * 768;
  const float* cb = p.hy_conv_b + (size_t)l * 768;
  const float w00 = cw[c], w01 = cw[768 + c], w02 = cw[1536 + c], b0 = cb[c];
  const float w10 = cw[256 + c], w11 = cw[768 + 256 + c], w12 = cw[1536 + 256 + c], b1 = cb[256 + c];
  const float w20 = cw[512 + c], w21 = cw[768 + 512 + c], w22 = cw[1536 + 512 + c], b2 = cb[512 + c];
  const float* x0a = zb0 + (size_t)c * Ls; const float* x1a = zb0 + (size_t)(256 + c) * Ls; const float* va = zb0 + (size_t)(512 + c) * Ls;
  const float* x0b = zb1 + (size_t)c * Ls; const float* x1b = zb1 + (size_t)(256 + c) * Ls; const float* vb = zb1 + (size_t)(512 + c) * Ls;
#pragma unroll 4
  for (int t = tidx(); t < Ls; t += NTHR) {
    const float ua = conv3(x1a, t, Ls, w10, w11, w12, b1) * conv3(va, t, Ls, w20, w21, w22, b2);
    const float ub = conv3(x1b, t, Ls, w10, w11, w12, b1) * conv3(vb, t, Ls, w20, w21, w22, b2);
    X[t] = make_float2(ua, ub);
    X[Ls + t] = make_float2(0.f, 0.f);
  }
  __syncthreads();
  fft_dif(X, lg);
  const float2* Kh = lat ? p.Khat + (size_t)(l * 256 + c) * (2 * SEQ) : p.Khatc + (size_t)(l * 256 + c) * (2 * CL);
#pragma unroll 8
  for (int i = tidx(); i < N; i += NTHR) {
    const float2 a = X[i], k = Kh[i];
    X[i] = make_float2(a.x * k.x - a.y * k.y, a.x * k.y + a.y * k.x);
  }
  __syncthreads();
  fft_dit_inv(X, lg);
  const float invN = 1.f / (float)N, skip = p.hy_skip[l * 256 + c];
  const size_t rba = lat ? (size_t)(2 * bp) * SEQ : (size_t)T + (size_t)(2 * bp) * CL;
  const size_t rbb = rba + Ls;
#pragma unroll 4
  for (int t = tidx(); t < Ls; t += NTHR) {
    const float2 y = X[t];
    const float ua = conv3(x1a, t, Ls, w10, w11, w12, b1) * conv3(va, t, Ls, w20, w21, w22, b2);
    const float ub = conv3(x1b, t, Ls, w10, w11, w12, b1) * conv3(vb, t, Ls, w20, w21, w22, b2);
    const float oa = (y.x * invN + skip * ua) * conv3(x0a, t, Ls, w00, w01, w02, b0);
    const float ob = (y.y * invN + skip * ub) * conv3(x0b, t, Ls, w00, w01, w02, b0);
    p.HO[(rba + t) * HS + 512 + c] = f2bf(oa);
    p.HO[(rbb + t) * HS + 512 + c] = f2bf(ob);
  }
  __syncthreads();
}

DI void fnet_item(const Params& p, float2* X, int b, int g, int m, bool lat) {
  const int Ls = lat ? SEQ : CL, lg = lat ? 13 : 8;
  const float* zb = lat ? p.ZT + (size_t)b * 1024 * SEQ : p.ZTc + (size_t)b * 1024 * CL;
  const float* re = zb + (size_t)(768 + g * 64 + m) * Ls;
  const bool hasim = (m >= 1 && m <= 31);
  const float* im = zb + (size_t)(768 + g * 64 + 32 + (hasim ? m : 0)) * Ls;
#pragma unroll 8
  for (int t = tidx(); t < Ls; t += NTHR) X[t] = make_float2(re[t], hasim ? im[t] : 0.f);
  __syncthreads();
  fft_dif(X, lg);
  const float s = rsqrtf((float)Ls * 64.f);
  const size_t rb = lat ? (size_t)b * SEQ : (size_t)T + (size_t)b * CL;
#pragma unroll 4
  for (int i = tidx(); i < Ls; i += NTHR) {
    const int k = (int)(__brev((unsigned)i) >> (32 - lg));
    const bf16_t v = f2bf(X[i].x * s);
    p.F[(rb + k) * 256 + g * 64 + m] = v;
    if (hasim) p.F[(rb + ((Ls - k) & (Ls - 1))) * 256 + g * 64 + 64 - m] = v;
  }
  __syncthreads();
}

DI void mixers_phase(const Params& p, int l, char* lds) {
  float2* X = (float2*)lds;
  const int xcd = blockIdx.x & 7;
#pragma unroll 1
  for (int it = 0;; ++it) {
    const int loc = xcd_local(it, l == DEPTH - 1 ? 256 : 264);
    if (loc < 0) break;
    int grp, pair, qrow0, qpos0, jfirst, nloc;
    bool window = false;
    if (loc < 256) {
      grp = loc < 128 ? 1 : 0;
      const int q = loc & 127, qb = q & 63;
      pair = 2 * xcd + (q >> 6);
      qpos0 = qb * 128;
      qrow0 = (pair >> 1) * SEQ + qpos0;
      if (grp) { jfirst = 0; nloc = 128; }
      else {
        const int fb = qb > 0 ? qb - 1 : 0, lb = qb < 63 ? qb + 1 : 63;
        jfirst = fb * 128; nloc = (lb - fb + 1) * 2; window = true;
      }
    } else {
      const int q = loc - 256;
      grp = q >> 2;
      pair = 2 * xcd + ((q >> 1) & 1);
      qpos0 = (q & 1) * 128;
      qrow0 = T + (pair >> 1) * CL + qpos0;
      jfirst = 0; nloc = 0;
    }
    if (grp) attn_item<true>(p, l, lds, grp, pair >> 1, pair & 1, qrow0, qpos0, jfirst, nloc, false);
    else attn_item<false>(p, l, lds, grp, pair >> 1, pair & 1, qrow0, qpos0, jfirst, nloc, window);
  }
#pragma unroll 1
  for (int it = 0;; ++it) {
    int loc = xcd_local(it, l == DEPTH - 1 ? 128 : 256);
    if (loc < 0) break;
    loc &= 255;
    hyena_item(p, l, X, (loc >> 5) & 3, xcd * 32 + (loc & 31), loc < 128);
  }
#pragma unroll 1
  for (int it = 0;; ++it) {
    int loc = xcd_local(it, l == DEPTH - 1 ? 132 : 264);
    if (loc < 0) break;
    if (loc >= 264) loc -= 264;
    const int q = loc < 132 ? loc : loc - 132;
    fnet_item(p, X, xcd, q / 33, q % 33, loc < 132);
  }
}

DI void row_pass(const Params& p, int l, int mode) {
  const int lane = tidx() & 63, wave = tidx() >> 6;
  const int nrows = (l == DEPTH - 1 && mode) ? T : MROWS;
  const bool first = (l == 0 && mode <= 1);
  const float* xl = first ? p.x : p.out;
  const float* xc = first ? p.ctx : p.cx;
  int ml = l, sho = 0, sco = 1024;
  if (mode == 1) { sho = 3072; sco = 4096; }
  if (mode == 2) ml = l + 1;
  const bool has_h = ml < DEPTH;
  const int stride = gridDim.x * 8;
  float4 LG[4], LB[4], GT[4], SH[4], SC[4];
#pragma unroll
  for (int j = 0; j < 4; ++j) {
    const int col = lane * 4 + 256 * j;
    LG[j] = mode ? *(const float4*)((mode == 1 ? p.ln1_g : p.ln2_g) + (size_t)l * D + col) : make_float4(0.f, 0.f, 0.f, 0.f);
    LB[j] = mode ? *(const float4*)((mode == 1 ? p.ln1_b : p.ln2_b) + (size_t)l * D + col) : make_float4(0.f, 0.f, 0.f, 0.f);
    GT[j] = SH[j] = SC[j] = make_float4(0.f, 0.f, 0.f, 0.f);
  }
  int mr_cur = -1;
  int r = blockIdx.x * 8 + wave;
  float4 xv[4];
  uint2 yv[4];
#define ROWLOAD(XV, YV, rr)                                                                       \
  {                                                                                               \
    const float* xs_ = (rr) < T ? xl + (size_t)(rr) * D : xc + (size_t)((rr) - T) * D;            \
    _Pragma("unroll") for (int j = 0; j < 4; ++j) { const f32x4 t_ = __builtin_nontemporal_load((const f32x4*)(xs_ + lane * 4 + 256 * j)); XV[j] = make_float4(t_.x, t_.y, t_.z, t_.w); } \
    if (mode) { const bf16_t* yr_ = p.Y + (size_t)(rr) * D;                                       \
      _Pragma("unroll") for (int j = 0; j < 4; ++j) { const u32x2 t_ = __builtin_nontemporal_load((const u32x2*)(yr_ + lane * 4 + 256 * j)); YV[j] = make_uint2(t_.x, t_.y); } } \
  }
  if (r < nrows) ROWLOAD(xv, yv, r);
#pragma unroll 1
  for (; r < nrows; r += stride) {
    float4 xn[4];
    uint2 yn[4];
    const int rn = r + stride;
    if (rn < nrows) ROWLOAD(xn, yn, rn);
    const bool lat = r < T;
    const int mr = lat ? (r >> 13) : 8;
    if (mr != mr_cur) {
      mr_cur = mr;
      const float* md = p.mod + ((size_t)l * 9 + mr) * 6144;
      const float* md2 = p.mod + ((size_t)(has_h ? ml : l) * 9 + mr) * 6144;
#pragma unroll
      for (int j = 0; j < 4; ++j) {
        const int col = lane * 4 + 256 * j;
        if (mode) GT[j] = *(const float4*)(md + (mode == 1 ? 2048 : 5120) + col);
        SH[j] = *(const float4*)(md2 + sho + col);
        SC[j] = *(const float4*)(md2 + sco + col);
      }
    }
    float v[16];
#pragma unroll
    for (int j = 0; j < 4; ++j) { v[4 * j] = xv[j].x; v[4 * j + 1] = xv[j].y; v[4 * j + 2] = xv[j].z; v[4 * j + 3] = xv[j].w; }
    if (mode) {
      float s = 0.f;
#pragma unroll
      for (int j = 0; j < 4; ++j) {
        v[4 * j] = ALPHA * v[4 * j] + GT[j].x * bf2f(yv[j].x & 0xffffu);
        v[4 * j + 1] = ALPHA * v[4 * j + 1] + GT[j].y * bf2f(yv[j].x >> 16);
        v[4 * j + 2] = ALPHA * v[4 * j + 2] + GT[j].z * bf2f(yv[j].y & 0xffffu);
        v[4 * j + 3] = ALPHA * v[4 * j + 3] + GT[j].w * bf2f(yv[j].y >> 16);
        s += v[4 * j] + v[4 * j + 1] + v[4 * j + 2] + v[4 * j + 3];
      }
      const float mu = wave_sum(s) * (1.f / D);
      float q = 0.f;
#pragma unroll
      for (int i = 0; i < 16; ++i) { const float d = v[i] - mu; q += d * d; }
      const float rstd = rsqrtf(wave_sum(q) * (1.f / D) + 1e-6f);
      float* xd = lat ? p.out + (size_t)r * D : p.cx + (size_t)(r - T) * D;
#pragma unroll
      for (int j = 0; j < 4; ++j) {
        const int col = lane * 4 + 256 * j;
        v[4 * j] = (v[4 * j] - mu) * rstd * LG[j].x + LB[j].x;
        v[4 * j + 1] = (v[4 * j + 1] - mu) * rstd * LG[j].y + LB[j].y;
        v[4 * j + 2] = (v[4 * j + 2] - mu) * rstd * LG[j].z + LB[j].z;
        v[4 * j + 3] = (v[4 * j + 3] - mu) * rstd * LG[j].w + LB[j].w;
        { const f32x4 t_ = {v[4 * j], v[4 * j + 1], v[4 * j + 2], v[4 * j + 3]}; __builtin_nontemporal_store(t_, (f32x4*)(xd + col)); }
      }
    }
    if (has_h) {
      float s = 0.f;
#pragma unroll
      for (int i = 0; i < 16; ++i) s += v[i];
      const float mu = wave_sum(s) * (1.f / D);
      float q = 0.f;
#pragma unroll
      for (int i = 0; i < 16; ++i) { const float d = v[i] - mu; q += d * d; }
      const float rstd = rsqrtf(wave_sum(q) * (1.f / D) + 1e-6f);
      bf16_t* hr = p.HO + (size_t)r * HS;
#pragma unroll
      for (int j = 0; j < 4; ++j) {
        const int col = lane * 4 + 256 * j;
        uint2 w;
        w.x = pack2((v[4 * j] - mu) * rstd * (1.f + SC[j].x) + SH[j].x, (v[4 * j + 1] - mu) * rstd * (1.f + SC[j].y) + SH[j].y);
        w.y = pack2((v[4 * j + 2] - mu) * rstd * (1.f + SC[j].z) + SH[j].z, (v[4 * j + 3] - mu) * rstd * (1.f + SC[j].w) + SH[j].w);
        *(uint2*)(hr + col) = w;
      }
    }
#pragma unroll
    for (int j = 0; j < 4; ++j) { xv[j] = xn[j]; yv[j] = yn[j]; }
  }
#undef ROWLOAD
}

DI void merge_norm_phase(const Params& p, int nrows) {
  const int lane = tidx() & 63, wave = tidx() >> 6;
#pragma unroll 1
  for (int r0 = (blockIdx.x * 8 + wave) * 4; r0 < nrows; r0 += gridDim.x * 32) {
    uint4 a[4], b[4];
#pragma unroll
    for (int k = 0; k < 4; ++k) {
      const int r = r0 + k < nrows ? r0 + k : nrows - 1;
      const bf16_t* hr = p.HO + (size_t)r * HS + lane * 16;
      a[k] = *(const uint4*)hr; b[k] = *(const uint4*)(hr + 8);
    }
#pragma unroll
    for (int k = 0; k < 4; ++k) {
      if (r0 + k >= nrows) break;
      bf16_t* hr = p.HO + (size_t)(r0 + k) * HS + lane * 16;
      unsigned u[8] = {a[k].x, a[k].y, a[k].z, a[k].w, b[k].x, b[k].y, b[k].z, b[k].w};
      float f[16];
      float ss = 0.f;
#pragma unroll
      for (int i = 0; i < 8; ++i) { f[2 * i] = bf2f(u[i] & 0xffffu); f[2 * i + 1] = bf2f(u[i] >> 16); ss += f[2 * i] * f[2 * i] + f[2 * i + 1] * f[2 * i + 1]; }
      ss = row16_sum(ss);
      const float rs = rsqrtf(ss * (1.f / 256.f) + 1e-6f);
#pragma unroll
      for (int i = 0; i < 8; ++i) u[i] = pack2(f[2 * i] * rs, f[2 * i + 1] * rs);
      *(uint4*)hr = make_uint4(u[0], u[1], u[2], u[3]);
      *(uint4*)(hr + 8) = make_uint4(u[4], u[5], u[6], u[7]);
    }
  }
}

DI void conv_tile(float* lds, const float* src, int ldsrc, bf16_t* dst, int ldd, int k0, int n0, const float* rowscale) {
  const int tid = tidx();
#pragma unroll
  for (int i = 0; i < 8; ++i) {
    const int idx = tid + NTHR * i, kk = idx >> 6, nn = idx & 63;
    float v = src[(size_t)(k0 + kk) * ldsrc + n0 + nn];
    if (rowscale) v *= rowscale[k0 + kk];
    lds[kk * 65 + nn] = v;
  }
  __syncthreads();
#pragma unroll
  for (int i = 0; i < 4; ++i) {
    const int pidx = tid + NTHR * i, nn = pidx >> 5, kp = pidx & 31;
    *(unsigned*)(dst + (size_t)(n0 + nn) * ldd + k0 + 2 * kp) = pack2(lds[(2 * kp) * 65 + nn], lds[(2 * kp + 1) * 65 + nn]);
  }
  __syncthreads();
}
DI void fold_tile(float* lds, const float* src, bf16_t* dst, int k0, int g) {
  const int tid = tidx();
  float* cs = lds + 64 * 65;
  float* sn = cs + 64;
#pragma unroll
  for (int i = 0; i < 8; ++i) {
    const int idx = tid + NTHR * i, kk = idx >> 6, nn = idx & 63;
    lds[kk * 65 + nn] = src[(size_t)(k0 + kk) * DP + 1792 + g * 64 + nn];
  }
  if (tid < 64) { cs[tid] = cos_rev((float)tid * (1.f / 64.f)); sn[tid] = sin_rev((float)tid * (1.f / 64.f)); }
  __syncthreads();
#pragma unroll 1
  for (int i = 0; i < 4; ++i) {
    const int pidx = tid + NTHR * i, mp = pidx >> 5, kp = pidx & 31;
    float a0 = 0.f, a1 = 0.f;
    const int mm = mp <= 32 ? mp : mp - 32;
#pragma unroll 4
    for (int j = 0; j < 64; ++j) {
      const int ph = (mm * j) & 63;
      const float cm = mp <= 32 ? cs[ph] : -sn[ph];
      a0 += lds[(2 * kp) * 65 + j] * cm;
      a1 += lds[(2 * kp + 1) * 65 + j] * cm;
    }
    *(unsigned*)(dst + (size_t)(1792 + g * 64 + mp) * HS + k0 + 2 * kp) = pack2(a0, a1);
  }
  __syncthreads();
}
DI void convert_phase(const Params& p, float* lds) {
  constexpr int PER = 2848;
  for (int job = blockIdx.x; job < PER * DEPTH; job += gridDim.x) {
    const int l = job / PER;
    int j = job - l * PER;
    if (j >= 448 && j < 512) {
      j -= 448;
      fold_tile(lds, p.w_in + (size_t)l * D * DP, p.Win + (size_t)l * DP * HS, (j & 15) * 64, j >> 4);
      continue;
    }
    const float* src; bf16_t* dst; int ldsrc, ldd, k0, n0; const float* rs = nullptr;
    if (j < 448) {
      src = p.w_in + (size_t)l * D * DP; ldsrc = DP; dst = p.Win + (size_t)l * DP * HS; ldd = HS; k0 = (j / 28) * 64; n0 = (j % 28) * 64;
    } else if (j < 768) {
      j -= 512;
      src = p.w_out + (size_t)l * D * D; ldsrc = D; dst = p.Wout + (size_t)l * D * HS; ldd = HS; k0 = (j >> 4) * 64; n0 = (j & 15) * 64;
      rs = p.out_norm_g + l * D;
    } else if (j < 2144) {
      j -= 768;
      src = p.ffn_w_up + (size_t)l * D * DFF2; ldsrc = DFF2; dst = p.Wup + (size_t)l * 2 * DFFP * HS; ldd = HS; k0 = (j / 86) * 64; n0 = (j % 86) * 64;
      if (n0 >= DFF) { src += DFF; dst += (size_t)DFFP * HS; n0 -= DFF; ldsrc = DFF2; }
    } else if (j < 2832) {
      j -= 2144;
      src = p.ffn_w_down + (size_t)l * DFF * D; ldsrc = D; dst = p.Wdn + (size_t)l * D * DFFP; ldd = DFFP; k0 = (j >> 4) * 64; n0 = (j & 15) * 64;
    } else {
      j -= 2832;
      src = p.fnet_w + (size_t)l * 256 * 256; ldsrc = 256; dst = p.Wfn + (size_t)l * 256 * 256; ldd = 256; k0 = (j >> 2) * 64; n0 = (j & 3) * 64;
    }
    conv_tile(lds, src, ldsrc, dst, ldd, k0, n0, rs);
  }
}
DI void pad_phase(const Params& p) {
  const int gtid = blockIdx.x * NTHR + tidx(), gn = gridDim.x * NTHR;
  for (int idx = gtid; idx < DEPTH * 2 * 64 * D; idx += gn) {
    const int k = idx & (D - 1), r = (idx >> 10) & 63, h = (idx >> 16) & 1, l = idx >> 17;
    p.Wup[((size_t)l * 2 * DFFP + (size_t)h * DFFP + DFF + r) * HS + k] = 0;
  }
  for (int idx = gtid; idx < DEPTH * D * 64; idx += gn) {
    const int k = idx & 63, r = idx >> 6;
    p.Wdn[(size_t)r * DFFP + DFF + k] = 0;
  }
  for (int idx = gtid; idx < DEPTH * 2 * DFFP; idx += gn) {
    const int c = idx % DFFP, h = (idx / DFFP) & 1, l = idx / (2 * DFFP);
    const bool ok = c < DFF;
    p.bupP[idx] = ok ? p.ffn_b_up[(size_t)l * DFF2 + h * DFF + c] : 0.f;
    p.cbP[idx] = ok ? p.ffn_conv_b[(size_t)l * DFF2 + h * DFF + c] : 0.f;
#pragma unroll
    for (int tap = 0; tap < 3; ++tap)
      p.cwP[(size_t)l * 6 * DFFP + (size_t)(tap * 2 + h) * DFFP + c] = ok ? p.ffn_conv_w[((size_t)l * 3 + tap) * DFF2 + h * DFF + c] : 0.f;
  }
}
DI void mod_phase(const Params& p, float* lds) {
  float* s = lds;
  float* part = lds + 9216;
  const int tid = tidx(), col = tid & 63, ks = tid >> 6;
  for (int item = blockIdx.x; item < DEPTH * 96; item += gridDim.x) {
    const int l = item / 96, n0 = (item % 96) * 64;
    for (int idx = tid; idx < 9 * 1024; idx += NTHR) {
      const int r = idx >> 10, k = idx & 1023;
      s[idx] = siluf(r < 8 ? p.c[r * D + k] : p.c_ctx[k]);
    }
    __syncthreads();
    float acc[9];
#pragma unroll
    for (int r = 0; r < 9; ++r) acc[r] = 0.f;
    const float* w = p.w_ada + (size_t)l * D * 6144 + n0 + col;
    for (int k = ks * 128; k < ks * 128 + 128; ++k) {
      const float wv = w[(size_t)k * 6144];
#pragma unroll
      for (int r = 0; r < 9; ++r) acc[r] += s[r * 1024 + k] * wv;
    }
#pragma unroll
    for (int r = 0; r < 9; ++r) part[(ks * 9 + r) * 64 + col] = acc[r];
    __syncthreads();
    for (int idx = tid; idx < 576; idx += NTHR) {
      const int r = idx >> 6, cc = idx & 63;
      float a = p.b_ada[l * 6144 + n0 + cc];
#pragma unroll
      for (int q = 0; q < 8; ++q) a += part[(q * 9 + r) * 64 + cc];
      p.mod[((size_t)l * 9 + r) * 6144 + n0 + cc] = a;
    }
    __syncthreads();
  }
}
DI void hy_mlp_item(const Params& p, float* lds, int l, int tt, bool lat) {
  const int Ls = lat ? SEQ : CL, t0 = tt * 32, tid = tidx();
  float* feat = lds;
  float* h1 = lds + 544;
  float* h2 = h1 + 2048;
  float* outl = h2 + 2048;
  for (int idx = tid; idx < 32 * 17; idx += NTHR) {
    const int t = idx / 17, f = idx % 17;
    const float tg = (float)(t0 + t);
    float v;
    if (f == 0) v = tg / (float)(Ls - 1);
    else {
      const int jb = (f - 1) & 7;
      const float band = 1e-4f + (float)jb * ((7.f - 1e-4f) / 7.f);
      const float rev = tg * band / (float)Ls;
      v = f <= 8 ? cos_rev(rev) : -sin_rev(rev);
    }
    feat[idx] = v;
  }
  __syncthreads();
  const float* w1 = p.hy_f_w1 + (size_t)l * 17 * 64;
  const float* w2 = p.hy_f_w2 + (size_t)l * 64 * 64;
  const float* w3 = p.hy_f_w3 + (size_t)l * 64 * 512;
#pragma unroll
  for (int i = 0; i < 4; ++i) {
    const int idx = tid + NTHR * i, t = idx >> 6, n = idx & 63;
    float a = p.hy_f_b1[l * 64 + n];
    for (int f = 0; f < 17; ++f) a += feat[t * 17 + f] * w1[f * 64 + n];
    h1[idx] = sin_rev(p.hy_f_freq[l * 64 + n] * a * INV2PI);
  }
  __syncthreads();
#pragma unroll
  for (int i = 0; i < 4; ++i) {
    const int idx = tid + NTHR * i, t = idx >> 6, n = idx & 63;
    float a = p.hy_f_b2[l * 64 + n];
    for (int k = 0; k < 64; ++k) a += h1[t * 64 + k] * w2[k * 64 + n];
    h2[n * 32 + t] = sin_rev(p.hy_f_freq[l * 64 + n] * a * INV2PI);
  }
  __syncthreads();
  {
    const int n = tid, c = n & 255;
    float acc[32];
#pragma unroll
    for (int t = 0; t < 32; ++t) acc[t] = 0.f;
#pragma unroll 2
    for (int k = 0; k < 64; ++k) {
      const float wv = w3[k * 512 + n];
#pragma unroll
      for (int t4 = 0; t4 < 8; ++t4) {
        const float4 hv = *(const float4*)(h2 + k * 32 + t4 * 4);
        acc[4 * t4] += hv.x * wv; acc[4 * t4 + 1] += hv.y * wv; acc[4 * t4 + 2] += hv.z * wv; acc[4 * t4 + 3] += hv.w * wv;
      }
    }
    const float mind = -3.0701134573253946f, maxd = -15.350567286626973f;
    const float delta = fabsf(mind + (maxd - mind) * ((float)c / 255.f));
#pragma unroll
    for (int t = 0; t < 32; ++t) {
      const float tn = (float)(t0 + t) / (float)(Ls - 1);
      outl[n * 33 + t] = acc[t] * __expf(-tn * delta);
    }
  }
  __syncthreads();
  const int N2 = 2 * Ls;
  float* kv = lat ? p.kvec + (size_t)l * 256 * (2 * SEQ) : p.kvecc + (size_t)l * 256 * (2 * CL);
  for (int idx = tid; idx < 512 * 32; idx += NTHR) {
    const int n = idx >> 5, t = idx & 31, c = n & 255, dir = n >> 8, tg = t0 + t;
    float val = outl[n * 33 + t];
    if (dir == 0) {
      if (tg == 0) val += outl[(256 + c) * 33];
      kv[(size_t)c * N2 + tg] = val;
    } else {
      if (tg == 0) kv[(size_t)c * N2 + Ls] = 0.f;
      else kv[(size_t)c * N2 + N2 - tg] = val;
    }
  }
  __syncthreads();
}
DI void khat_item(const Params& p, float2* X, int l, int c, bool lat) {
  const int Ls = lat ? SEQ : CL, lg = lat ? 14 : 9, N = 2 * Ls;
  const float* kv = lat ? p.kvec + (size_t)(l * 256 + c) * N : p.kvecc + (size_t)(l * 256 + c) * N;
  float2* Kh = lat ? p.Khat + (size_t)(l * 256 + c) * N : p.Khatc + (size_t)(l * 256 + c) * N;
#pragma unroll 8
  for (int i = tidx(); i < N; i += NTHR) X[i] = make_float2(kv[i], kv[N + i]);
  __syncthreads();
  fft_dif(X, lg);
#pragma unroll 4
  for (int i = tidx(); i < N; i += NTHR) {
    const int k = (int)(__brev((unsigned)i) >> (32 - lg));
    const int ip = (int)(__brev((unsigned)((N - k) & (N - 1))) >> (32 - lg));
    const float2 z = X[i], w = X[ip];
    Kh[i] = make_float2(0.5f * (z.x + w.x), 0.5f * (z.y - w.y));
    Kh[N + i] = make_float2(0.5f * (z.y + w.y), -0.5f * (z.x - w.x));
  }
  __syncthreads();
}

DI void grid_barrier(unsigned* bar, unsigned n) {
  asm volatile("s_waitcnt vmcnt(0) lgkmcnt(0)" ::: "memory");
  __syncthreads();
  if (threadIdx.x == 0) {
    const unsigned G = gridDim.x;
    __builtin_amdgcn_fence(__ATOMIC_RELEASE, "agent");
    if ((G & 7u) == 0u) {
      const unsigned x = blockIdx.x & 7u, per = G >> 3;
      unsigned* cnt = bar + 64 * (1 + x);
      unsigned* rel = bar + 64 * (9 + x);
      const unsigned old = __hip_atomic_fetch_add(cnt, 1u, __ATOMIC_RELAXED, __HIP_MEMORY_SCOPE_AGENT);
      if (old + 1u == n * per) {
        __hip_atomic_fetch_add(bar, 1u, __ATOMIC_RELAXED, __HIP_MEMORY_SCOPE_AGENT);
        while (__hip_atomic_load(bar, __ATOMIC_RELAXED, __HIP_MEMORY_SCOPE_AGENT) < n * 8u) __builtin_amdgcn_s_sleep(1);
        __hip_atomic_store(rel, n, __ATOMIC_RELAXED, __HIP_MEMORY_SCOPE_AGENT);
      } else {
        while (__hip_atomic_load(rel, __ATOMIC_RELAXED, __HIP_MEMORY_SCOPE_AGENT) < n) __builtin_amdgcn_s_sleep(1);
      }
    } else {
      __hip_atomic_fetch_add(bar, 1u, __ATOMIC_RELAXED, __HIP_MEMORY_SCOPE_AGENT);
      while (__hip_atomic_load(bar, __ATOMIC_RELAXED, __HIP_MEMORY_SCOPE_AGENT) < n * G) __builtin_amdgcn_s_sleep(1);
    }
    __builtin_amdgcn_fence(__ATOMIC_ACQUIRE, "agent");
  }
  __syncthreads();
}

__global__ void __launch_bounds__(NTHR) fwd_megakernel(Params p) {
  extern __shared__ __attribute__((aligned(16))) char lds[];
  cg::grid_group grid = cg::this_grid();
  float* ldsf = (float*)lds;
#pragma unroll 1
  for (int ph2 = 0; ph2 < 2 * (2 + 9 * DEPTH); ++ph2) {
    const int ph = ph2 >> 1;
    int l = 0, kind = ph;
    if (ph >= 2) { l = (ph - 2) / 9; kind = 3 + (ph - 2) % 9; }
    if ((ph2 & 1) && !(l == 0 && ((PROBE_DUP >> kind) & 1))) continue;
    if (kind == 0) {
      convert_phase(p, ldsf);
      pad_phase(p);
      mod_phase(p, ldsf);
#pragma unroll 1
      for (int item = blockIdx.x; item < DEPTH * 264; item += gridDim.x) {
        const int ll = item / 264, r = item % 264;
        hy_mlp_item(p, ldsf, ll, r < 256 ? r : r - 256, r < 256);
      }
    } else if (kind == 1) {
#pragma unroll 1
      for (int item = blockIdx.x; item < 2 * DEPTH * 128; item += gridDim.x)
        khat_item(p, (float2*)lds, (item >> 7) & 3, (item & 127) * 2, item < DEPTH * 128);
    }
    if (kind == 0) {
    } else if (kind == 1 || kind == 8 || kind == 11) {
      row_pass(p, l, kind == 1 ? 0 : (kind == 8 ? 1 : 2));
    } else if (kind == 3) {
      inproj_phase(p, l, lds);
    } else if (kind == 4) {
      mixers_phase(p, l, lds);
    } else if (kind == 6) {
      merge_norm_phase(p, l == DEPTH - 1 ? T : MROWS);
    } else if (kind == 9) {
      ffn_up_phase(p, l, lds);
    } else {
      const bf16_t* A; const bf16_t* Wt; const float* bias; bf16_t* out; int lda, ldw, K, NTn, ocol0;
      if (kind == 5) { A = p.F; lda = 256; Wt = p.Wfn + (size_t)l * 256 * 256; ldw = 256; K = 256; NTn = 1; bias = p.fnet_b + l * 256; out = p.HO; ocol0 = 768; }
      else if (kind == 7) { A = p.HO; lda = HS; Wt = p.Wout + (size_t)l * D * HS; ldw = HS; K = D; NTn = 4; bias = p.b_out + l * D; out = p.Y; ocol0 = 0; }
      else { A = p.ACT; lda = DFFP; Wt = p.Wdn + (size_t)l * D * DFFP; ldw = DFFP; K = DFFP; NTn = 4; bias = p.ffn_b_down + l * D; out = p.Y; ocol0 = 0; }
      gemm_plain_phase(lds, A, lda, Wt, ldw, K, l == DEPTH - 1 ? T / 256 : MROWS / 256, NTn, bias, out, kind == 5 ? HS : D, ocol0);
    }
    if (ph == 0) grid.sync();
    else grid_barrier(p.bar, (unsigned)ph);
  }
}

extern "C" void kernel_launch(void* const* d_in, const int* in_sizes, int n_in, void* d_out, int out_size, void* d_ws,
                              size_t ws_size, hipStream_t stream) {
  Params p{};
  const float** pf = (const float**)&p;
  for (int i = 0; i < 34; ++i) pf[i] = (const float*)d_in[i];
  p.out = (float*)d_out;
  char* w = (char*)d_ws;
  size_t off = 8192;
  p.bar = (unsigned*)d_ws;
  (void)hipMemsetAsync(d_ws, 0, 8192, stream);
  auto take = [&](size_t bytes) { char* r = w + off; off += (bytes + 255) & ~(size_t)255; return r; };
  p.Win = (bf16_t*)take((size_t)DEPTH * DP * HS * 2);
  p.Wout = (bf16_t*)take((size_t)DEPTH * D * HS * 2);
  p.Wup = (bf16_t*)take((size_t)DEPTH * 2 * DFFP * HS * 2);
  p.Wdn = (bf16_t*)take((size_t)DEPTH * D * DFFP * 2);
  p.bupP = (float*)take((size_t)DEPTH * 2 * DFFP * 4);
  p.cwP = (float*)take((size_t)DEPTH * 6 * DFFP * 4);
  p.cbP = (float*)take((size_t)DEPTH * 2 * DFFP * 4);
  p.Wfn = (bf16_t*)take((size_t)DEPTH * 256 * 256 * 2);
  p.mod = (float*)take((size_t)DEPTH * 9 * 6144 * 4);
  p.Khat = (float2*)take((size_t)DEPTH * 256 * 2 * SEQ * 8);
  p.Khatc = (float2*)take((size_t)DEPTH * 256 * 2 * CL * 8);
  p.cx = (float*)take((size_t)TC * D * 4);
  p.HO = (bf16_t*)take((size_t)(MROWS + 256) * HS * 2);
  p.Y = (bf16_t*)take((size_t)MROWS * D * 2);
  const size_t r0 = off;
  p.Zq = (bf16_t*)take((size_t)MROWS * HS * 2);
  p.ZT = (float*)take((size_t)NB * 1024 * SEQ * 4);
  p.ZTc = (float*)take((size_t)NB * 1024 * CL * 4);
  p.VT = (bf16_t*)take((size_t)2 * NB * 2 * 64 * LV * 2);
  p.F = (bf16_t*)take((size_t)MROWS * 256 * 2);
  const size_t r1 = off;
  p.ACT = (bf16_t*)(w + r0);
  p.kvec = (float*)(w + r0);
  p.kvecc = (float*)(w + r0 + (size_t)DEPTH * 256 * 2 * SEQ * 4);
  const size_t act_end = r0 + (size_t)MROWS * DFFP * 2;
  if (act_end > off) off = act_end;
  (void)r1;
  if (off > ws_size) fprintf(stderr, "workspace too small: need %zu have %zu\n", off, ws_size);
  static int grid_blocks = 0;
  if (!grid_blocks) {
    (void)hipFuncSetAttribute((const void*)fwd_megakernel, hipFuncAttributeMaxDynamicSharedMemorySize, (int)LDS_BYTES);
    int dev = 0, cus = 0, per_cu = 0;
    (void)hipGetDevice(&dev);
    (void)hipDeviceGetAttribute(&cus, hipDeviceAttributeMultiprocessorCount, dev);
    (void)hipOccupancyMaxActiveBlocksPerMultiprocessor(&per_cu, fwd_megakernel, NTHR, LDS_BYTES);
    if (per_cu > 1) per_cu = 1;
    grid_blocks = cus * per_cu;
  }
  void* args[] = {&p};
  hipError_t e = hipLaunchCooperativeKernel((void*)fwd_megakernel, dim3(grid_blocks), dim3(NTHR), args, LDS_BYTES, stream);
  if (e != hipSuccess) fprintf(stderr, "cooperative launch failed: %s (grid %d)\n", hipGetErrorString(e), grid_blocks);
}
```

```cpp
#include <hip/hip_runtime.h>
#include <hip/hip_cooperative_groups.h>
#include <stdint.h>
#include <cstdio>
namespace cg = cooperative_groups;

typedef unsigned short bf16_t;
typedef short bf16x8 __attribute__((ext_vector_type(8)));
typedef float f32x4 __attribute__((ext_vector_type(4)));
typedef float f32x16 __attribute__((ext_vector_type(16)));
typedef __bf16 bf2_t __attribute__((ext_vector_type(2)));
typedef float f2_t __attribute__((ext_vector_type(2)));

#define DI __device__ __forceinline__
typedef unsigned u32x2 __attribute__((ext_vector_type(2)));

constexpr int D = 1024, NB = 8, SEQ = 8192, DEPTH = 4, CL = 256;
constexpr int T = NB * SEQ, TC = NB * CL, MROWS = T + TC;
constexpr int DP = 2048, DFF = 2752, DFF2 = 5504, DFFP = 2816;
constexpr int LV = SEQ + CL + 64;
constexpr int HS = 1088;
constexpr int NTHR = 512;
constexpr float ALPHA = 1.681792830507429f;
constexpr float LOG2E = 1.4426950408889634f;
constexpr float INV2PI = 0.15915494309189535f;
constexpr size_t LDS_BYTES = 135168;
#ifndef PROBE_MIX
#define PROBE_MIX 0
#endif
#ifndef PROBE_DUP
#define PROBE_DUP 0x000
#endif

struct Params {
  const float *x, *c, *ctx, *c_ctx, *w_ada, *b_ada, *w_in, *sink_a, *q_norm_g, *k_norm_g,
      *hy_conv_w, *hy_conv_b, *hy_f_w1, *hy_f_b1, *hy_f_freq, *hy_f_w2, *hy_f_b2, *hy_f_w3, *hy_skip,
      *fnet_w, *fnet_b, *out_norm_g, *w_out, *b_out, *ln1_g, *ln1_b, *ffn_w_up, *ffn_b_up, *ffn_conv_w, *ffn_conv_b,
      *ffn_w_down, *ffn_b_down, *ln2_g, *ln2_b;
  float* out;
  bf16_t *Win, *Wout, *Wup, *Wdn, *Wfn;
  float* mod;
  float2 *Khat, *Khatc;
  float* cx;
  bf16_t *HO, *Y, *Zq;
  float *ZT, *ZTc;
  bf16_t *VT, *F;
  float *kvec, *kvecc;
  bf16_t* ACT;
  float *bupP, *cwP, *cbP;
  unsigned* bar;
};

DI int tidx() { int t = threadIdx.x; asm volatile("" : "+v"(t)); return t; }
DI unsigned pack2(float a, float b) {
  f2_t v = {a, b};
  bf2_t r = __builtin_convertvector(v, bf2_t);
  return __builtin_bit_cast(unsigned, r);
}
DI bf16_t f2bf(float a) { return (bf16_t)(pack2(a, 0.f) & 0xffffu); }
DI float bf2f(unsigned h) { return __uint_as_float(h << 16); }
DI float sin_rev(float r) { return __builtin_amdgcn_sinf(r); }
DI float cos_rev(float r) { return __builtin_amdgcn_cosf(r); }
#define dpp_f(v, ctrl, row_mask) __builtin_bit_cast(float, __builtin_amdgcn_update_dpp(0, __builtin_bit_cast(int, (float)(v)), (ctrl), (row_mask), 0xf, false))
DI float row16_sum(float v) {
  v += dpp_f(v, 0xB1, 0xf);
  v += dpp_f(v, 0x4E, 0xf);
  v += dpp_f(v, 0x141, 0xf);
  v += dpp_f(v, 0x140, 0xf);
  return v;
}
DI float wave_sum(float v) {
  v = row16_sum(v);
  v += dpp_f(v, 0x142, 0xa);
  v += dpp_f(v, 0x143, 0xc);
  return __builtin_bit_cast(float, __builtin_amdgcn_readlane(__builtin_bit_cast(int, v), 63));
}
DI float siluf(float x) { return x * __builtin_amdgcn_rcpf(1.f + __builtin_amdgcn_exp2f(-1.4426950408889634f * x)); }

DI int grid8() { return (int)(gridDim.x & ~7u); }
DI int xcd_local(int it, int per_xcd) {
  const int G8 = grid8();
  if ((int)blockIdx.x >= G8) return -1;
  const int loc = it * (G8 >> 3) + ((int)blockIdx.x >> 3);
  return loc < per_xcd ? loc : -1;
}
DI bool tile_map(int it, int MT, int NTn, int& mt, int& nt) {
  const int G8 = grid8();
  if ((int)blockIdx.x >= G8) return false;
  const int xcd = blockIdx.x & 7, slot = blockIdx.x >> 3, SL = G8 >> 3;
  const int MTx = (MT - xcd + 7) >> 3;
  const int q = it * SL + slot;
  if (q >= MTx * NTn) return false;
  const int gm = q / (4 * NTn), rem = q - gm * 4 * NTn;
  int gsz = MTx - 4 * gm;
  if (gsz > 4) gsz = 4;
  nt = rem / gsz;
  mt = xcd + 8 * (gm * 4 + rem % gsz);
  return true;
}

typedef __attribute__((address_space(3))) unsigned char lds_uc;
constexpr int HTB = 16384;
DI int lds_byte(int r, int c) {
  const int st = (r >> 4) * 2 + (c >> 5), rr = r & 15, cc = c & 31, ob = rr * 64 + cc * 2;
  return st * 1024 + (ob ^ (((ob >> 9) & 1) << 5));
}
DI void stage_rc(int b, int& R, int& C) {
  const int st = b >> 10, sb = b & 1023, swz = sb ^ (((sb >> 9) & 1) << 5);
  R = (st >> 1) * 16 + (swz >> 6);
  C = (st & 1) * 32 + ((swz & 63) >> 1);
}
struct PgUnit { const char* A; const char* B; int mt, nt; };
struct PgDesc { size_t a_h, b_h; int nk; unsigned voffA, voffB; size_t dA, dB; };
#define PG_WAIT_V(n) asm volatile("s_waitcnt vmcnt(" #n ")" ::: "memory")
#define PG_WAIT_L(n) asm volatile("s_waitcnt lgkmcnt(" #n ")" ::: "memory")
#define PG_BAR __builtin_amdgcn_s_barrier()
#define PG_SCHED __builtin_amdgcn_sched_barrier(0)

template <class Src, class Epi>
DI void pgemm(char* lds_, const PgDesc& d, const Src& src, const Epi& epi) {
  lds_uc* lds = (lds_uc*)lds_;
  const int tid = tidx(), wid = __builtin_amdgcn_readfirstlane(tid >> 6), lane = tid & 63, wr = wid >> 2, wc = wid & 3, fr = lane & 15, fq = lane >> 4;
  const int nt = d.nk;
  const size_t kstep = 128, ah = d.a_h, bh = d.b_h, voffA_d = d.dA, voffB_d = d.dB;
  const unsigned voffA = d.voffA, voffB = d.voffB;
  const unsigned ldsw = (unsigned)wid * 1024u;
  const int aoff = lds_byte(wr * 64 + fr, fq * 8), boff = lds_byte(wc * 32 + fr, fq * 8);
#define PG_SA(b, h) (((b) * 2 + (h)) * HTB)
#define PG_SB(b, h) ((4 + (b) * 2 + (h)) * HTB)
#define PG_STAGE(bufoff, gbase, voff) do { _Pragma("unroll") for (int _i = 0; _i < 2; ++_i) \
    __builtin_amdgcn_global_load_lds((const unsigned*)((const char*)(gbase) + (size_t)_i * voff##_d + voff), (__attribute__((address_space(3))) unsigned*)(lds + (bufoff) + ldsw + _i * 8192), 16, 0, 0); } while (0)
#define PG_LDA(dst, b, h) do { _Pragma("unroll") for (int m = 0; m < 4; ++m) _Pragma("unroll") for (int k = 0; k < 2; ++k) dst[m][k] = *(const __attribute__((address_space(3))) bf16x8*)(lds + PG_SA(b, h) + aoff + m * 2048 + k * 1024); } while (0)
#define PG_LDB(dst, b, h) do { _Pragma("unroll") for (int n = 0; n < 2; ++n) _Pragma("unroll") for (int k = 0; k < 2; ++k) dst[n][k] = *(const __attribute__((address_space(3))) bf16x8*)(lds + PG_SB(b, h) + boff + n * 2048 + k * 1024); } while (0)
#define PG_MMA(ai, bj, At, Bt) do { __builtin_amdgcn_s_setprio(1); _Pragma("unroll") for (int m = 0; m < 4; ++m) _Pragma("unroll") for (int n = 0; n < 2; ++n) _Pragma("unroll") for (int k = 0; k < 2; ++k) \
    acc[ai][bj][m][n] = __builtin_amdgcn_mfma_f32_16x16x32_bf16(Bt[n][k], At[m][k], acc[ai][bj][m][n], 0, 0, 0); __builtin_amdgcn_s_setprio(0); } while (0)
  PgUnit cur, nxt;
  int ui = 0;
  if (!src.next(0, cur)) return;
  f32x4 acc[2][2][4][2];
#pragma unroll
  for (int a = 0; a < 2; ++a)
#pragma unroll
    for (int b = 0; b < 2; ++b)
#pragma unroll
      for (int m = 0; m < 4; ++m)
#pragma unroll
        for (int n = 0; n < 2; ++n) acc[a][b][m][n] = (f32x4){0.f, 0.f, 0.f, 0.f};
  bf16x8 At[4][2], B0[2][2], B1[2][2];
  const char* cA = cur.A;
  const char* cB = cur.B;
  PG_WAIT_V(0);
  PG_STAGE(PG_SB(0, 0), cB, voffB); PG_STAGE(PG_SA(0, 0), cA, voffA); PG_STAGE(PG_SB(0, 1), cB + bh, voffB); PG_STAGE(PG_SA(0, 1), cA + ah, voffA);
  if (wr == 1) PG_BAR;
  PG_WAIT_V(4); PG_BAR;
  PG_STAGE(PG_SB(1, 0), cB + kstep, voffB); PG_STAGE(PG_SA(1, 0), cA + kstep, voffA); PG_STAGE(PG_SB(1, 1), cB + bh + kstep, voffB);
  PG_WAIT_V(6); PG_BAR;
  for (;;) {
    const bool has_next = src.next(ui + 1, nxt);
    const char* nA = has_next ? nxt.A : cA;
    const char* nB = has_next ? nxt.B : cB;
    for (int t = 0; t < nt; t += 2) {
      const bool last = (t == nt - 2);
      const char* a1 = cA + (size_t)(t + 1) * kstep;
      const char* a2 = last ? nA : cA + (size_t)(t + 2) * kstep;
      const char* b2 = last ? nB : cB + (size_t)(t + 2) * kstep;
      const char* a3 = a2 + kstep;
      const char* b3 = b2 + kstep;
      PG_LDB(B0, 0, 0); PG_SCHED; PG_LDA(At, 0, 0); PG_STAGE(PG_SA(1, 1), a1 + ah, voffA);
      PG_WAIT_L(8); PG_BAR; PG_WAIT_L(0); PG_MMA(0, 0, At, B0); PG_BAR; PG_SCHED;
      PG_LDB(B1, 0, 1); PG_STAGE(PG_SB(0, 0), b2, voffB);
      PG_BAR; PG_WAIT_L(0); PG_MMA(0, 1, At, B1); PG_BAR;
      PG_LDA(At, 0, 1); PG_STAGE(PG_SA(0, 0), a2, voffA);
      PG_BAR; PG_WAIT_L(0); PG_MMA(1, 0, At, B0); PG_BAR; PG_SCHED;
      PG_STAGE(PG_SB(0, 1), b2 + bh, voffB);
      PG_WAIT_V(6); PG_BAR; PG_MMA(1, 1, At, B1); PG_BAR;
      PG_LDB(B0, 1, 0); PG_SCHED; PG_LDA(At, 1, 0); PG_STAGE(PG_SA(0, 1), a2 + ah, voffA);
      PG_WAIT_L(8); PG_BAR; PG_WAIT_L(0); PG_MMA(0, 0, At, B0); PG_BAR; PG_SCHED;
      PG_LDB(B1, 1, 1); PG_STAGE(PG_SB(1, 0), b3, voffB);
      PG_BAR; PG_WAIT_L(0); PG_MMA(0, 1, At, B1); PG_BAR;
      PG_LDA(At, 1, 1); PG_STAGE(PG_SA(1, 0), a3, voffA);
      PG_BAR; PG_WAIT_L(0); PG_MMA(1, 0, At, B0); PG_BAR; PG_SCHED;
      PG_STAGE(PG_SB(1, 1), b3 + bh, voffB);
      PG_WAIT_V(6); PG_BAR; PG_MMA(1, 1, At, B1); PG_BAR;
    }
    epi(acc, cur, wr, wc, fr, fq);
    if (!has_next) break;
#pragma unroll
    for (int a = 0; a < 2; ++a)
#pragma unroll
      for (int b = 0; b < 2; ++b)
#pragma unroll
        for (int m = 0; m < 4; ++m)
#pragma unroll
          for (int n = 0; n < 2; ++n) acc[a][b][m][n] = (f32x4){0.f, 0.f, 0.f, 0.f};
    cur = nxt; cA = nA; cB = nB; ++ui;
  }
  PG_WAIT_V(0);
  if (wr == 0) PG_BAR;
  PG_BAR;
#undef PG_SA
#undef PG_SB
#undef PG_STAGE
#undef PG_LDA
#undef PG_LDB
#undef PG_MMA
}

struct PlainSrc {
  const bf16_t* A; const bf16_t* Wt; int lda, ldw, MT, NTn, rev;
  DI bool next(int i, PgUnit& u) const {
    if (!tile_map(i, MT, NTn, u.mt, u.nt)) return false;
    if (rev) u.mt = MT - 1 - u.mt;
    u.A = (const char*)(A + (size_t)u.mt * 256 * lda);
    u.B = (const char*)(Wt + (size_t)u.nt * 256 * ldw);
    return true;
  }
};
struct PlainEpi {
  const float* bias; bf16_t* out; int ldo, ocol0;
  DI void operator()(f32x4 (&acc)[2][2][4][2], const PgUnit& u, int wr, int wc, int fr, int fq) const {
    asm volatile("" : "+v"(fr), "+v"(fq));
#pragma unroll
    for (int bj = 0; bj < 2; ++bj)
#pragma unroll
      for (int n = 0; n < 2; ++n) {
        const int col = u.nt * 256 + bj * 128 + wc * 32 + n * 16 + fq * 4;
        const float4 bv = *(const float4*)(bias + col);
#pragma unroll
        for (int ai = 0; ai < 2; ++ai)
#pragma unroll
          for (int m = 0; m < 4; ++m) {
            const int row = u.mt * 256 + ai * 128 + wr * 64 + m * 16 + fr;
            uint2 w;
            w.x = pack2(acc[ai][bj][m][n][0] + bv.x, acc[ai][bj][m][n][1] + bv.y);
            w.y = pack2(acc[ai][bj][m][n][2] + bv.z, acc[ai][bj][m][n][3] + bv.w);
            *(uint2*)(out + (size_t)row * ldo + ocol0 + col) = w;
          }
      }
  }
};
DI void gemm_plain_phase(char* lds, const bf16_t* A, int lda, const bf16_t* Wt, int ldw, int K, int MT, int NTn, const float* bias,
                         bf16_t* out, int ldo, int ocol0, int rev) {
  PgDesc d;
  d.a_h = (size_t)128 * lda * 2; d.b_h = (size_t)128 * ldw * 2; d.nk = K / 64;
  {
    int R, C;
    stage_rc(tidx() * 16, R, C);
    d.voffA = (unsigned)(R * lda + C) * 2u; d.dA = (size_t)64 * lda * 2;
    d.voffB = (unsigned)(R * ldw + C) * 2u; d.dB = (size_t)64 * ldw * 2;
  }
  PlainSrc src{A, Wt, lda, ldw, MT, NTn, rev};
  PlainEpi epi{bias, out, ldo, ocol0};
  pgemm(lds, d, src, epi);
}

struct InprojSrc {
  const bf16_t* A; const bf16_t* Wt;
  DI bool next(int i, PgUnit& u) const {
    if (!tile_map(i, MROWS / 256, DP / 256, u.mt, u.nt)) return false;
    u.A = (const char*)(A + (size_t)u.mt * 256 * HS);
    u.B = (const char*)(Wt + (size_t)u.nt * 256 * HS);
    return true;
  }
};
struct InprojEpi {
  const Params* pp; int l;
  DI void operator()(f32x4 (&acc)[2][2][4][2], const PgUnit& u, int wr, int wc, int fr, int fq) const {
    asm volatile("" : "+v"(fr), "+v"(fq));
    const Params& p = *pp;
    const int mt = u.mt, hs = u.nt * 4 + wc;
    const bool isctx = mt >= 256;
    int b, t0;
    if (!isctx) { const int row0 = mt * 256; b = row0 >> 13; t0 = row0 & (SEQ - 1); }
    else { b = mt - 256; t0 = 0; }
    const int rb = wr * 64 + fr;
    if (hs < 6 || (hs >= 8 && hs < 14)) {
      const bool isB = hs >= 8;
      const int hh = isB ? hs - 8 : hs;
      const bool isq = hh < 4;
      if (isB) {
        const float* gp = (isq ? p.q_norm_g : p.k_norm_g) + l * 64 + fq * 4;
        const float4 g00 = *(const float4*)(gp), g01 = *(const float4*)(gp + 16), g10 = *(const float4*)(gp + 32), g11 = *(const float4*)(gp + 48);
#pragma unroll
        for (int ai = 0; ai < 2; ++ai)
#pragma unroll
          for (int m = 0; m < 4; ++m) {
            float ss = 0.f;
#pragma unroll
            for (int bj = 0; bj < 2; ++bj)
#pragma unroll
              for (int n = 0; n < 2; ++n)
#pragma unroll
                for (int j = 0; j < 4; ++j) ss += acc[ai][bj][m][n][j] * acc[ai][bj][m][n][j];
            ss += __shfl_xor(ss, 16, 64); ss += __shfl_xor(ss, 32, 64);
            const float r = rsqrtf(ss * (1.f / 64.f) + 1e-6f);
            acc[ai][0][m][0] *= (f32x4){g00.x * r, g00.y * r, g00.z * r, g00.w * r};
            acc[ai][0][m][1] *= (f32x4){g01.x * r, g01.y * r, g01.z * r, g01.w * r};
            acc[ai][1][m][0] *= (f32x4){g10.x * r, g10.y * r, g10.z * r, g10.w * r};
            acc[ai][1][m][1] *= (f32x4){g11.x * r, g11.y * r, g11.z * r, g11.w * r};
            __builtin_amdgcn_sched_barrier(0);
          }
      }
      if (!isctx) {
        float inv[4];
#pragma unroll
        for (int j = 0; j < 4; ++j) inv[j] = exp2f(-(float)(fq * 4 + j) * (13.287712379549449f / 16.f)) * INV2PI;
#pragma unroll
        for (int ai = 0; ai < 2; ++ai)
#pragma unroll
          for (int m = 0; m < 4; ++m) {
            const int t = t0 + ai * 128 + rb + m * 16;
            const float p0 = (float)(t >> 6), p1 = (float)(t & 63);
#pragma unroll
            for (int j = 0; j < 4; ++j) {
              const float a0 = p0 * inv[j], a1 = p1 * inv[j];
              const float c0 = cos_rev(a0), s0 = sin_rev(a0), c1 = cos_rev(a1), s1 = sin_rev(a1);
              const float x1 = acc[ai][0][m][0][j], x2 = acc[ai][0][m][1][j], y1 = acc[ai][1][m][0][j], y2 = acc[ai][1][m][1][j];
              acc[ai][0][m][0][j] = x1 * c0 - x2 * s0; acc[ai][0][m][1][j] = x2 * c0 + x1 * s0;
              acc[ai][1][m][0][j] = y1 * c1 - y2 * s1; acc[ai][1][m][1][j] = y2 * c1 + y1 * s1;
            }
            __builtin_amdgcn_sched_barrier(0);
          }
      }
      const float sc = isq ? 0.125f * LOG2E : 1.f;
#pragma unroll
      for (int ai = 0; ai < 2; ++ai)
#pragma unroll
        for (int m = 0; m < 4; ++m) {
          bf16_t* zr = p.Zq + (size_t)(mt * 256 + ai * 128 + rb + m * 16) * HS + hs * 64 + fq * 4;
#pragma unroll
          for (int bj = 0; bj < 2; ++bj)
#pragma unroll
            for (int n = 0; n < 2; ++n) {
              uint2 w;
              w.x = pack2(acc[ai][bj][m][n][0] * sc, acc[ai][bj][m][n][1] * sc);
              w.y = pack2(acc[ai][bj][m][n][2] * sc, acc[ai][bj][m][n][3] * sc);
              *(uint2*)(zr + bj * 32 + n * 16) = w;
            }
        }
    } else if (hs < 16) {
      const int grp = hs >= 14 ? 1 : 0, kvh = hs & 1;
      bf16_t* vb = p.VT + (size_t)((grp * 8 + b) * 2 + kvh) * 64 * LV + (isctx ? SEQ : 0) + t0 + rb;
#pragma unroll
      for (int bj = 0; bj < 2; ++bj)
#pragma unroll
        for (int n = 0; n < 2; ++n)
#pragma unroll
          for (int j = 0; j < 4; ++j) {
            bf16_t* vd = vb + (size_t)(bj * 32 + n * 16 + fq * 4 + j) * LV;
#pragma unroll
            for (int ai = 0; ai < 2; ++ai)
#pragma unroll
              for (int m = 0; m < 4; ++m) vd[ai * 128 + m * 16] = f2bf(acc[ai][bj][m][n][j]);
          }
    } else {
      const int colb = hs * 64 - 1024;
      const int Ls = isctx ? CL : SEQ;
      float* zb = (isctx ? p.ZTc + (size_t)b * 1024 * CL : p.ZT + (size_t)b * 1024 * SEQ) + t0 + rb;
#pragma unroll
      for (int bj = 0; bj < 2; ++bj)
#pragma unroll
        for (int n = 0; n < 2; ++n)
#pragma unroll
          for (int j = 0; j < 4; ++j) {
            float* zd = zb + (size_t)(colb + bj * 32 + n * 16 + fq * 4 + j) * Ls;
#pragma unroll
            for (int ai = 0; ai < 2; ++ai)
#pragma unroll
              for (int m = 0; m < 4; ++m) __builtin_nontemporal_store(acc[ai][bj][m][n][j], zd + ai * 128 + m * 16);
          }
    }
  }
};
DI void inproj_phase(const Params& p, int l, char* lds) {
  PgDesc d;
  d.a_h = (size_t)128 * HS * 2; d.b_h = (size_t)32 * HS * 2; d.nk = D / 64;
  {
    int R, C;
    stage_rc(tidx() * 16, R, C);
    d.voffA = (unsigned)(R * HS + C) * 2u; d.dA = (size_t)64 * HS * 2;
    d.voffB = (unsigned)(((R >> 5) * 64 + (R & 31)) * HS + C) * 2u; d.dB = (size_t)128 * HS * 2;
  }
  InprojSrc src{p.HO, p.Win + (size_t)l * DP * HS};
  InprojEpi epi{&p, l};
  pgemm(lds, d, src, epi);
}

DI float dpp_ror1(float v) { return __builtin_bit_cast(float, __builtin_amdgcn_update_dpp(0, __builtin_bit_cast(int, v), 0x121, 0xf, 0xf, false)); }
DI float dpp_rol1(float v) { return __builtin_bit_cast(float, __builtin_amdgcn_update_dpp(0, __builtin_bit_cast(int, v), 0x12f, 0xf, 0xf, false)); }
DI float row_prev(float prevreg, float cur) {
  return __builtin_bit_cast(float, __builtin_amdgcn_update_dpp(__builtin_bit_cast(int, dpp_ror1(prevreg)), __builtin_bit_cast(int, cur), 0x111, 0xf, 0xf, false));
}
DI float row_next(float nextreg, float cur) {
  return __builtin_bit_cast(float, __builtin_amdgcn_update_dpp(__builtin_bit_cast(int, dpp_rol1(nextreg)), __builtin_bit_cast(int, cur), 0x101, 0xf, 0xf, false));
}
constexpr int FUP_MT = 8 * 33 + 8 * 2, FUP_NT = DFFP / 128;
DI void ffn_tile(int mt, int& Ls, int& rowbase, int& ti) {
  if (mt < 264) { const int b = mt / 33; ti = mt - b * 33; Ls = SEQ; rowbase = b * SEQ; }
  else { const int q = mt - 264; const int b = q >> 1; ti = q & 1; Ls = CL; rowbase = T + b * CL; }
}
struct FfnUpSrc {
  const bf16_t* A; const bf16_t* Wt; int MT;
  DI bool next(int i, PgUnit& u) const {
    if (!tile_map(i, MT, FUP_NT, u.mt, u.nt)) return false;
    int Ls, rowbase, ti;
    ffn_tile(u.mt, Ls, rowbase, ti);
    u.A = (const char*)(A + ((long)rowbase + 252 * ti - 1) * HS);
    u.B = (const char*)(Wt + (size_t)u.nt * 128 * HS);
    return true;
  }
};
struct FfnUpEpi {
  const float *bup, *cw, *cb; bf16_t* act;
  DI void operator()(f32x4 (&acc)[2][2][4][2], const PgUnit& u, int wr, int wc, int fr, int fq) const {
    asm volatile("" : "+v"(fr), "+v"(fq));
    int Ls, rowbase, ti;
    ffn_tile(u.mt, Ls, rowbase, ti);
    const int tw = 252 * ti - 1 + 126 * wr;
    bf16_t* ob = act + (size_t)rowbase * DFFP;
#pragma unroll
    for (int n = 0; n < 2; ++n)
#pragma unroll
      for (int jp = 0; jp < 2; ++jp) {
        int col = u.nt * 128 + wc * 32 + n * 16 + fq * 4 + jp * 2;
        asm volatile("" : "+v"(col) :: "memory");
        float oo[8][2];
#pragma unroll
        for (int jj = 0; jj < 2; ++jj) {
          const int j = jp * 2 + jj, c = col + jj;
          {
            const float bu = bup[c], w0 = cw[c], w1 = cw[2 * DFFP + c], w2 = cw[4 * DFFP + c], bb = cb[c];
            float ua[8];
#pragma unroll
            for (int q = 0; q < 8; ++q) {
              const int t = tw + fr * 8 + q;
              ua[q] = (t >= 0 && t < Ls) ? acc[q >> 2][0][q & 3][n][j] + bu : 0.f;
            }
            const float upl = __builtin_bit_cast(float, __builtin_amdgcn_update_dpp(0, __builtin_bit_cast(int, ua[7]), 0x111, 0xf, 0xf, false));
            const float dnl = __builtin_bit_cast(float, __builtin_amdgcn_update_dpp(0, __builtin_bit_cast(int, ua[0]), 0x101, 0xf, 0xf, false));
#pragma unroll
            for (int q = 0; q < 8; ++q) {
              const float up = q > 0 ? ua[q > 0 ? q - 1 : 0] : upl;
              const float dn = q < 7 ? ua[q < 7 ? q + 1 : 7] : dnl;
              oo[q][jj] = siluf(w0 * up + w1 * ua[q] + w2 * dn + bb);
            }
          }
          {
            const float bu = bup[DFFP + c], w0 = cw[DFFP + c], w1 = cw[3 * DFFP + c], w2 = cw[5 * DFFP + c], bb = cb[DFFP + c];
            float ug[8];
#pragma unroll
            for (int q = 0; q < 8; ++q) {
              const int t = tw + fr * 8 + q;
              ug[q] = (t >= 0 && t < Ls) ? acc[q >> 2][1][q & 3][n][j] + bu : 0.f;
            }
            const float upl = __builtin_bit_cast(float, __builtin_amdgcn_update_dpp(0, __builtin_bit_cast(int, ug[7]), 0x111, 0xf, 0xf, false));
            const float dnl = __builtin_bit_cast(float, __builtin_amdgcn_update_dpp(0, __builtin_bit_cast(int, ug[0]), 0x101, 0xf, 0xf, false));
#pragma unroll
            for (int q = 0; q < 8; ++q) {
              const float up = q > 0 ? ug[q > 0 ? q - 1 : 0] : upl;
              const float dn = q < 7 ? ug[q < 7 ? q + 1 : 7] : dnl;
              oo[q][jj] *= (w0 * up + w1 * ug[q] + w2 * dn + bb);
            }
          }
        }
#pragma unroll
        for (int q = 0; q < 8; ++q) {
          const int lr = fr * 8 + q;
          const int t = tw + lr;
          if (lr >= 1 && lr <= 126 && t < Ls) *(unsigned*)(ob + (size_t)t * DFFP + col) = pack2(oo[q][0], oo[q][1]);
        }
        __builtin_amdgcn_sched_barrier(0);
      }
  }
};
DI void ffn_up_phase(const Params& p, int l, char* lds) {
  PgDesc d;
  d.a_h = (size_t)4 * HS * 2; d.b_h = (size_t)DFFP * HS * 2; d.nk = D / 64;
  {
    int R, C;
    stage_rc(tidx() * 16, R, C);
    d.voffA = (unsigned)(((R & 15) * 8 + (R >> 4)) * HS + C) * 2u; d.dA = (size_t)126 * HS * 2;
    d.voffB = (unsigned)(R * HS + C) * 2u; d.dB = (size_t)64 * HS * 2;
  }
  FfnUpSrc src{p.HO, p.Wup + (size_t)l * 2 * DFFP * HS, l == DEPTH - 1 ? 264 : FUP_MT};
  FfnUpEpi epi{p.bupP + (size_t)l * 2 * DFFP, p.cwP + (size_t)l * 6 * DFFP, p.cbP + (size_t)l * 2 * DFFP, p.ACT};
  pgemm(lds, d, src, epi);
}

DI int crow(int i, int h) { return (i & 3) + 8 * (i >> 2) + 4 * h; }
template <bool FIXED>
DI void attn_item(const Params& p, int l, char* lds, int grp, int b, int kvh, int qrow0, int qpos0, int jfirst, int nloc,
                  bool window) {
  const int tid = tidx(), lane = tid & 63, wave = tid >> 6, g = wave >> 2, qw = wave & 3;
  const int q31 = lane & 31, h = lane >> 5;
  const int head = kvh * 2 + g;
  const int qcol = (grp ? 512 : 0) + head * 64, kcol = (grp ? 768 : 256) + kvh * 64;
  const bf16_t* Zq = p.Zq;
  bf16x8 qf[4];
  {
    const bf16_t* qp = Zq + (size_t)(qrow0 + qw * 32 + q31) * HS + qcol + h * 8;
#pragma unroll
    for (int kk = 0; kk < 4; ++kk) qf[kk] = *(const bf16x8*)(qp + kk * 16);
  }
  const bf16_t* vt = p.VT + (size_t)((grp * 8 + b) * 2 + kvh) * 64 * LV;
  float m_run, l_run;
  if (grp == 0) { m_run = p.sink_a[l * 4 + head] * LOG2E; l_run = 1.f; }
  else { m_run = -1e30f; l_run = 0.f; }
  if (FIXED) {
    float gq = fabsf(p.q_norm_g[l * 64 + lane]), gk = fabsf(p.k_norm_g[l * 64 + lane]);
#pragma unroll
    for (int m = 32; m >= 1; m >>= 1) { gq = fmaxf(gq, __shfl_xor(gq, m, 64)); gk = fmaxf(gk, __shfl_xor(gk, m, 64)); }
    m_run = 8.f * LOG2E * gq * gk * 1.001f + 0.01f;
  }
  f32x16 O0, O1;
#pragma unroll
  for (int i = 0; i < 16; ++i) { O0[i] = 0.f; O1[i] = 0.f; }
  const int ntiles = nloc + 4;
  const int srow = tid >> 3, sch = tid & 7;
  char* Kl = lds;
  char* Vl = lds + 4 * 9216;
  uint4 rkA, rvA, rkB, rvB;
#define TILEJ(ti) ((ti) < nloc ? jfirst + (ti) * 64 : SEQ + ((ti) - nloc) * 64)
#define AGLOAD(rk, rv, ti)                                                                                 \
  {                                                                                                        \
    const int j_ = TILEJ(ti);                                                                              \
    const int key_ = j_ + srow;                                                                            \
    const size_t krow_ = key_ < SEQ ? (size_t)b * SEQ + key_ : (size_t)T + (size_t)b * CL + (key_ - SEQ);  \
    rk = *(const uint4*)(Zq + krow_ * HS + kcol + sch * 8);                                                \
    rv = *(const uint4*)(vt + (size_t)srow * LV + j_ + sch * 8);                                           \
  }
#define ASWRITE(rk, rv, slot)                                                                              \
  {                                                                                                        \
    *(uint4*)(Kl + (slot) * 9216 + srow * 144 + sch * 16) = rk;                                            \
    uint2* vp_ = (uint2*)(Vl + (slot) * 8704 + srow * 136 + sch * 16);                                     \
    vp_[0] = make_uint2(rv.x, rv.y);                                                                       \
    vp_[1] = make_uint2(rv.z, rv.w);                                                                       \
  }
  AGLOAD(rkA, rvA, 0);
  AGLOAD(rkB, rvB, 1);
  ASWRITE(rkA, rvA, 0);
  ASWRITE(rkB, rvB, 1);
  __syncthreads();
  const int qpos = qpos0 + qw * 32 + q31;
  int s0 = 0;
#pragma unroll 1
  for (int ti = 0; ti < ntiles; ti += 2) {
    const int s1 = s0 + 1, s2 = 2 - s0;
    if (ti + 2 < ntiles) { AGLOAD(rkA, rvA, ti + 2); AGLOAD(rkB, rvB, ti + 3); }
    {
      const int tcur = ti;
      const char* kb = Kl + s0 * 9216;
      const char* vb = Vl + s0 * 8704;
    f32x16 S0, S1;
    const float sinit = FIXED ? -m_run : 0.f;
#pragma unroll
    for (int i = 0; i < 16; ++i) { S0[i] = sinit; S1[i] = sinit; }
    bf16x8 kf[8];
    union { uint2 u[2]; bf16x8 v; } vfr[8];
#pragma unroll
    for (int kk = 0; kk < 4; ++kk) {
      kf[2 * kk] = *(const bf16x8*)(kb + q31 * 144 + kk * 32 + h * 16);
      kf[2 * kk + 1] = *(const bf16x8*)(kb + (32 + q31) * 144 + kk * 32 + h * 16);
    }
#pragma unroll
    for (int c = 0; c < 4; ++c)
#pragma unroll
      for (int ds = 0; ds < 2; ++ds) {
        const char* vp = vb + (ds * 32 + q31) * 136 + (16 * c + h * 4) * 2;
        vfr[c * 2 + ds].u[0] = *(const uint2*)vp;
        vfr[c * 2 + ds].u[1] = *(const uint2*)(vp + 16);
      }
    __builtin_amdgcn_sched_barrier(0);
#pragma unroll
    for (int kk = 0; kk < 4; ++kk) {
      S0 = __builtin_amdgcn_mfma_f32_32x32x16_bf16(kf[2 * kk], qf[kk], S0, 0, 0, 0);
      S1 = __builtin_amdgcn_mfma_f32_32x32x16_bf16(kf[2 * kk + 1], qf[kk], S1, 0, 0, 0);
    }
    const int j = TILEJ(tcur);
    if (window && j < SEQ) {
#pragma unroll
      for (int i = 0; i < 16; ++i) {
        const int kp = j + crow(i, h);
        int d0 = kp - qpos; d0 = d0 < 0 ? -d0 : d0;
        int d1 = kp + 32 - qpos; d1 = d1 < 0 ? -d1 : d1;
        S0[i] = d0 <= 128 ? S0[i] : -1e30f;
        S1[i] = d1 <= 128 ? S1[i] : -1e30f;
      }
    }
    if (FIXED) {
      float rs = 0.f;
#pragma unroll
      for (int i = 0; i < 16; ++i) {
        S0[i] = __builtin_amdgcn_exp2f(S0[i]);
        S1[i] = __builtin_amdgcn_exp2f(S1[i]);
        rs += S0[i] + S1[i];
      }
      l_run += rs;
    } else {
      float mx = S0[0];
#pragma unroll
      for (int i = 1; i < 16; ++i) mx = fmaxf(mx, S0[i]);
#pragma unroll
      for (int i = 0; i < 16; ++i) mx = fmaxf(mx, S1[i]);
      mx = fmaxf(mx, __shfl_xor(mx, 32, 64));
      const float mnew = fmaxf(m_run, mx);
      const float alpha = __builtin_amdgcn_exp2f(m_run - mnew);
      float rs = 0.f;
#pragma unroll
      for (int i = 0; i < 16; ++i) {
        S0[i] = __builtin_amdgcn_exp2f(S0[i] - mnew);
        S1[i] = __builtin_amdgcn_exp2f(S1[i] - mnew);
        rs += S0[i] + S1[i];
      }
      rs += __shfl_xor(rs, 32, 64);
      l_run = l_run * alpha + rs;
      m_run = mnew;
#pragma unroll
      for (int i = 0; i < 16; ++i) { O0[i] *= alpha; O1[i] *= alpha; }
    }
#pragma unroll
    for (int c = 0; c < 4; ++c) {
      union { unsigned u[4]; bf16x8 v; } pf;
      if (c < 2) {
#pragma unroll
        for (int e = 0; e < 4; ++e) pf.u[e] = pack2(S0[(c & 1) * 8 + 2 * e], S0[(c & 1) * 8 + 2 * e + 1]);
      } else {
#pragma unroll
        for (int e = 0; e < 4; ++e) pf.u[e] = pack2(S1[(c & 1) * 8 + 2 * e], S1[(c & 1) * 8 + 2 * e + 1]);
      }
      O0 = __builtin_amdgcn_mfma_f32_32x32x16_bf16(vfr[c * 2].v, pf.v, O0, 0, 0, 0);
      O1 = __builtin_amdgcn_mfma_f32_32x32x16_bf16(vfr[c * 2 + 1].v, pf.v, O1, 0, 0, 0);
    }

    }
    {
      const int tcur = ti + 1;
      const char* kb = Kl + s1 * 9216;
      const char* vb = Vl + s1 * 8704;
    f32x16 S0, S1;
    const float sinit = FIXED ? -m_run : 0.f;
#pragma unroll
    for (int i = 0; i < 16; ++i) { S0[i] = sinit; S1[i] = sinit; }
    bf16x8 kf[8];
    union { uint2 u[2]; bf16x8 v; } vfr[8];
#pragma unroll
    for (int kk = 0; kk < 4; ++kk) {
      kf[2 * kk] = *(const bf16x8*)(kb + q31 * 144 + kk * 32 + h * 16);
      kf[2 * kk + 1] = *(const bf16x8*)(kb + (32 + q31) * 144 + kk * 32 + h * 16);
    }
#pragma unroll
    for (int c = 0; c < 4; ++c)
#pragma unroll
      for (int ds = 0; ds < 2; ++ds) {
        const char* vp = vb + (ds * 32 + q31) * 136 + (16 * c + h * 4) * 2;
        vfr[c * 2 + ds].u[0] = *(const uint2*)vp;
        vfr[c * 2 + ds].u[1] = *(const uint2*)(vp + 16);
      }
    __builtin_amdgcn_sched_barrier(0);
#pragma unroll
    for (int kk = 0; kk < 4; ++kk) {
      S0 = __builtin_amdgcn_mfma_f32_32x32x16_bf16(kf[2 * kk], qf[kk], S0, 0, 0, 0);
      S1 = __builtin_amdgcn_mfma_f32_32x32x16_bf16(kf[2 * kk + 1], qf[kk], S1, 0, 0, 0);
    }
    const int j = TILEJ(tcur);
    if (window && j < SEQ) {
#pragma unroll
      for (int i = 0; i < 16; ++i) {
        const int kp = j + crow(i, h);
        int d0 = kp - qpos; d0 = d0 < 0 ? -d0 : d0;
        int d1 = kp + 32 - qpos; d1 = d1 < 0 ? -d1 : d1;
        S0[i] = d0 <= 128 ? S0[i] : -1e30f;
        S1[i] = d1 <= 128 ? S1[i] : -1e30f;
      }
    }
    if (FIXED) {
      float rs = 0.f;
#pragma unroll
      for (int i = 0; i < 16; ++i) {
        S0[i] = __builtin_amdgcn_exp2f(S0[i]);
        S1[i] = __builtin_amdgcn_exp2f(S1[i]);
        rs += S0[i] + S1[i];
      }
      l_run += rs;
    } else {
      float mx = S0[0];
#pragma unroll
      for (int i = 1; i < 16; ++i) mx = fmaxf(mx, S0[i]);
#pragma unroll
      for (int i = 0; i < 16; ++i) mx = fmaxf(mx, S1[i]);
      mx = fmaxf(mx, __shfl_xor(mx, 32, 64));
      const float mnew = fmaxf(m_run, mx);
      const float alpha = __builtin_amdgcn_exp2f(m_run - mnew);
      float rs = 0.f;
#pragma unroll
      for (int i = 0; i < 16; ++i) {
        S0[i] = __builtin_amdgcn_exp2f(S0[i] - mnew);
        S1[i] = __builtin_amdgcn_exp2f(S1[i] - mnew);
        rs += S0[i] + S1[i];
      }
      rs += __shfl_xor(rs, 32, 64);
      l_run = l_run * alpha + rs;
      m_run = mnew;
#pragma unroll
      for (int i = 0; i < 16; ++i) { O0[i] *= alpha; O1[i] *= alpha; }
    }
#pragma unroll
    for (int c = 0; c < 4; ++c) {
      union { unsigned u[4]; bf16x8 v; } pf;
      if (c < 2) {
#pragma unroll
        for (int e = 0; e < 4; ++e) pf.u[e] = pack2(S0[(c & 1) * 8 + 2 * e], S0[(c & 1) * 8 + 2 * e + 1]);
      } else {
#pragma unroll
        for (int e = 0; e < 4; ++e) pf.u[e] = pack2(S1[(c & 1) * 8 + 2 * e], S1[(c & 1) * 8 + 2 * e + 1]);
      }
      O0 = __builtin_amdgcn_mfma_f32_32x32x16_bf16(vfr[c * 2].v, pf.v, O0, 0, 0, 0);
      O1 = __builtin_amdgcn_mfma_f32_32x32x16_bf16(vfr[c * 2 + 1].v, pf.v, O1, 0, 0, 0);
    }

      if (ti + 2 < ntiles) { ASWRITE(rkA, rvA, s2); ASWRITE(rkB, rvB, s2 + 1); }
      __syncthreads();
    }
    s0 = s2;
  }
#undef TILEJ
#undef AGLOAD
#undef ASWRITE
  if (FIXED) l_run += __shfl_xor(l_run, 32, 64);
  const float inv = 1.f / l_run;
  bf16_t* op = p.HO + (size_t)(qrow0 + qw * 32 + q31) * HS + grp * 256 + head * 64 + h * 4;
#pragma unroll
  for (int gi = 0; gi < 4; ++gi) {
    uint2 w;
    w.x = pack2(O0[gi * 4 + 0] * inv, O0[gi * 4 + 1] * inv);
    w.y = pack2(O0[gi * 4 + 2] * inv, O0[gi * 4 + 3] * inv);
    *(uint2*)(op + gi * 8) = w;
    w.x = pack2(O1[gi * 4 + 0] * inv, O1[gi * 4 + 1] * inv);
    w.y = pack2(O1[gi * 4 + 2] * inv, O1[gi * 4 + 3] * inv);
    *(uint2*)(op + 32 + gi * 8) = w;
  }
}

DI float2 c_add(float2 a, float2 b) { return make_float2(a.x + b.x, a.y + b.y); }
DI float2 c_sub(float2 a, float2 b) { return make_float2(a.x - b.x, a.y - b.y); }
DI float2 c_mul(float2 a, float2 w) { return make_float2(a.x * w.x - a.y * w.y, a.x * w.y + a.y * w.x); }
DI float2 c_mni(float2 a) { return make_float2(a.y, -a.x); }
DI float2 c_pi(float2 a) { return make_float2(-a.y, a.x); }
constexpr float RS2 = 0.70710678118654752f;
DI void fft_bottom_r2(float2* X, int lg) {
  const int n2 = 1 << (lg - 1);
  for (int j = tidx(); j < n2; j += NTHR) {
    const float2 a = X[2 * j], b = X[2 * j + 1];
    X[2 * j] = c_add(a, b);
    X[2 * j + 1] = c_sub(a, b);
  }
  __syncthreads();
}
DI void fft_dif(float2* X, int lg) {
  const int n8 = 1 << (lg - 3);
  int s = lg - 1;
  for (; s >= 2; s -= 3) {
    const int q = 1 << (s - 2);
    const float inv = 1.0f / (float)(8 * q);
    for (int j = tidx(); j < n8; j += NTHR) {
      const int p = j & (q - 1);
      const int i0 = ((j >> (s - 2)) << (s + 1)) + p;
      float2 v[8];
#pragma unroll
      for (int k = 0; k < 8; ++k) v[k] = X[i0 + k * q];
      const float r = (float)p * inv;
      const float2 W = make_float2(cos_rev(r), -sin_rev(r));
      const float2 W2 = make_float2(W.x * W.x - W.y * W.y, 2.f * W.x * W.y);
      const float2 W4 = make_float2(W2.x * W2.x - W2.y * W2.y, 2.f * W2.x * W2.y);
      float2 y[8];
#pragma unroll
      for (int k = 0; k < 4; ++k) {
        y[k] = c_add(v[k], v[k + 4]);
        const float2 d = c_mul(c_sub(v[k], v[k + 4]), W);
        y[k + 4] = k == 0 ? d : (k == 1 ? make_float2((d.x + d.y) * RS2, (d.y - d.x) * RS2)
                                        : (k == 2 ? c_mni(d) : make_float2((d.y - d.x) * RS2, -(d.x + d.y) * RS2)));
      }
      float2 z[8];
#pragma unroll
      for (int b = 0; b < 8; b += 4) {
        z[b] = c_add(y[b], y[b + 2]);
        z[b + 2] = c_mul(c_sub(y[b], y[b + 2]), W2);
        z[b + 1] = c_add(y[b + 1], y[b + 3]);
        z[b + 3] = c_mni(c_mul(c_sub(y[b + 1], y[b + 3]), W2));
      }
#pragma unroll
      for (int b = 0; b < 8; b += 2) {
        X[i0 + b * q] = c_add(z[b], z[b + 1]);
        X[i0 + (b + 1) * q] = c_mul(c_sub(z[b], z[b + 1]), W4);
      }
    }
    __syncthreads();
  }
  if (s == 1) {
    const int n4 = 1 << (lg - 2);
    for (int j = tidx(); j < n4; j += NTHR) {
      const float2 x0 = X[4 * j], x1 = X[4 * j + 1], x2 = X[4 * j + 2], x3 = X[4 * j + 3];
      const float2 y0 = c_add(x0, x2), y2 = c_sub(x0, x2), y1 = c_add(x1, x3), y3 = c_mni(c_sub(x1, x3));
      X[4 * j] = c_add(y0, y1); X[4 * j + 1] = c_sub(y0, y1); X[4 * j + 2] = c_add(y2, y3); X[4 * j + 3] = c_sub(y2, y3);
    }
    __syncthreads();
  } else if (s == 0) {
    fft_bottom_r2(X, lg);
  }
}
DI void fft_dit_inv(float2* X, int lg) {
  const int n8 = 1 << (lg - 3);
  const int rem = lg % 3;
  int s = 0;
  if (rem == 1) { fft_bottom_r2(X, lg); s = 1; }
  else if (rem == 2) {
    const int n4 = 1 << (lg - 2);
    for (int j = tidx(); j < n4; j += NTHR) {
      const float2 x0 = X[4 * j], x1 = X[4 * j + 1], x2 = X[4 * j + 2], x3 = X[4 * j + 3];
      const float2 y0 = c_add(x0, x1), y1 = c_sub(x0, x1), y2 = c_add(x2, x3), y3 = c_pi(c_sub(x2, x3));
      X[4 * j] = c_add(y0, y2); X[4 * j + 2] = c_sub(y0, y2); X[4 * j + 1] = c_add(y1, y3); X[4 * j + 3] = c_sub(y1, y3);
    }
    __syncthreads();
    s = 2;
  }
  for (; s + 2 < lg; s += 3) {
    const int q = 1 << s;
    const float inv = 1.0f / (float)(8 * q);
    for (int j = tidx(); j < n8; j += NTHR) {
      const int p = j & (q - 1);
      const int i0 = ((j >> s) << (s + 3)) + p;
      float2 o[8];
#pragma unroll
      for (int k = 0; k < 8; ++k) o[k] = X[i0 + k * q];
      const float r = (float)p * inv;
      const float2 W = make_float2(cos_rev(r), sin_rev(r));
      const float2 W2 = make_float2(W.x * W.x - W.y * W.y, 2.f * W.x * W.y);
      const float2 W4 = make_float2(W2.x * W2.x - W2.y * W2.y, 2.f * W2.x * W2.y);
      float2 z[8];
#pragma unroll
      for (int b = 0; b < 8; b += 2) {
        const float2 t = c_mul(o[b + 1], W4);
        z[b] = c_add(o[b], t); z[b + 1] = c_sub(o[b], t);
      }
      float2 y[8];
#pragma unroll
      for (int b = 0; b < 8; b += 4) {
        const float2 t = c_mul(z[b + 2], W2);
        y[b] = c_add(z[b], t); y[b + 2] = c_sub(z[b], t);
        const float2 u = c_pi(c_mul(z[b + 3], W2));
        y[b + 1] = c_add(z[b + 1], u); y[b + 3] = c_sub(z[b + 1], u);
      }
#pragma unroll
      for (int k = 0; k < 4; ++k) {
        const float2 d = c_mul(y[k + 4], W);
        const float2 t = k == 0 ? d : (k == 1 ? make_float2((d.x - d.y) * RS2, (d.x + d.y) * RS2)
                                              : (k == 2 ? c_pi(d) : make_float2(-(d.x + d.y) * RS2, (d.x - d.y) * RS2)));
        X[i0 + k * q] = c_add(y[k], t);
        X[i0 + (k + 4) * q] = c_sub(y[k], t);
      }
    }
    __syncthreads();
  }
}

DI float conv3(const float* z, int t, int Ls, float w0, float w1, float w2, float bias) {
  const float zm = t > 0 ? z[t - 1] : 0.f, zc = z[t], zp = t < Ls - 1 ? z[t + 1] : 0.f;
  return w0 * zm + w1 * zc + w2 * zp + bias;
}

DI void hyena_item(const Params& p, int l, float2* X, int bp, int c, bool lat) {
  const int Ls = lat ? SEQ : CL, lg = lat ? 14 : 9, N = 2 * Ls;
  const float* zb0 = lat ? p.ZT + (size_t)(2 * bp) * 1024 * SEQ : p.ZTc + (size_t)(2 * bp) * 1024 * CL;
  const float* zb1 = zb0 + (size_t)1024 * Ls;
  const float* cw = p.hy_conv_w + (size_t)l * 3 * 768;
  const float* cb = p.hy_conv_b + (size_t)l * 768;
  const float w00 = cw[c], w01 = cw[768 + c], w02 = cw[1536 + c], b0 = cb[c];
  const float w10 = cw[256 + c], w11 = cw[768 + 256 + c], w12 = cw[1536 + 256 + c], b1 = cb[256 + c];
  const float w20 = cw[512 + c], w21 = cw[768 + 512 + c], w22 = cw[1536 + 512 + c], b2 = cb[512 + c];
  const float* x0a = zb0 + (size_t)c * Ls; const float* x1a = zb0 + (size_t)(256 + c) * Ls; const float* va = zb0 + (size_t)(512 + c) * Ls;
  const float* x0b = zb1 + (size_t)c * Ls; const float* x1b = zb1 + (size_t)(256 + c) * Ls; const float* vb = zb1 + (size_t)(512 + c) * Ls;
#pragma unroll 4
  for (int t = tidx(); t < Ls; t += NTHR) {
    const float ua = conv3(x1a, t, Ls, w10, w11, w12, b1) * conv3(va, t, Ls, w20, w21, w22, b2);
    const float ub = conv3(x1b, t, Ls, w10, w11, w12, b1) * conv3(vb, t, Ls, w20, w21, w22, b2);
    X[t] = make_float2(ua, ub);
    X[Ls + t] = make_float2(0.f, 0.f);
  }
  __syncthreads();
  fft_dif(X, lg);
  const float2* Kh = lat ? p.Khat + (size_t)(l * 256 + c) * (2 * SEQ) : p.Khatc + (size_t)(l * 256 + c) * (2 * CL);
#pragma unroll 8
  for (int i = tidx(); i < N; i += NTHR) {
    const float2 a = X[i], k = Kh[i];
    X[i] = make_float2(a.x * k.x - a.y * k.y, a.x * k.y + a.y * k.x);
  }
  __syncthreads();
  fft_dit_inv(X, lg);
  const float invN = 1.f / (float)N, skip = p.hy_skip[l * 256 + c];
  const size_t rba = lat ? (size_t)(2 * bp) * SEQ : (size_t)T + (size_t)(2 * bp) * CL;
  const size_t rbb = rba + Ls;
#pragma unroll 4
  for (int t = tidx(); t < Ls; t += NTHR) {
    const float2 y = X[t];
    const float ua = conv3(x1a, t, Ls, w10, w11, w12, b1) * conv3(va, t, Ls, w20, w21, w22, b2);
    const float ub = conv3(x1b, t, Ls, w10, w11, w12, b1) * conv3(vb, t, Ls, w20, w21, w22, b2);
    const float oa = (y.x * invN + skip * ua) * conv3(x0a, t, Ls, w00, w01, w02, b0);
    const float ob = (y.y * invN + skip * ub) * conv3(x0b, t, Ls, w00, w01, w02, b0);
    p.HO[(rba + t) * HS + 512 + c] = f2bf(oa);
    p.HO[(rbb + t) * HS + 512 + c] = f2bf(ob);
  }
  __syncthreads();
}

DI void fnet_item(const Params& p, float2* X, int b, int g, int m, bool lat) {
  const int Ls = lat ? SEQ : CL, lg = lat ? 13 : 8;
  const float* zb = lat ? p.ZT + (size_t)b * 1024 * SEQ : p.ZTc + (size_t)b * 1024 * CL;
  const float* re = zb + (size_t)(768 + g * 64 + m) * Ls;
  const bool hasim = (m >= 1 && m <= 31);
  const float* im = zb + (size_t)(768 + g * 64 + 32 + (hasim ? m : 0)) * Ls;
#pragma unroll 8
  for (int t = tidx(); t < Ls; t += NTHR) X[t] = make_float2(re[t], hasim ? im[t] : 0.f);
  __syncthreads();
  fft_dif(X, lg);
  const float s = rsqrtf((float)Ls * 64.f);
  const size_t rb = lat ? (size_t)b * SEQ : (size_t)T + (size_t)b * CL;
#pragma unroll 4
  for (int i = tidx(); i < Ls; i += NTHR) {
    const int k = (int)(__brev((unsigned)i) >> (32 - lg));
    const bf16_t v = f2bf(X[i].x * s);
    p.F[(rb + k) * 256 + g * 64 + m] = v;
    if (hasim) p.F[(rb + ((Ls - k) & (Ls - 1))) * 256 + g * 64 + 64 - m] = v;
  }
  __syncthreads();
}

DI void mixers_phase(const Params& p, int l, char* lds) {
  float2* X = (float2*)lds;
  const int xcd = blockIdx.x & 7;
#pragma unroll 1
  for (int it = 0;; ++it) {
    const int loc = xcd_local(it, l == DEPTH - 1 ? 256 : 264);
    if (loc < 0) break;
    int grp, pair, qrow0, qpos0, jfirst, nloc;
    bool window = false;
    if (loc < 256) {
      grp = loc < 128 ? 1 : 0;
      const int q = loc & 127, qb = q & 63;
      pair = 2 * xcd + (q >> 6);
      qpos0 = qb * 128;
      qrow0 = (pair >> 1) * SEQ + qpos0;
      if (grp) { jfirst = 0; nloc = 128; }
      else {
        const int fb = qb > 0 ? qb - 1 : 0, lb = qb < 63 ? qb + 1 : 63;
        jfirst = fb * 128; nloc = (lb - fb + 1) * 2; window = true;
      }
    } else {
      const int q = loc - 256;
      grp = q >> 2;
      pair = 2 * xcd + ((q >> 1) & 1);
      qpos0 = (q & 1) * 128;
      qrow0 = T + (pair >> 1) * CL + qpos0;
      jfirst = 0; nloc = 0;
    }
    if (grp) attn_item<true>(p, l, lds, grp, pair >> 1, pair & 1, qrow0, qpos0, jfirst, nloc, false);
    else attn_item<false>(p, l, lds, grp, pair >> 1, pair & 1, qrow0, qpos0, jfirst, nloc, window);
  }
#pragma unroll 1
  for (int it = 0;; ++it) {
    int loc = xcd_local(it, l == DEPTH - 1 ? 128 : 256);
    if (loc < 0) break;
    loc &= 255;
    hyena_item(p, l, X, (loc >> 5) & 3, xcd * 32 + (loc & 31), loc < 128);
  }
#pragma unroll 1
  for (int it = 0;; ++it) {
    int loc = xcd_local(it, l == DEPTH - 1 ? 132 : 264);
    if (loc < 0) break;
    if (loc >= 264) loc -= 264;
    const int q = loc < 132 ? loc : loc - 132;
    fnet_item(p, X, xcd, q / 33, q % 33, loc < 132);
  }
}

DI void row_pass(const Params& p, int l, int mode) {
  const int lane = tidx() & 63, wave = tidx() >> 6;
  const int nrows = (l == DEPTH - 1 && mode) ? T : MROWS;
  const bool first = (l == 0 && mode <= 1);
  const float* xl = first ? p.x : p.out;
  const float* xc = first ? p.ctx : p.cx;
  int ml = l, sho = 0, sco = 1024;
  if (mode == 1) { sho = 3072; sco = 4096; }
  if (mode == 2) ml = l + 1;
  const bool has_h = ml < DEPTH;
  const int stride = gridDim.x * 8;
  float4 LG[4], LB[4], GT[4], SH[4], SC[4];
#pragma unroll
  for (int j = 0; j < 4; ++j) {
    const int col = lane * 4 + 256 * j;
    LG[j] = mode ? *(const float4*)((mode == 1 ? p.ln1_g : p.ln2_g) + (size_t)l * D + col) : make_float4(0.f, 0.f, 0.f, 0.f);
    LB[j] = mode ? *(const float4*)((mode == 1 ? p.ln1_b : p.ln2_b) + (size_t)l * D + col) : make_float4(0.f, 0.f, 0.f, 0.f);
    GT[j] = SH[j] = SC[j] = make_float4(0.f, 0.f, 0.f, 0.f);
  }
  int mr_cur = -1;
  int r = blockIdx.x * 8 + wave;
  float4 xv[4];
  uint2 yv[4];
#define ROWLOAD(XV, YV, rr)                                                                       \
  {                                                                                               \
    const float* xs_ = (rr) < T ? xl + (size_t)(rr) * D : xc + (size_t)((rr) - T) * D;            \
    _Pragma("unroll") for (int j = 0; j < 4; ++j) { const f32x4 t_ = __builtin_nontemporal_load((const f32x4*)(xs_ + lane * 4 + 256 * j)); XV[j] = make_float4(t_.x, t_.y, t_.z, t_.w); } \
    if (mode) { const bf16_t* yr_ = p.Y + (size_t)(rr) * D;                                       \
      _Pragma("unroll") for (int j = 0; j < 4; ++j) { const u32x2 t_ = __builtin_nontemporal_load((const u32x2*)(yr_ + lane * 4 + 256 * j)); YV[j] = make_uint2(t_.x, t_.y); } } \
  }
  if (r < nrows) ROWLOAD(xv, yv, r);
#pragma unroll 1
  for (; r < nrows; r += stride) {
    float4 xn[4];
    uint2 yn[4];
    const int rn = r + stride;
    if (rn < nrows) ROWLOAD(xn, yn, rn);
    const bool lat = r < T;
    const int mr = lat ? (r >> 13) : 8;
    if (mr != mr_cur) {
      mr_cur = mr;
      const float* md = p.mod + ((size_t)l * 9 + mr) * 6144;
      const float* md2 = p.mod + ((size_t)(has_h ? ml : l) * 9 + mr) * 6144;
#pragma unroll
      for (int j = 0; j < 4; ++j) {
        const int col = lane * 4 + 256 * j;
        if (mode) GT[j] = *(const float4*)(md + (mode == 1 ? 2048 : 5120) + col);
        SH[j] = *(const float4*)(md2 + sho + col);
        SC[j] = *(const float4*)(md2 + sco + col);
      }
    }
    float v[16];
#pragma unroll
    for (int j = 0; j < 4; ++j) { v[4 * j] = xv[j].x; v[4 * j + 1] = xv[j].y; v[4 * j + 2] = xv[j].z; v[4 * j + 3] = xv[j].w; }
    if (mode) {
      float s = 0.f;
#pragma unroll
      for (int j = 0; j < 4; ++j) {
        v[4 * j] = ALPHA * v[4 * j] + GT[j].x * bf2f(yv[j].x & 0xffffu);
        v[4 * j + 1] = ALPHA * v[4 * j + 1] + GT[j].y * bf2f(yv[j].x >> 16);
        v[4 * j + 2] = ALPHA * v[4 * j + 2] + GT[j].z * bf2f(yv[j].y & 0xffffu);
        v[4 * j + 3] = ALPHA * v[4 * j + 3] + GT[j].w * bf2f(yv[j].y >> 16);
        s += v[4 * j] + v[4 * j + 1] + v[4 * j + 2] + v[4 * j + 3];
      }
      const float mu = wave_sum(s) * (1.f / D);
      float q = 0.f;
#pragma unroll
      for (int i = 0; i < 16; ++i) { const float d = v[i] - mu; q += d * d; }
      const float rstd = rsqrtf(wave_sum(q) * (1.f / D) + 1e-6f);
      float* xd = lat ? p.out + (size_t)r * D : p.cx + (size_t)(r - T) * D;
#pragma unroll
      for (int j = 0; j < 4; ++j) {
        const int col = lane * 4 + 256 * j;
        v[4 * j] = (v[4 * j] - mu) * rstd * LG[j].x + LB[j].x;
        v[4 * j + 1] = (v[4 * j + 1] - mu) * rstd * LG[j].y + LB[j].y;
        v[4 * j + 2] = (v[4 * j + 2] - mu) * rstd * LG[j].z + LB[j].z;
        v[4 * j + 3] = (v[4 * j + 3] - mu) * rstd * LG[j].w + LB[j].w;
        { const f32x4 t_ = {v[4 * j], v[4 * j + 1], v[4 * j + 2], v[4 * j + 3]}; __builtin_nontemporal_store(t_, (f32x4*)(xd + col)); }
      }
    }
    if (has_h) {
      float s = 0.f;
#pragma unroll
      for (int i = 0; i < 16; ++i) s += v[i];
      const float mu = wave_sum(s) * (1.f / D);
      float q = 0.f;
#pragma unroll
      for (int i = 0; i < 16; ++i) { const float d = v[i] - mu; q += d * d; }
      const float rstd = rsqrtf(wave_sum(q) * (1.f / D) + 1e-6f);
      bf16_t* hr = p.HO + (size_t)r * HS;
#pragma unroll
      for (int j = 0; j < 4; ++j) {
        const int col = lane * 4 + 256 * j;
        uint2 w;
        w.x = pack2((v[4 * j] - mu) * rstd * (1.f + SC[j].x) + SH[j].x, (v[4 * j + 1] - mu) * rstd * (1.f + SC[j].y) + SH[j].y);
        w.y = pack2((v[4 * j + 2] - mu) * rstd * (1.f + SC[j].z) + SH[j].z, (v[4 * j + 3] - mu) * rstd * (1.f + SC[j].w) + SH[j].w);
        *(uint2*)(hr + col) = w;
      }
    }
#pragma unroll
    for (int j = 0; j < 4; ++j) { xv[j] = xn[j]; yv[j] = yn[j]; }
  }
#undef ROWLOAD
}

DI void merge_norm_phase(const Params& p, int nrows) {
  const int lane = tidx() & 63, wave = tidx() >> 6;
#pragma unroll 1
  for (int r0 = (blockIdx.x * 8 + wave) * 4; r0 < nrows; r0 += gridDim.x * 32) {
    uint4 a[4], b[4];
#pragma unroll
    for (int k = 0; k < 4; ++k) {
      const int r = r0 + k < nrows ? r0 + k : nrows - 1;
      const bf16_t* hr = p.HO + (size_t)r * HS + lane * 16;
      a[k] = *(const uint4*)hr; b[k] = *(const uint4*)(hr + 8);
    }
#pragma unroll
    for (int k = 0; k < 4; ++k) {
      if (r0 + k >= nrows) break;
      bf16_t* hr = p.HO + (size_t)(r0 + k) * HS + lane * 16;
      unsigned u[8] = {a[k].x, a[k].y, a[k].z, a[k].w, b[k].x, b[k].y, b[k].z, b[k].w};
      float f[16];
      float ss = 0.f;
#pragma unroll
      for (int i = 0; i < 8; ++i) { f[2 * i] = bf2f(u[i] & 0xffffu); f[2 * i + 1] = bf2f(u[i] >> 16); ss += f[2 * i] * f[2 * i] + f[2 * i + 1] * f[2 * i + 1]; }
      ss = row16_sum(ss);
      const float rs = rsqrtf(ss * (1.f / 256.f) + 1e-6f);
#pragma unroll
      for (int i = 0; i < 8; ++i) u[i] = pack2(f[2 * i] * rs, f[2 * i + 1] * rs);
      *(uint4*)hr = make_uint4(u[0], u[1], u[2], u[3]);
      *(uint4*)(hr + 8) = make_uint4(u[4], u[5], u[6], u[7]);
    }
  }
}

DI void conv_tile(float* lds, const float* src, int ldsrc, bf16_t* dst, int ldd, int k0, int n0, const float* rowscale) {
  const int tid = tidx();
#pragma unroll
  for (int i = 0; i < 8; ++i) {
    const int idx = tid + NTHR * i, kk = idx >> 6, nn = idx & 63;
    float v = src[(size_t)(k0 + kk) * ldsrc + n0 + nn];
    if (rowscale) v *= rowscale[k0 + kk];
    lds[kk * 65 + nn] = v;
  }
  __syncthreads();
#pragma unroll
  for (int i = 0; i < 4; ++i) {
    const int pidx = tid + NTHR * i, nn = pidx >> 5, kp = pidx & 31;
    *(unsigned*)(dst + (size_t)(n0 + nn) * ldd + k0 + 2 * kp) = pack2(lds[(2 * kp) * 65 + nn], lds[(2 * kp + 1) * 65 + nn]);
  }
  __syncthreads();
}
DI void fold_tile(float* lds, const float* src, bf16_t* dst, int k0, int g) {
  const int tid = tidx();
  float* cs = lds + 64 * 65;
  float* sn = cs + 64;
#pragma unroll
  for (int i = 0; i < 8; ++i) {
    const int idx = tid + NTHR * i, kk = idx >> 6, nn = idx & 63;
    lds[kk * 65 + nn] = src[(size_t)(k0 + kk) * DP + 1792 + g * 64 + nn];
  }
  if (tid < 64) { cs[tid] = cos_rev((float)tid * (1.f / 64.f)); sn[tid] = sin_rev((float)tid * (1.f / 64.f)); }
  __syncthreads();
#pragma unroll 1
  for (int i = 0; i < 4; ++i) {
    const int pidx = tid + NTHR * i, mp = pidx >> 5, kp = pidx & 31;
    float a0 = 0.f, a1 = 0.f;
    const int mm = mp <= 32 ? mp : mp - 32;
#pragma unroll 4
    for (int j = 0; j < 64; ++j) {
      const int ph = (mm * j) & 63;
      const float cm = mp <= 32 ? cs[ph] : -sn[ph];
      a0 += lds[(2 * kp) * 65 + j] * cm;
      a1 += lds[(2 * kp + 1) * 65 + j] * cm;
    }
    *(unsigned*)(dst + (size_t)(1792 + g * 64 + mp) * HS + k0 + 2 * kp) = pack2(a0, a1);
  }
  __syncthreads();
}
DI void convert_phase(const Params& p, float* lds) {
  constexpr int PER = 2848;
  for (int job = blockIdx.x; job < PER * DEPTH; job += gridDim.x) {
    const int l = job / PER;
    int j = job - l * PER;
    if (j >= 448 && j < 512) {
      j -= 448;
      fold_tile(lds, p.w_in + (size_t)l * D * DP, p.Win + (size_t)l * DP * HS, (j & 15) * 64, j >> 4);
      continue;
    }
    const float* src; bf16_t* dst; int ldsrc, ldd, k0, n0; const float* rs = nullptr;
    if (j < 448) {
      src = p.w_in + (size_t)l * D * DP; ldsrc = DP; dst = p.Win + (size_t)l * DP * HS; ldd = HS; k0 = (j / 28) * 64; n0 = (j % 28) * 64;
    } else if (j < 768) {
      j -= 512;
      src = p.w_out + (size_t)l * D * D; ldsrc = D; dst = p.Wout + (size_t)l * D * HS; ldd = HS; k0 = (j >> 4) * 64; n0 = (j & 15) * 64;
      rs = p.out_norm_g + l * D;
    } else if (j < 2144) {
      j -= 768;
      src = p.ffn_w_up + (size_t)l * D * DFF2; ldsrc = DFF2; dst = p.Wup + (size_t)l * 2 * DFFP * HS; ldd = HS; k0 = (j / 86) * 64; n0 = (j % 86) * 64;
      if (n0 >= DFF) { src += DFF; dst += (size_t)DFFP * HS; n0 -= DFF; ldsrc = DFF2; }
    } else if (j < 2832) {
      j -= 2144;
      src = p.ffn_w_down + (size_t)l * DFF * D; ldsrc = D; dst = p.Wdn + (size_t)l * D * DFFP; ldd = DFFP; k0 = (j >> 4) * 64; n0 = (j & 15) * 64;
    } else {
      j -= 2832;
      src = p.fnet_w + (size_t)l * 256 * 256; ldsrc = 256; dst = p.Wfn + (size_t)l * 256 * 256; ldd = 256; k0 = (j >> 2) * 64; n0 = (j & 3) * 64;
    }
    conv_tile(lds, src, ldsrc, dst, ldd, k0, n0, rs);
  }
}
DI void pad_phase(const Params& p) {
  const int gtid = blockIdx.x * NTHR + tidx(), gn = gridDim.x * NTHR;
  for (int idx = gtid; idx < DEPTH * 2 * 64 * D; idx += gn) {
    const int k = idx & (D - 1), r = (idx >> 10) & 63, h = (idx >> 16) & 1, l = idx >> 17;
    p.Wup[((size_t)l * 2 * DFFP + (size_t)h * DFFP + DFF + r) * HS + k] = 0;
  }
  for (int idx = gtid; idx < DEPTH * D * 64; idx += gn) {
    const int k = idx & 63, r = idx >> 6;
    p.Wdn[(size_t)r * DFFP + DFF + k] = 0;
  }
  for (int idx = gtid; idx < DEPTH * 2 * DFFP; idx += gn) {
    const int c = idx % DFFP, h = (idx / DFFP) & 1, l = idx / (2 * DFFP);
    const bool ok = c < DFF;
    p.bupP[idx] = ok ? p.ffn_b_up[(size_t)l * DFF2 + h * DFF + c] : 0.f;
    p.cbP[idx] = ok ? p.ffn_conv_b[(size_t)l * DFF2 + h * DFF + c] : 0.f;
#pragma unroll
    for (int tap = 0; tap < 3; ++tap)
      p.cwP[(size_t)l * 6 * DFFP + (size_t)(tap * 2 + h) * DFFP + c] = ok ? p.ffn_conv_w[((size_t)l * 3 + tap) * DFF2 + h * DFF + c] : 0.f;
  }
}
DI void mod_phase(const Params& p, float* lds) {
  float* s = lds;
  float* part = lds + 9216;
  const int tid = tidx(), col = tid & 63, ks = tid >> 6;
  for (int item = blockIdx.x; item < DEPTH * 96; item += gridDim.x) {
    const int l = item / 96, n0 = (item % 96) * 64;
    for (int idx = tid; idx < 9 * 1024; idx += NTHR) {
      const int r = idx >> 10, k = idx & 1023;
      s[idx] = siluf(r < 8 ? p.c[r * D + k] : p.c_ctx[k]);
    }
    __syncthreads();
    float acc[9];
#pragma unroll
    for (int r = 0; r < 9; ++r) acc[r] = 0.f;
    const float* w = p.w_ada + (size_t)l * D * 6144 + n0 + col;
    for (int k = ks * 128; k < ks * 128 + 128; ++k) {
      const float wv = w[(size_t)k * 6144];
#pragma unroll
      for (int r = 0; r < 9; ++r) acc[r] += s[r * 1024 + k] * wv;
    }
#pragma unroll
    for (int r = 0; r < 9; ++r) part[(ks * 9 + r) * 64 + col] = acc[r];
    __syncthreads();
    for (int idx = tid; idx < 576; idx += NTHR) {
      const int r = idx >> 6, cc = idx & 63;
      float a = p.b_ada[l * 6144 + n0 + cc];
#pragma unroll
      for (int q = 0; q < 8; ++q) a += part[(q * 9 + r) * 64 + cc];
      p.mod[((size_t)l * 9 + r) * 6144 + n0 + cc] = a;
    }
    __syncthreads();
  }
}
DI void hy_mlp_item(const Params& p, float* lds, int l, int tt, bool lat) {
  const int Ls = lat ? SEQ : CL, t0 = tt * 32, tid = tidx();
  float* feat = lds;
  float* h1 = lds + 544;
  float* h2 = h1 + 2048;
  float* outl = h2 + 2048;
  for (int idx = tid; idx < 32 * 17; idx += NTHR) {
    const int t = idx / 17, f = idx % 17;
    const float tg = (float)(t0 + t);
    float v;
    if (f == 0) v = tg / (float)(Ls - 1);
    else {
      const int jb = (f - 1) & 7;
      const float band = 1e-4f + (float)jb * ((7.f - 1e-4f) / 7.f);
      const float rev = tg * band / (float)Ls;
      v = f <= 8 ? cos_rev(rev) : -sin_rev(rev);
    }
    feat[idx] = v;
  }
  __syncthreads();
  const float* w1 = p.hy_f_w1 + (size_t)l * 17 * 64;
  const float* w2 = p.hy_f_w2 + (size_t)l * 64 * 64;
  const float* w3 = p.hy_f_w3 + (size_t)l * 64 * 512;
#pragma unroll
  for (int i = 0; i < 4; ++i) {
    const int idx = tid + NTHR * i, t = idx >> 6, n = idx & 63;
    float a = p.hy_f_b1[l * 64 + n];
    for (int f = 0; f < 17; ++f) a += feat[t * 17 + f] * w1[f * 64 + n];
    h1[idx] = sin_rev(p.hy_f_freq[l * 64 + n] * a * INV2PI);
  }
  __syncthreads();
#pragma unroll
  for (int i = 0; i < 4; ++i) {
    const int idx = tid + NTHR * i, t = idx >> 6, n = idx & 63;
    float a = p.hy_f_b2[l * 64 + n];
    for (int k = 0; k < 64; ++k) a += h1[t * 64 + k] * w2[k * 64 + n];
    h2[n * 32 + t] = sin_rev(p.hy_f_freq[l * 64 + n] * a * INV2PI);
  }
  __syncthreads();
  {
    const int n = tid, c = n & 255;
    float acc[32];
#pragma unroll
    for (int t = 0; t < 32; ++t) acc[t] = 0.f;
#pragma unroll 2
    for (int k = 0; k < 64; ++k) {
      const float wv = w3[k * 512 + n];
#pragma unroll
      for (int t4 = 0; t4 < 8; ++t4) {
        const float4 hv = *(const float4*)(h2 + k * 32 + t4 * 4);
        acc[4 * t4] += hv.x * wv; acc[4 * t4 + 1] += hv.y * wv; acc[4 * t4 + 2] += hv.z * wv; acc[4 * t4 + 3] += hv.w * wv;
      }
    }
    const float mind = -3.0701134573253946f, maxd = -15.350567286626973f;
    const float delta = fabsf(mind + (maxd - mind) * ((float)c / 255.f));
#pragma unroll
    for (int t = 0; t < 32; ++t) {
      const float tn = (float)(t0 + t) / (float)(Ls - 1);
      outl[n * 33 + t] = acc[t] * __expf(-tn * delta);
    }
  }
  __syncthreads();
  const int N2 = 2 * Ls;
  float* kv = lat ? p.kvec + (size_t)l * 256 * (2 * SEQ) : p.kvecc + (size_t)l * 256 * (2 * CL);
  for (int idx = tid; idx < 512 * 32; idx += NTHR) {
    const int n = idx >> 5, t = idx & 31, c = n & 255, dir = n >> 8, tg = t0 + t;
    float val = outl[n * 33 + t];
    if (dir == 0) {
      if (tg == 0) val += outl[(256 + c) * 33];
      kv[(size_t)c * N2 + tg] = val;
    } else {
      if (tg == 0) kv[(size_t)c * N2 + Ls] = 0.f;
      else kv[(size_t)c * N2 + N2 - tg] = val;
    }
  }
  __syncthreads();
}
DI void khat_item(const Params& p, float2* X, int l, int c, bool lat) {
  const int Ls = lat ? SEQ : CL, lg = lat ? 14 : 9, N = 2 * Ls;
  const float* kv = lat ? p.kvec + (size_t)(l * 256 + c) * N : p.kvecc + (size_t)(l * 256 + c) * N;
  float2* Kh = lat ? p.Khat + (size_t)(l * 256 + c) * N : p.Khatc + (size_t)(l * 256 + c) * N;
#pragma unroll 8
  for (int i = tidx(); i < N; i += NTHR) X[i] = make_float2(kv[i], kv[N + i]);
  __syncthreads();
  fft_dif(X, lg);
#pragma unroll 4
  for (int i = tidx(); i < N; i += NTHR) {
    const int k = (int)(__brev((unsigned)i) >> (32 - lg));
    const int ip = (int)(__brev((unsigned)((N - k) & (N - 1))) >> (32 - lg));
    const float2 z = X[i], w = X[ip];
    Kh[i] = make_float2(0.5f * (z.x + w.x), 0.5f * (z.y - w.y));
    Kh[N + i] = make_float2(0.5f * (z.y + w.y), -0.5f * (z.x - w.x));
  }
  __syncthreads();
}

DI void grid_barrier(unsigned* bar, unsigned n) {
  asm volatile("s_waitcnt vmcnt(0) lgkmcnt(0)" ::: "memory");
  __syncthreads();
  if (threadIdx.x == 0) {
    const unsigned G = gridDim.x;
    __builtin_amdgcn_fence(__ATOMIC_RELEASE, "agent");
    if ((G & 7u) == 0u) {
      const unsigned x = blockIdx.x & 7u, per = G >> 3;
      unsigned* cnt = bar + 64 * (1 + x);
      unsigned* rel = bar + 64 * (9 + x);
      const unsigned old = __hip_atomic_fetch_add(cnt, 1u, __ATOMIC_RELAXED, __HIP_MEMORY_SCOPE_AGENT);
      if (old + 1u == n * per) {
        __hip_atomic_fetch_add(bar, 1u, __ATOMIC_RELAXED, __HIP_MEMORY_SCOPE_AGENT);
        while (__hip_atomic_load(bar, __ATOMIC_RELAXED, __HIP_MEMORY_SCOPE_AGENT) < n * 8u) __builtin_amdgcn_s_sleep(1);
        __hip_atomic_store(rel, n, __ATOMIC_RELAXED, __HIP_MEMORY_SCOPE_AGENT);
      } else {
        while (__hip_atomic_load(rel, __ATOMIC_RELAXED, __HIP_MEMORY_SCOPE_AGENT) < n) __builtin_amdgcn_s_sleep(1);
      }
    } else {
      __hip_atomic_fetch_add(bar, 1u, __ATOMIC_RELAXED, __HIP_MEMORY_SCOPE_AGENT);
      while (__hip_atomic_load(bar, __ATOMIC_RELAXED, __HIP_MEMORY_SCOPE_AGENT) < n * G) __builtin_amdgcn_s_sleep(1);
    }
    __builtin_amdgcn_fence(__ATOMIC_ACQUIRE, "agent");
  }
  __syncthreads();
}

__global__ void __launch_bounds__(NTHR) fwd_megakernel(Params p) {
  extern __shared__ __attribute__((aligned(16))) char lds[];
  cg::grid_group grid = cg::this_grid();
  float* ldsf = (float*)lds;
#pragma unroll 1
  for (int ph2 = 0; ph2 < 2 * (2 + 9 * DEPTH); ++ph2) {
    const int ph = ph2 >> 1;
    int l = 0, kind = ph;
    if (ph >= 2) { l = (ph - 2) / 9; kind = 3 + (ph - 2) % 9; }
    if ((ph2 & 1) && !(l == 0 && ((PROBE_DUP >> kind) & 1))) continue;
    if (kind == 0) {
      convert_phase(p, ldsf);
      pad_phase(p);
      mod_phase(p, ldsf);
#pragma unroll 1
      for (int item = blockIdx.x; item < DEPTH * 264; item += gridDim.x) {
        const int ll = item / 264, r = item % 264;
        hy_mlp_item(p, ldsf, ll, r < 256 ? r : r - 256, r < 256);
      }
    } else if (kind == 1) {
#pragma unroll 1
      for (int item = blockIdx.x; item < 2 * DEPTH * 128; item += gridDim.x)
        khat_item(p, (float2*)lds, (item >> 7) & 3, (item & 127) * 2, item < DEPTH * 128);
    }
    if (kind == 0) {
    } else if (kind == 1 || kind == 8 || kind == 11) {
      row_pass(p, l, kind == 1 ? 0 : (kind == 8 ? 1 : 2));
    } else if (kind == 3) {
      inproj_phase(p, l, lds);
    } else if (kind == 4) {
      mixers_phase(p, l, lds);
    } else if (kind == 6) {
      merge_norm_phase(p, l == DEPTH - 1 ? T : MROWS);
    } else if (kind == 9) {
      ffn_up_phase(p, l, lds);
    } else {
      const bf16_t* A; const bf16_t* Wt; const float* bias; bf16_t* out; int lda, ldw, K, NTn, ocol0;
      if (kind == 5) { A = p.F; lda = 256; Wt = p.Wfn + (size_t)l * 256 * 256; ldw = 256; K = 256; NTn = 1; bias = p.fnet_b + l * 256; out = p.HO; ocol0 = 768; }
      else if (kind == 7) { A = p.HO; lda = HS; Wt = p.Wout + (size_t)l * D * HS; ldw = HS; K = D; NTn = 4; bias = p.b_out + l * D; out = p.Y; ocol0 = 0; }
      else { A = p.ACT; lda = DFFP; Wt = p.Wdn + (size_t)l * D * DFFP; ldw = DFFP; K = DFFP; NTn = 4; bias = p.ffn_b_down + l * D; out = p.Y; ocol0 = 0; }
      gemm_plain_phase(lds, A, lda, Wt, ldw, K, l == DEPTH - 1 ? T / 256 : MROWS / 256, NTn, bias, out, kind == 5 ? HS : D, ocol0, kind == 10 ? 1 : 0);
    }
    if (ph == 0) grid.sync();
    else grid_barrier(p.bar, (unsigned)ph);
  }
}

extern "C" void kernel_launch(void* const* d_in, const int* in_sizes, int n_in, void* d_out, int out_size, void* d_ws,
                              size_t ws_size, hipStream_t stream) {
  Params p{};
  const float** pf = (const float**)&p;
  for (int i = 0; i < 34; ++i) pf[i] = (const float*)d_in[i];
  p.out = (float*)d_out;
  char* w = (char*)d_ws;
  size_t off = 8192;
  p.bar = (unsigned*)d_ws;
  (void)hipMemsetAsync(d_ws, 0, 8192, stream);
  auto take = [&](size_t bytes) { char* r = w + off; off += (bytes + 255) & ~(size_t)255; return r; };
  p.Win = (bf16_t*)take((size_t)DEPTH * DP * HS * 2);
  p.Wout = (bf16_t*)take((size_t)DEPTH * D * HS * 2);
  p.Wup = (bf16_t*)take((size_t)DEPTH * 2 * DFFP * HS * 2);
  p.Wdn = (bf16_t*)take((size_t)DEPTH * D * DFFP * 2);
  p.bupP = (float*)take((size_t)DEPTH * 2 * DFFP * 4);
  p.cwP = (float*)take((size_t)DEPTH * 6 * DFFP * 4);
  p.cbP = (float*)take((size_t)DEPTH * 2 * DFFP * 4);
  p.Wfn = (bf16_t*)take((size_t)DEPTH * 256 * 256 * 2);
  p.mod = (float*)take((size_t)DEPTH * 9 * 6144 * 4);
  p.Khat = (float2*)take((size_t)DEPTH * 256 * 2 * SEQ * 8);
  p.Khatc = (float2*)take((size_t)DEPTH * 256 * 2 * CL * 8);
  p.cx = (float*)take((size_t)TC * D * 4);
  p.HO = (bf16_t*)take((size_t)(MROWS + 256) * HS * 2);
  p.Y = (bf16_t*)take((size_t)MROWS * D * 2);
  const size_t r0 = off;
  p.Zq = (bf16_t*)take((size_t)MROWS * HS * 2);
  p.ZT = (float*)take((size_t)NB * 1024 * SEQ * 4);
  p.ZTc = (float*)take((size_t)NB * 1024 * CL * 4);
  p.VT = (bf16_t*)take((size_t)2 * NB * 2 * 64 * LV * 2);
  p.F = (bf16_t*)take((size_t)MROWS * 256 * 2);
  const size_t r1 = off;
  p.ACT = (bf16_t*)(w + r0);
  p.kvec = (float*)(w + r0);
  p.kvecc = (float*)(w + r0 + (size_t)DEPTH * 256 * 2 * SEQ * 4);
  const size_t act_end = r0 + (size_t)MROWS * DFFP * 2;
  if (act_end > off) off = act_end;
  (void)r1;
  if (off > ws_size) fprintf(stderr, "workspace too small: need %zu have %zu\n", off, ws_size);
  static int grid_blocks = 0;
  if (!grid_blocks) {
    (void)hipFuncSetAttribute((const void*)fwd_megakernel, hipFuncAttributeMaxDynamicSharedMemorySize, (int)LDS_BYTES);
    int dev = 0, cus = 0, per_cu = 0;
    (void)hipGetDevice(&dev);
    (void)hipDeviceGetAttribute(&cus, hipDeviceAttributeMultiprocessorCount, dev);
    (void)hipOccupancyMaxActiveBlocksPerMultiprocessor(&per_cu, fwd_megakernel, NTHR, LDS_BYTES);
    if (per_cu > 1) per_cu = 1;
    grid_blocks = cus * per_cu;
  }
  void* args[] = {&p};
  hipError_t e = hipLaunchCooperativeKernel((void*)fwd_megakernel, dim3(grid_blocks), dim3(NTHR), args, LDS_BYTES, stream);
  if (e != hipSuccess) fprintf(stderr, "cooperative launch failed: %s (grid %d)\n", hipGetErrorString(e), grid_blocks);
}
```

```cpp
#include <hip/hip_runtime.h>
#include <hip/hip_cooperative_groups.h>
#include <stdint.h>
#include <cstdio>
namespace cg = cooperative_groups;

typedef unsigned short bf16_t;
typedef short bf16x8 __attribute__((ext_vector_type(8)));
typedef float f32x4 __attribute__((ext_vector_type(4)));
typedef float f32x16 __attribute__((ext_vector_type(16)));
typedef __bf16 bf2_t __attribute__((ext_vector_type(2)));
typedef float f2_t __attribute__((ext_vector_type(2)));

#define DI __device__ __forceinline__
typedef unsigned u32x2 __attribute__((ext_vector_type(2)));

constexpr int D = 1024, NB = 8, SEQ = 8192, DEPTH = 4, CL = 256;
constexpr int T = NB * SEQ, TC = NB * CL, MROWS = T + TC;
constexpr int DP = 2048, DFF = 2752, DFF2 = 5504, DFFP = 2816;
constexpr int LV = SEQ + CL + 64;
constexpr int HS = 1088;
constexpr int NTHR = 512;
constexpr float ALPHA = 1.681792830507429f;
constexpr float LOG2E = 1.4426950408889634f;
constexpr float INV2PI = 0.15915494309189535f;
constexpr size_t LDS_BYTES = 135168;
#ifndef PROBE_MIX
#define PROBE_MIX 0
#endif
#ifndef PROBE_DUP
#define PROBE_DUP 0x000
#endif

struct Params {
  const float *x, *c, *ctx, *c_ctx, *w_ada, *b_ada, *w_in, *sink_a, *q_norm_g, *k_norm_g,
      *hy_conv_w, *hy_conv_b, *hy_f_w1, *hy_f_b1, *hy_f_freq, *hy_f_w2, *hy_f_b2, *hy_f_w3, *hy_skip,
      *fnet_w, *fnet_b, *out_norm_g, *w_out, *b_out, *ln1_g, *ln1_b, *ffn_w_up, *ffn_b_up, *ffn_conv_w, *ffn_conv_b,
      *ffn_w_down, *ffn_b_down, *ln2_g, *ln2_b;
  float* out;
  bf16_t *Win, *Wout, *Wup, *Wdn, *Wfn;
  float* mod;
  float2 *Khat, *Khatc;
  float* cx;
  bf16_t *HO, *Y, *Zq;
  float *ZT, *ZTc;
  bf16_t *VT, *F;
  float *kvec, *kvecc;
  bf16_t* ACT;
  float *bupP, *cwP, *cbP;
  unsigned* bar;
};

DI int tidx() { int t = threadIdx.x; asm volatile("" : "+v"(t)); return t; }
DI unsigned pack2(float a, float b) {
  f2_t v = {a, b};
  bf2_t r = __builtin_convertvector(v, bf2_t);
  return __builtin_bit_cast(unsigned, r);
}
DI bf16_t f2bf(float a) { return (bf16_t)(pack2(a, 0.f) & 0xffffu); }
DI float bf2f(unsigned h) { return __uint_as_float(h << 16); }
DI float sin_rev(float r) { return __builtin_amdgcn_sinf(r); }
DI float cos_rev(float r) { return __builtin_amdgcn_cosf(r); }
#define dpp_f(v, ctrl, row_mask) __builtin_bit_cast(float, __builtin_amdgcn_update_dpp(0, __builtin_bit_cast(int, (float)(v)), (ctrl), (row_mask), 0xf, false))
DI float row16_sum(float v) {
  v += dpp_f(v, 0xB1, 0xf);
  v += dpp_f(v, 0x4E, 0xf);
  v += dpp_f(v, 0x141, 0xf);
  v += dpp_f(v, 0x140, 0xf);
  return v;
}
DI float wave_sum(float v) {
  v = row16_sum(v);
  v += dpp_f(v, 0x142, 0xa);
  v += dpp_f(v, 0x143, 0xc);
  return __builtin_bit_cast(float, __builtin_amdgcn_readlane(__builtin_bit_cast(int, v), 63));
}
DI float siluf(float x) { return x * __builtin_amdgcn_rcpf(1.f + __builtin_amdgcn_exp2f(-1.4426950408889634f * x)); }

DI int grid8() { return (int)(gridDim.x & ~7u); }
DI int xcd_local(int it, int per_xcd) {
  const int G8 = grid8();
  if ((int)blockIdx.x >= G8) return -1;
  const int loc = it * (G8 >> 3) + ((int)blockIdx.x >> 3);
  return loc < per_xcd ? loc : -1;
}
DI bool tile_map(int it, int MT, int NTn, int& mt, int& nt) {
  const int G8 = grid8();
  if ((int)blockIdx.x >= G8) return false;
  const int xcd = blockIdx.x & 7, slot = blockIdx.x >> 3, SL = G8 >> 3;
  const int MTx = (MT - xcd + 7) >> 3;
  const int q = it * SL + slot;
  if (q >= MTx * NTn) return false;
  const int gm = q / (4 * NTn), rem = q - gm * 4 * NTn;
  int gsz = MTx - 4 * gm;
  if (gsz > 4) gsz = 4;
  nt = rem / gsz;
  mt = xcd + 8 * (gm * 4 + rem % gsz);
  return true;
}

typedef __attribute__((address_space(3))) unsigned char lds_uc;
constexpr int HTB = 16384;
DI int lds_byte(int r, int c) {
  const int st = (r >> 4) * 2 + (c >> 5), rr = r & 15, cc = c & 31, ob = rr * 64 + cc * 2;
  return st * 1024 + (ob ^ (((ob >> 9) & 1) << 5));
}
DI void stage_rc(int b, int& R, int& C) {
  const int st = b >> 10, sb = b & 1023, swz = sb ^ (((sb >> 9) & 1) << 5);
  R = (st >> 1) * 16 + (swz >> 6);
  C = (st & 1) * 32 + ((swz & 63) >> 1);
}
struct PgUnit { const char* A; const char* B; int mt, nt; };
struct PgDesc { size_t a_h, b_h; int nk; unsigned voffA, voffB; size_t dA, dB; };
#define PG_WAIT_V(n) asm volatile("s_waitcnt vmcnt(" #n ")" ::: "memory")
#define PG_WAIT_L(n) asm volatile("s_waitcnt lgkmcnt(" #n ")" ::: "memory")
#define PG_BAR __builtin_amdgcn_s_barrier()
#define PG_SCHED __builtin_amdgcn_sched_barrier(0)

template <class Src, class Epi>
DI void pgemm(char* lds_, const PgDesc& d, const Src& src, const Epi& epi) {
  lds_uc* lds = (lds_uc*)lds_;
  const int tid = tidx(), wid = __builtin_amdgcn_readfirstlane(tid >> 6), lane = tid & 63, wr = wid >> 2, wc = wid & 3, fr = lane & 15, fq = lane >> 4;
  const int nt = d.nk;
  const size_t kstep = 128, ah = d.a_h, bh = d.b_h, voffA_d = d.dA, voffB_d = d.dB;
  const unsigned voffA = d.voffA, voffB = d.voffB;
  const unsigned ldsw = (unsigned)wid * 1024u;
  const int aoff = lds_byte(wr * 64 + fr, fq * 8), boff = lds_byte(wc * 32 + fr, fq * 8);
#define PG_SA(b, h) (((b) * 2 + (h)) * HTB)
#define PG_SB(b, h) ((4 + (b) * 2 + (h)) * HTB)
#define PG_STAGE(bufoff, gbase, voff) do { _Pragma("unroll") for (int _i = 0; _i < 2; ++_i) \
    __builtin_amdgcn_global_load_lds((const unsigned*)((const char*)(gbase) + (size_t)_i * voff##_d + voff), (__attribute__((address_space(3))) unsigned*)(lds + (bufoff) + ldsw + _i * 8192), 16, 0, 0); } while (0)
#define PG_LDA(dst, b, h) do { _Pragma("unroll") for (int m = 0; m < 4; ++m) _Pragma("unroll") for (int k = 0; k < 2; ++k) dst[m][k] = *(const __attribute__((address_space(3))) bf16x8*)(lds + PG_SA(b, h) + aoff + m * 2048 + k * 1024); } while (0)
#define PG_LDB(dst, b, h) do { _Pragma("unroll") for (int n = 0; n < 2; ++n) _Pragma("unroll") for (int k = 0; k < 2; ++k) dst[n][k] = *(const __attribute__((address_space(3))) bf16x8*)(lds + PG_SB(b, h) + boff + n * 2048 + k * 1024); } while (0)
#define PG_MMA(ai, bj, At, Bt) do { __builtin_amdgcn_s_setprio(1); _Pragma("unroll") for (int m = 0; m < 4; ++m) _Pragma("unroll") for (int n = 0; n < 2; ++n) _Pragma("unroll") for (int k = 0; k < 2; ++k) \
    acc[ai][bj][m][n] = __builtin_amdgcn_mfma_f32_16x16x32_bf16(Bt[n][k], At[m][k], acc[ai][bj][m][n], 0, 0, 0); __builtin_amdgcn_s_setprio(0); } while (0)
  PgUnit cur, nxt;
  int ui = 0;
  if (!src.next(0, cur)) return;
  f32x4 acc[2][2][4][2];
#pragma unroll
  for (int a = 0; a < 2; ++a)
#pragma unroll
    for (int b = 0; b < 2; ++b)
#pragma unroll
      for (int m = 0; m < 4; ++m)
#pragma unroll
        for (int n = 0; n < 2; ++n) acc[a][b][m][n] = (f32x4){0.f, 0.f, 0.f, 0.f};
  bf16x8 At[4][2], B0[2][2], B1[2][2];
  const char* cA = cur.A;
  const char* cB = cur.B;
  PG_WAIT_V(0);
  PG_STAGE(PG_SB(0, 0), cB, voffB); PG_STAGE(PG_SA(0, 0), cA, voffA); PG_STAGE(PG_SB(0, 1), cB + bh, voffB); PG_STAGE(PG_SA(0, 1), cA + ah, voffA);
  if (wr == 1) PG_BAR;
  PG_WAIT_V(4); PG_BAR;
  PG_STAGE(PG_SB(1, 0), cB + kstep, voffB); PG_STAGE(PG_SA(1, 0), cA + kstep, voffA); PG_STAGE(PG_SB(1, 1), cB + bh + kstep, voffB);
  PG_WAIT_V(6); PG_BAR;
  for (;;) {
    const bool has_next = src.next(ui + 1, nxt);
    const char* nA = has_next ? nxt.A : cA;
    const char* nB = has_next ? nxt.B : cB;
    for (int t = 0; t < nt; t += 2) {
      const bool last = (t == nt - 2);
      const char* a1 = cA + (size_t)(t + 1) * kstep;
      const char* a2 = last ? nA : cA + (size_t)(t + 2) * kstep;
      const char* b2 = last ? nB : cB + (size_t)(t + 2) * kstep;
      const char* a3 = a2 + kstep;
      const char* b3 = b2 + kstep;
      PG_LDB(B0, 0, 0); PG_SCHED; PG_LDA(At, 0, 0); PG_STAGE(PG_SA(1, 1), a1 + ah, voffA);
      PG_WAIT_L(8); PG_BAR; PG_WAIT_L(0); PG_MMA(0, 0, At, B0); PG_BAR; PG_SCHED;
      PG_LDB(B1, 0, 1); PG_STAGE(PG_SB(0, 0), b2, voffB);
      PG_BAR; PG_WAIT_L(0); PG_MMA(0, 1, At, B1); PG_BAR;
      PG_LDA(At, 0, 1); PG_STAGE(PG_SA(0, 0), a2, voffA);
      PG_BAR; PG_WAIT_L(0); PG_MMA(1, 0, At, B0); PG_BAR; PG_SCHED;
      PG_STAGE(PG_SB(0, 1), b2 + bh, voffB);
      PG_WAIT_V(6); PG_BAR; PG_MMA(1, 1, At, B1); PG_BAR;
      PG_LDB(B0, 1, 0); PG_SCHED; PG_LDA(At, 1, 0); PG_STAGE(PG_SA(0, 1), a2 + ah, voffA);
      PG_WAIT_L(8); PG_BAR; PG_WAIT_L(0); PG_MMA(0, 0, At, B0); PG_BAR; PG_SCHED;
      PG_LDB(B1, 1, 1); PG_STAGE(PG_SB(1, 0), b3, voffB);
      PG_BAR; PG_WAIT_L(0); PG_MMA(0, 1, At, B1); PG_BAR;
      PG_LDA(At, 1, 1); PG_STAGE(PG_SA(1, 0), a3, voffA);
      PG_BAR; PG_WAIT_L(0); PG_MMA(1, 0, At, B0); PG_BAR; PG_SCHED;
      PG_STAGE(PG_SB(1, 1), b3 + bh, voffB);
      PG_WAIT_V(6); PG_BAR; PG_MMA(1, 1, At, B1); PG_BAR;
    }
    epi(acc, cur, wr, wc, fr, fq);
    if (!has_next) break;
#pragma unroll
    for (int a = 0; a < 2; ++a)
#pragma unroll
      for (int b = 0; b < 2; ++b)
#pragma unroll
        for (int m = 0; m < 4; ++m)
#pragma unroll
          for (int n = 0; n < 2; ++n) acc[a][b][m][n] = (f32x4){0.f, 0.f, 0.f, 0.f};
    cur = nxt; cA = nA; cB = nB; ++ui;
  }
  PG_WAIT_V(0);
  if (wr == 0) PG_BAR;
  PG_BAR;
#undef PG_SA
#undef PG_SB
#undef PG_STAGE
#undef PG_LDA
#undef PG_LDB
#undef PG_MMA
}

struct PlainSrc {
  const bf16_t* A; const bf16_t* Wt; int lda, ldw, MT, NTn, rev;
  DI bool next(int i, PgUnit& u) const {
    if (!tile_map(i, MT, NTn, u.mt, u.nt)) return false;
    if (rev) u.mt = MT - 1 - u.mt;
    u.A = (const char*)(A + (size_t)u.mt * 256 * lda);
    u.B = (const char*)(Wt + (size_t)u.nt * 256 * ldw);
    return true;
  }
};
struct PlainEpi {
  const float* bias; bf16_t* out; int ldo, ocol0;
  DI void operator()(f32x4 (&acc)[2][2][4][2], const PgUnit& u, int wr, int wc, int fr, int fq) const {
    asm volatile("" : "+v"(fr), "+v"(fq));
#pragma unroll
    for (int bj = 0; bj < 2; ++bj)
#pragma unroll
      for (int n = 0; n < 2; ++n) {
        const int col = u.nt * 256 + bj * 128 + wc * 32 + n * 16 + fq * 4;
        const float4 bv = *(const float4*)(bias + col);
#pragma unroll
        for (int ai = 0; ai < 2; ++ai)
#pragma unroll
          for (int m = 0; m < 4; ++m) {
            const int row = u.mt * 256 + ai * 128 + wr * 64 + m * 16 + fr;
            uint2 w;
            w.x = pack2(acc[ai][bj][m][n][0] + bv.x, acc[ai][bj][m][n][1] + bv.y);
            w.y = pack2(acc[ai][bj][m][n][2] + bv.z, acc[ai][bj][m][n][3] + bv.w);
            *(uint2*)(out + (size_t)row * ldo + ocol0 + col) = w;
          }
      }
  }
};
DI void gemm_plain_phase(char* lds, const bf16_t* A, int lda, const bf16_t* Wt, int ldw, int K, int MT, int NTn, const float* bias,
                         bf16_t* out, int ldo, int ocol0, int rev) {
  PgDesc d;
  d.a_h = (size_t)128 * lda * 2; d.b_h = (size_t)128 * ldw * 2; d.nk = K / 64;
  {
    int R, C;
    stage_rc(tidx() * 16, R, C);
    d.voffA = (unsigned)(R * lda + C) * 2u; d.dA = (size_t)64 * lda * 2;
    d.voffB = (unsigned)(R * ldw + C) * 2u; d.dB = (size_t)64 * ldw * 2;
  }
  PlainSrc src{A, Wt, lda, ldw, MT, NTn, rev};
  PlainEpi epi{bias, out, ldo, ocol0};
  pgemm(lds, d, src, epi);
}

struct InprojSrc {
  const bf16_t* A; const bf16_t* Wt;
  DI bool next(int i, PgUnit& u) const {
    if (!tile_map(i, MROWS / 256, DP / 256, u.mt, u.nt)) return false;
    u.A = (const char*)(A + (size_t)u.mt * 256 * HS);
    u.B = (const char*)(Wt + (size_t)u.nt * 256 * HS);
    return true;
  }
};
struct InprojEpi {
  const Params* pp; int l;
  DI void operator()(f32x4 (&acc)[2][2][4][2], const PgUnit& u, int wr, int wc, int fr, int fq) const {
    asm volatile("" : "+v"(fr), "+v"(fq));
    const Params& p = *pp;
    const int mt = u.mt, hs = u.nt * 4 + wc;
    const bool isctx = mt >= 256;
    int b, t0;
    if (!isctx) { const int row0 = mt * 256; b = row0 >> 13; t0 = row0 & (SEQ - 1); }
    else { b = mt - 256; t0 = 0; }
    const int rb = wr * 64 + fr;
    if (hs < 6 || (hs >= 8 && hs < 14)) {
      const bool isB = hs >= 8;
      const int hh = isB ? hs - 8 : hs;
      const bool isq = hh < 4;
      if (isB) {
        const float* gp = (isq ? p.q_norm_g : p.k_norm_g) + l * 64 + fq * 4;
        const float4 g00 = *(const float4*)(gp), g01 = *(const float4*)(gp + 16), g10 = *(const float4*)(gp + 32), g11 = *(const float4*)(gp + 48);
#pragma unroll
        for (int ai = 0; ai < 2; ++ai)
#pragma unroll
          for (int m = 0; m < 4; ++m) {
            float ss = 0.f;
#pragma unroll
            for (int bj = 0; bj < 2; ++bj)
#pragma unroll
              for (int n = 0; n < 2; ++n)
#pragma unroll
                for (int j = 0; j < 4; ++j) ss += acc[ai][bj][m][n][j] * acc[ai][bj][m][n][j];
            ss += __shfl_xor(ss, 16, 64); ss += __shfl_xor(ss, 32, 64);
            const float r = rsqrtf(ss * (1.f / 64.f) + 1e-6f);
            acc[ai][0][m][0] *= (f32x4){g00.x * r, g00.y * r, g00.z * r, g00.w * r};
            acc[ai][0][m][1] *= (f32x4){g01.x * r, g01.y * r, g01.z * r, g01.w * r};
            acc[ai][1][m][0] *= (f32x4){g10.x * r, g10.y * r, g10.z * r, g10.w * r};
            acc[ai][1][m][1] *= (f32x4){g11.x * r, g11.y * r, g11.z * r, g11.w * r};
            __builtin_amdgcn_sched_barrier(0);
          }
      }
      if (!isctx) {
        float inv[4];
#pragma unroll
        for (int j = 0; j < 4; ++j) inv[j] = exp2f(-(float)(fq * 4 + j) * (13.287712379549449f / 16.f)) * INV2PI;
#pragma unroll
        for (int ai = 0; ai < 2; ++ai)
#pragma unroll
          for (int m = 0; m < 4; ++m) {
            const int t = t0 + ai * 128 + rb + m * 16;
            const float p0 = (float)(t >> 6), p1 = (float)(t & 63);
#pragma unroll
            for (int j = 0; j < 4; ++j) {
              const float a0 = p0 * inv[j], a1 = p1 * inv[j];
              const float c0 = cos_rev(a0), s0 = sin_rev(a0), c1 = cos_rev(a1), s1 = sin_rev(a1);
              const float x1 = acc[ai][0][m][0][j], x2 = acc[ai][0][m][1][j], y1 = acc[ai][1][m][0][j], y2 = acc[ai][1][m][1][j];
              acc[ai][0][m][0][j] = x1 * c0 - x2 * s0; acc[ai][0][m][1][j] = x2 * c0 + x1 * s0;
              acc[ai][1][m][0][j] = y1 * c1 - y2 * s1; acc[ai][1][m][1][j] = y2 * c1 + y1 * s1;
            }
            __builtin_amdgcn_sched_barrier(0);
          }
      }
      const float sc = isq ? 0.125f * LOG2E : 1.f;
#pragma unroll
      for (int ai = 0; ai < 2; ++ai)
#pragma unroll
        for (int m = 0; m < 4; ++m) {
          bf16_t* zr = p.Zq + (size_t)(mt * 256 + ai * 128 + rb + m * 16) * HS + hs * 64 + fq * 4;
#pragma unroll
          for (int bj = 0; bj < 2; ++bj)
#pragma unroll
            for (int n = 0; n < 2; ++n) {
              uint2 w;
              w.x = pack2(acc[ai][bj][m][n][0] * sc, acc[ai][bj][m][n][1] * sc);
              w.y = pack2(acc[ai][bj][m][n][2] * sc, acc[ai][bj][m][n][3] * sc);
              *(uint2*)(zr + bj * 32 + n * 16) = w;
            }
        }
    } else if (hs < 16) {
      const int grp = hs >= 14 ? 1 : 0, kvh = hs & 1;
      bf16_t* vb = p.VT + (size_t)((grp * 8 + b) * 2 + kvh) * 64 * LV + (isctx ? SEQ : 0) + t0 + rb;
#pragma unroll
      for (int bj = 0; bj < 2; ++bj)
#pragma unroll
        for (int n = 0; n < 2; ++n)
#pragma unroll
          for (int j = 0; j < 4; ++j) {
            bf16_t* vd = vb + (size_t)(bj * 32 + n * 16 + fq * 4 + j) * LV;
#pragma unroll
            for (int ai = 0; ai < 2; ++ai)
#pragma unroll
              for (int m = 0; m < 4; ++m) vd[ai * 128 + m * 16] = f2bf(acc[ai][bj][m][n][j]);
          }
    } else {
      const int colb = hs * 64 - 1024;
      const int Ls = isctx ? CL : SEQ;
      float* zb = (isctx ? p.ZTc + (size_t)b * 1024 * CL : p.ZT + (size_t)b * 1024 * SEQ) + t0 + rb;
#pragma unroll
      for (int bj = 0; bj < 2; ++bj)
#pragma unroll
        for (int n = 0; n < 2; ++n)
#pragma unroll
          for (int j = 0; j < 4; ++j) {
            float* zd = zb + (size_t)(colb + bj * 32 + n * 16 + fq * 4 + j) * Ls;
#pragma unroll
            for (int ai = 0; ai < 2; ++ai)
#pragma unroll
              for (int m = 0; m < 4; ++m) __builtin_nontemporal_store(acc[ai][bj][m][n][j], zd + ai * 128 + m * 16);
          }
    }
  }
};
DI void inproj_phase(const Params& p, int l, char* lds) {
  PgDesc d;
  d.a_h = (size_t)128 * HS * 2; d.b_h = (size_t)32 * HS * 2; d.nk = D / 64;
  {
    int R, C;
    stage_rc(tidx() * 16, R, C);
    d.voffA = (unsigned)(R * HS + C) * 2u; d.dA = (size_t)64 * HS * 2;
    d.voffB = (unsigned)(((R >> 5) * 64 + (R & 31)) * HS + C) * 2u; d.dB = (size_t)128 * HS * 2;
  }
  InprojSrc src{p.HO, p.Win + (size_t)l * DP * HS};
  InprojEpi epi{&p, l};
  pgemm(lds, d, src, epi);
}

DI float dpp_ror1(float v) { return __builtin_bit_cast(float, __builtin_amdgcn_update_dpp(0, __builtin_bit_cast(int, v), 0x121, 0xf, 0xf, false)); }
DI float dpp_rol1(float v) { return __builtin_bit_cast(float, __builtin_amdgcn_update_dpp(0, __builtin_bit_cast(int, v), 0x12f, 0xf, 0xf, false)); }
DI float row_prev(float prevreg, float cur) {
  return __builtin_bit_cast(float, __builtin_amdgcn_update_dpp(__builtin_bit_cast(int, dpp_ror1(prevreg)), __builtin_bit_cast(int, cur), 0x111, 0xf, 0xf, false));
}
DI float row_next(float nextreg, float cur) {
  return __builtin_bit_cast(float, __builtin_amdgcn_update_dpp(__builtin_bit_cast(int, dpp_rol1(nextreg)), __builtin_bit_cast(int, cur), 0x101, 0xf, 0xf, false));
}
constexpr int FUP_MT = 8 * 33 + 8 * 2, FUP_NT = DFFP / 128;
DI void ffn_tile(int mt, int& Ls, int& rowbase, int& ti) {
  if (mt < 264) { const int b = mt / 33; ti = mt - b * 33; Ls = SEQ; rowbase = b * SEQ; }
  else { const int q = mt - 264; const int b = q >> 1; ti = q & 1; Ls = CL; rowbase = T + b * CL; }
}
struct FfnUpSrc {
  const bf16_t* A; const bf16_t* Wt; int MT;
  DI bool next(int i, PgUnit& u) const {
    if (!tile_map(i, MT, FUP_NT, u.mt, u.nt)) return false;
    int Ls, rowbase, ti;
    ffn_tile(u.mt, Ls, rowbase, ti);
    u.A = (const char*)(A + ((long)rowbase + 252 * ti - 1) * HS);
    u.B = (const char*)(Wt + (size_t)u.nt * 128 * HS);
    return true;
  }
};
struct FfnUpEpi {
  const float *bup, *cw, *cb; bf16_t* act;
  DI void operator()(f32x4 (&acc)[2][2][4][2], const PgUnit& u, int wr, int wc, int fr, int fq) const {
    asm volatile("" : "+v"(fr), "+v"(fq));
    int Ls, rowbase, ti;
    ffn_tile(u.mt, Ls, rowbase, ti);
    const int tw = 252 * ti - 1 + 126 * wr;
    bf16_t* ob = act + (size_t)rowbase * DFFP;
#pragma unroll
    for (int n = 0; n < 2; ++n)
#pragma unroll
      for (int jp = 0; jp < 2; ++jp) {
        int col = u.nt * 128 + wc * 32 + n * 16 + fq * 4 + jp * 2;
        asm volatile("" : "+v"(col) :: "memory");
        float oo[8][2];
#pragma unroll
        for (int jj = 0; jj < 2; ++jj) {
          const int j = jp * 2 + jj, c = col + jj;
          {
            const float bu = bup[c], w0 = cw[c], w1 = cw[2 * DFFP + c], w2 = cw[4 * DFFP + c], bb = cb[c];
            float ua[8];
#pragma unroll
            for (int q = 0; q < 8; ++q) {
              const int t = tw + fr * 8 + q;
              ua[q] = (t >= 0 && t < Ls) ? acc[q >> 2][0][q & 3][n][j] + bu : 0.f;
            }
            const float upl = __builtin_bit_cast(float, __builtin_amdgcn_update_dpp(0, __builtin_bit_cast(int, ua[7]), 0x111, 0xf, 0xf, false));
            const float dnl = __builtin_bit_cast(float, __builtin_amdgcn_update_dpp(0, __builtin_bit_cast(int, ua[0]), 0x101, 0xf, 0xf, false));
#pragma unroll
            for (int q = 0; q < 8; ++q) {
              const float up = q > 0 ? ua[q > 0 ? q - 1 : 0] : upl;
              const float dn = q < 7 ? ua[q < 7 ? q + 1 : 7] : dnl;
              oo[q][jj] = siluf(w0 * up + w1 * ua[q] + w2 * dn + bb);
            }
          }
          {
            const float bu = bup[DFFP + c], w0 = cw[DFFP + c], w1 = cw[3 * DFFP + c], w2 = cw[5 * DFFP + c], bb = cb[DFFP + c];
            float ug[8];
#pragma unroll
            for (int q = 0; q < 8; ++q) {
              const int t = tw + fr * 8 + q;
              ug[q] = (t >= 0 && t < Ls) ? acc[q >> 2][1][q & 3][n][j] + bu : 0.f;
            }
            const float upl = __builtin_bit_cast(float, __builtin_amdgcn_update_dpp(0, __builtin_bit_cast(int, ug[7]), 0x111, 0xf, 0xf, false));
            const float dnl = __builtin_bit_cast(float, __builtin_amdgcn_update_dpp(0, __builtin_bit_cast(int, ug[0]), 0x101, 0xf, 0xf, false));
#pragma unroll
            for (int q = 0; q < 8; ++q) {
              const float up = q > 0 ? ug[q > 0 ? q - 1 : 0] : upl;
              const float dn = q < 7 ? ug[q < 7 ? q + 1 : 7] : dnl;
              oo[q][jj] *= (w0 * up + w1 * ug[q] + w2 * dn + bb);
            }
          }
        }
#pragma unroll
        for (int q = 0; q < 8; ++q) {
          const int lr = fr * 8 + q;
          const int t = tw + lr;
          if (lr >= 1 && lr <= 126 && t < Ls) *(unsigned*)(ob + (size_t)t * DFFP + col) = pack2(oo[q][0], oo[q][1]);
        }
        __builtin_amdgcn_sched_barrier(0);
      }
  }
};
DI void ffn_up_phase(const Params& p, int l, char* lds) {
  PgDesc d;
  d.a_h = (size_t)4 * HS * 2; d.b_h = (size_t)DFFP * HS * 2; d.nk = D / 64;
  {
    int R, C;
    stage_rc(tidx() * 16, R, C);
    d.voffA = (unsigned)(((R & 15) * 8 + (R >> 4)) * HS + C) * 2u; d.dA = (size_t)126 * HS * 2;
    d.voffB = (unsigned)(R * HS + C) * 2u; d.dB = (size_t)64 * HS * 2;
  }
  FfnUpSrc src{p.HO, p.Wup + (size_t)l * 2 * DFFP * HS, l == DEPTH - 1 ? 264 : FUP_MT};
  FfnUpEpi epi{p.bupP + (size_t)l * 2 * DFFP, p.cwP + (size_t)l * 6 * DFFP, p.cbP + (size_t)l * 2 * DFFP, p.ACT};
  pgemm(lds, d, src, epi);
}

DI int crow(int i, int h) { return (i & 3) + 8 * (i >> 2) + 4 * h; }
template <bool FIXED>
DI void attn_item(const Params& p, int l, char* lds, int grp, int b, int kvh, int qrow0, int qpos0, int jfirst, int nloc,
                  bool window) {
  const int tid = tidx(), lane = tid & 63, wave = tid >> 6, g = wave >> 2, qw = wave & 3;
  const int q31 = lane & 31, h = lane >> 5;
  const int head = kvh * 2 + g;
  const int qcol = (grp ? 512 : 0) + head * 64, kcol = (grp ? 768 : 256) + kvh * 64;
  const bf16_t* Zq = p.Zq;
  bf16x8 qf[4];
  {
    const bf16_t* qp = Zq + (size_t)(qrow0 + qw * 32 + q31) * HS + qcol + h * 8;
#pragma unroll
    for (int kk = 0; kk < 4; ++kk) qf[kk] = *(const bf16x8*)(qp + kk * 16);
  }
  const bf16_t* vt = p.VT + (size_t)((grp * 8 + b) * 2 + kvh) * 64 * LV;
  float m_run, l_run;
  if (grp == 0) { m_run = p.sink_a[l * 4 + head] * LOG2E; l_run = 1.f; }
  else { m_run = -1e30f; l_run = 0.f; }
  if (FIXED) {
    float gq = fabsf(p.q_norm_g[l * 64 + lane]), gk = fabsf(p.k_norm_g[l * 64 + lane]);
#pragma unroll
    for (int m = 32; m >= 1; m >>= 1) { gq = fmaxf(gq, __shfl_xor(gq, m, 64)); gk = fmaxf(gk, __shfl_xor(gk, m, 64)); }
    m_run = 8.f * LOG2E * gq * gk * 1.001f + 0.01f;
  }
  f32x16 O0, O1;
#pragma unroll
  for (int i = 0; i < 16; ++i) { O0[i] = 0.f; O1[i] = 0.f; }
  const int ntiles = nloc + 4;
  const int srow = tid >> 3, sch = tid & 7;
  char* Kl = lds;
  char* Vl = lds + 4 * 9216;
  uint4 rkA, rvA, rkB, rvB;
#define TILEJ(ti) ((ti) < nloc ? jfirst + (ti) * 64 : SEQ + ((ti) - nloc) * 64)
#define AGLOAD(rk, rv, ti)                                                                                 \
  {                                                                                                        \
    const int j_ = TILEJ(ti);                                                                              \
    const int key_ = j_ + srow;                                                                            \
    const size_t krow_ = key_ < SEQ ? (size_t)b * SEQ + key_ : (size_t)T + (size_t)b * CL + (key_ - SEQ);  \
    rk = *(const uint4*)(Zq + krow_ * HS + kcol + sch * 8);                                                \
    rv = *(const uint4*)(vt + (size_t)srow * LV + j_ + sch * 8);                                           \
  }
#define ASWRITE(rk, rv, slot)                                                                              \
  {                                                                                                        \
    *(uint4*)(Kl + (slot) * 9216 + srow * 144 + sch * 16) = rk;                                            \
    uint2* vp_ = (uint2*)(Vl + (slot) * 8704 + srow * 136 + sch * 16);                                     \
    vp_[0] = make_uint2(rv.x, rv.y);                                                                       \
    vp_[1] = make_uint2(rv.z, rv.w);                                                                       \
  }
  AGLOAD(rkA, rvA, 0);
  AGLOAD(rkB, rvB, 1);
  ASWRITE(rkA, rvA, 0);
  ASWRITE(rkB, rvB, 1);
  __syncthreads();
  if (wave < 4) __builtin_amdgcn_s_setprio(1);
  const int qpos = qpos0 + qw * 32 + q31;
  int s0 = 0;
#pragma unroll 1
  for (int ti = 0; ti < ntiles; ti += 2) {
    const int s1 = s0 + 1, s2 = 2 - s0;
    if (ti + 2 < ntiles) { AGLOAD(rkA, rvA, ti + 2); AGLOAD(rkB, rvB, ti + 3); }
    {
      const int tcur = ti;
      const char* kb = Kl + s0 * 9216;
      const char* vb = Vl + s0 * 8704;
    f32x16 S0, S1;
    const float sinit = FIXED ? -m_run : 0.f;
#pragma unroll
    for (int i = 0; i < 16; ++i) { S0[i] = sinit; S1[i] = sinit; }
    bf16x8 kf[8];
    union { uint2 u[2]; bf16x8 v; } vfr[8];
#pragma unroll
    for (int kk = 0; kk < 4; ++kk) {
      kf[2 * kk] = *(const bf16x8*)(kb + q31 * 144 + kk * 32 + h * 16);
      kf[2 * kk + 1] = *(const bf16x8*)(kb + (32 + q31) * 144 + kk * 32 + h * 16);
    }
#pragma unroll
    for (int c = 0; c < 4; ++c)
#pragma unroll
      for (int ds = 0; ds < 2; ++ds) {
        const char* vp = vb + (ds * 32 + q31) * 136 + (16 * c + h * 4) * 2;
        vfr[c * 2 + ds].u[0] = *(const uint2*)vp;
        vfr[c * 2 + ds].u[1] = *(const uint2*)(vp + 16);
      }
    __builtin_amdgcn_sched_barrier(0);
#pragma unroll
    for (int kk = 0; kk < 4; ++kk) {
      S0 = __builtin_amdgcn_mfma_f32_32x32x16_bf16(kf[2 * kk], qf[kk], S0, 0, 0, 0);
      S1 = __builtin_amdgcn_mfma_f32_32x32x16_bf16(kf[2 * kk + 1], qf[kk], S1, 0, 0, 0);
    }
    const int j = TILEJ(tcur);
    if (window && j < SEQ) {
#pragma unroll
      for (int i = 0; i < 16; ++i) {
        const int kp = j + crow(i, h);
        int d0 = kp - qpos; d0 = d0 < 0 ? -d0 : d0;
        int d1 = kp + 32 - qpos; d1 = d1 < 0 ? -d1 : d1;
        S0[i] = d0 <= 128 ? S0[i] : -1e30f;
        S1[i] = d1 <= 128 ? S1[i] : -1e30f;
      }
    }
    if (FIXED) {
      float rs = 0.f;
#pragma unroll
      for (int i = 0; i < 16; ++i) {
        S0[i] = __builtin_amdgcn_exp2f(S0[i]);
        S1[i] = __builtin_amdgcn_exp2f(S1[i]);
        rs += S0[i] + S1[i];
      }
      l_run += rs;
    } else {
      float mx = S0[0];
#pragma unroll
      for (int i = 1; i < 16; ++i) mx = fmaxf(mx, S0[i]);
#pragma unroll
      for (int i = 0; i < 16; ++i) mx = fmaxf(mx, S1[i]);
      mx = fmaxf(mx, __shfl_xor(mx, 32, 64));
      const float mnew = fmaxf(m_run, mx);
      const float alpha = __builtin_amdgcn_exp2f(m_run - mnew);
      float rs = 0.f;
#pragma unroll
      for (int i = 0; i < 16; ++i) {
        S0[i] = __builtin_amdgcn_exp2f(S0[i] - mnew);
        S1[i] = __builtin_amdgcn_exp2f(S1[i] - mnew);
        rs += S0[i] + S1[i];
      }
      rs += __shfl_xor(rs, 32, 64);
      l_run = l_run * alpha + rs;
      m_run = mnew;
#pragma unroll
      for (int i = 0; i < 16; ++i) { O0[i] *= alpha; O1[i] *= alpha; }
    }
#pragma unroll
    for (int c = 0; c < 4; ++c) {
      union { unsigned u[4]; bf16x8 v; } pf;
      if (c < 2) {
#pragma unroll
        for (int e = 0; e < 4; ++e) pf.u[e] = pack2(S0[(c & 1) * 8 + 2 * e], S0[(c & 1) * 8 + 2 * e + 1]);
      } else {
#pragma unroll
        for (int e = 0; e < 4; ++e) pf.u[e] = pack2(S1[(c & 1) * 8 + 2 * e], S1[(c & 1) * 8 + 2 * e + 1]);
      }
      O0 = __builtin_amdgcn_mfma_f32_32x32x16_bf16(vfr[c * 2].v, pf.v, O0, 0, 0, 0);
      O1 = __builtin_amdgcn_mfma_f32_32x32x16_bf16(vfr[c * 2 + 1].v, pf.v, O1, 0, 0, 0);
    }

    }
    {
      const int tcur = ti + 1;
      const char* kb = Kl + s1 * 9216;
      const char* vb = Vl + s1 * 8704;
    f32x16 S0, S1;
    const float sinit = FIXED ? -m_run : 0.f;
#pragma unroll
    for (int i = 0; i < 16; ++i) { S0[i] = sinit; S1[i] = sinit; }
    bf16x8 kf[8];
    union { uint2 u[2]; bf16x8 v; } vfr[8];
#pragma unroll
    for (int kk = 0; kk < 4; ++kk) {
      kf[2 * kk] = *(const bf16x8*)(kb + q31 * 144 + kk * 32 + h * 16);
      kf[2 * kk + 1] = *(const bf16x8*)(kb + (32 + q31) * 144 + kk * 32 + h * 16);
    }
#pragma unroll
    for (int c = 0; c < 4; ++c)
#pragma unroll
      for (int ds = 0; ds < 2; ++ds) {
        const char* vp = vb + (ds * 32 + q31) * 136 + (16 * c + h * 4) * 2;
        vfr[c * 2 + ds].u[0] = *(const uint2*)vp;
        vfr[c * 2 + ds].u[1] = *(const uint2*)(vp + 16);
      }
    __builtin_amdgcn_sched_barrier(0);
#pragma unroll
    for (int kk = 0; kk < 4; ++kk) {
      S0 = __builtin_amdgcn_mfma_f32_32x32x16_bf16(kf[2 * kk], qf[kk], S0, 0, 0, 0);
      S1 = __builtin_amdgcn_mfma_f32_32x32x16_bf16(kf[2 * kk + 1], qf[kk], S1, 0, 0, 0);
    }
    const int j = TILEJ(tcur);
    if (window && j < SEQ) {
#pragma unroll
      for (int i = 0; i < 16; ++i) {
        const int kp = j + crow(i, h);
        int d0 = kp - qpos; d0 = d0 < 0 ? -d0 : d0;
        int d1 = kp + 32 - qpos; d1 = d1 < 0 ? -d1 : d1;
        S0[i] = d0 <= 128 ? S0[i] : -1e30f;
        S1[i] = d1 <= 128 ? S1[i] : -1e30f;
      }
    }
    if (FIXED) {
      float rs = 0.f;
#pragma unroll
      for (int i = 0; i < 16; ++i) {
        S0[i] = __builtin_amdgcn_exp2f(S0[i]);
        S1[i] = __builtin_amdgcn_exp2f(S1[i]);
        rs += S0[i] + S1[i];
      }
      l_run += rs;
    } else {
      float mx = S0[0];
#pragma unroll
      for (int i = 1; i < 16; ++i) mx = fmaxf(mx, S0[i]);
#pragma unroll
      for (int i = 0; i < 16; ++i) mx = fmaxf(mx, S1[i]);
      mx = fmaxf(mx, __shfl_xor(mx, 32, 64));
      const float mnew = fmaxf(m_run, mx);
      const float alpha = __builtin_amdgcn_exp2f(m_run - mnew);
      float rs = 0.f;
#pragma unroll
      for (int i = 0; i < 16; ++i) {
        S0[i] = __builtin_amdgcn_exp2f(S0[i] - mnew);
        S1[i] = __builtin_amdgcn_exp2f(S1[i] - mnew);
        rs += S0[i] + S1[i];
      }
      rs += __shfl_xor(rs, 32, 64);
      l_run = l_run * alpha + rs;
      m_run = mnew;
#pragma unroll
      for (int i = 0; i < 16; ++i) { O0[i] *= alpha; O1[i] *= alpha; }
    }
#pragma unroll
    for (int c = 0; c < 4; ++c) {
      union { unsigned u[4]; bf16x8 v; } pf;
      if (c < 2) {
#pragma unroll
        for (int e = 0; e < 4; ++e) pf.u[e] = pack2(S0[(c & 1) * 8 + 2 * e], S0[(c & 1) * 8 + 2 * e + 1]);
      } else {
#pragma unroll
        for (int e = 0; e < 4; ++e) pf.u[e] = pack2(S1[(c & 1) * 8 + 2 * e], S1[(c & 1) * 8 + 2 * e + 1]);
      }
      O0 = __builtin_amdgcn_mfma_f32_32x32x16_bf16(vfr[c * 2].v, pf.v, O0, 0, 0, 0);
      O1 = __builtin_amdgcn_mfma_f32_32x32x16_bf16(vfr[c * 2 + 1].v, pf.v, O1, 0, 0, 0);
    }

      if (ti + 2 < ntiles) { ASWRITE(rkA, rvA, s2); ASWRITE(rkB, rvB, s2 + 1); }
      __syncthreads();
    }
    s0 = s2;
  }
  __builtin_amdgcn_s_setprio(0);
#undef TILEJ
#undef AGLOAD
#undef ASWRITE
  if (FIXED) l_run += __shfl_xor(l_run, 32, 64);
  const float inv = 1.f / l_run;
  bf16_t* op = p.HO + (size_t)(qrow0 + qw * 32 + q31) * HS + grp * 256 + head * 64 + h * 4;
#pragma unroll
  for (int gi = 0; gi < 4; ++gi) {
    uint2 w;
    w.x = pack2(O0[gi * 4 + 0] * inv, O0[gi * 4 + 1] * inv);
    w.y = pack2(O0[gi * 4 + 2] * inv, O0[gi * 4 + 3] * inv);
    *(uint2*)(op + gi * 8) = w;
    w.x = pack2(O1[gi * 4 + 0] * inv, O1[gi * 4 + 1] * inv);
    w.y = pack2(O1[gi * 4 + 2] * inv, O1[gi * 4 + 3] * inv);
    *(uint2*)(op + 32 + gi * 8) = w;
  }
}

DI float2 c_add(float2 a, float2 b) { return make_float2(a.x + b.x, a.y + b.y); }
DI float2 c_sub(float2 a, float2 b) { return make_float2(a.x - b.x, a.y - b.y); }
DI float2 c_mul(float2 a, float2 w) { return make_float2(a.x * w.x - a.y * w.y, a.x * w.y + a.y * w.x); }
DI float2 c_mni(float2 a) { return make_float2(a.y, -a.x); }
DI float2 c_pi(float2 a) { return make_float2(-a.y, a.x); }
constexpr float RS2 = 0.70710678118654752f;
DI void fft_bottom_r2(float2* X, int lg) {
  const int n2 = 1 << (lg - 1);
  for (int j = tidx(); j < n2; j += NTHR) {
    const float2 a = X[2 * j], b = X[2 * j + 1];
    X[2 * j] = c_add(a, b);
    X[2 * j + 1] = c_sub(a, b);
  }
  __syncthreads();
}
DI void fft_dif(float2* X, int lg) {
  const int n8 = 1 << (lg - 3);
  int s = lg - 1;
  for (; s >= 2; s -= 3) {
    const int q = 1 << (s - 2);
    const float inv = 1.0f / (float)(8 * q);
    for (int j = tidx(); j < n8; j += NTHR) {
      const int p = j & (q - 1);
      const int i0 = ((j >> (s - 2)) << (s + 1)) + p;
      float2 v[8];
#pragma unroll
      for (int k = 0; k < 8; ++k) v[k] = X[i0 + k * q];
      const float r = (float)p * inv;
      const float2 W = make_float2(cos_rev(r), -sin_rev(r));
      const float2 W2 = make_float2(W.x * W.x - W.y * W.y, 2.f * W.x * W.y);
      const float2 W4 = make_float2(W2.x * W2.x - W2.y * W2.y, 2.f * W2.x * W2.y);
      float2 y[8];
#pragma unroll
      for (int k = 0; k < 4; ++k) {
        y[k] = c_add(v[k], v[k + 4]);
        const float2 d = c_mul(c_sub(v[k], v[k + 4]), W);
        y[k + 4] = k == 0 ? d : (k == 1 ? make_float2((d.x + d.y) * RS2, (d.y - d.x) * RS2)
                                        : (k == 2 ? c_mni(d) : make_float2((d.y - d.x) * RS2, -(d.x + d.y) * RS2)));
      }
      float2 z[8];
#pragma unroll
      for (int b = 0; b < 8; b += 4) {
        z[b] = c_add(y[b], y[b + 2]);
        z[b + 2] = c_mul(c_sub(y[b], y[b + 2]), W2);
        z[b + 1] = c_add(y[b + 1], y[b + 3]);
        z[b + 3] = c_mni(c_mul(c_sub(y[b + 1], y[b + 3]), W2));
      }
#pragma unroll
      for (int b = 0; b < 8; b += 2) {
        X[i0 + b * q] = c_add(z[b], z[b + 1]);
        X[i0 + (b + 1) * q] = c_mul(c_sub(z[b], z[b + 1]), W4);
      }
    }
    __syncthreads();
  }
  if (s == 1) {
    const int n4 = 1 << (lg - 2);
    for (int j = tidx(); j < n4; j += NTHR) {
      const float2 x0 = X[4 * j], x1 = X[4 * j + 1], x2 = X[4 * j + 2], x3 = X[4 * j + 3];
      const float2 y0 = c_add(x0, x2), y2 = c_sub(x0, x2), y1 = c_add(x1, x3), y3 = c_mni(c_sub(x1, x3));
      X[4 * j] = c_add(y0, y1); X[4 * j + 1] = c_sub(y0, y1); X[4 * j + 2] = c_add(y2, y3); X[4 * j + 3] = c_sub(y2, y3);
    }
    __syncthreads();
  } else if (s == 0) {
    fft_bottom_r2(X, lg);
  }
}
DI void fft_dit_inv(float2* X, int lg) {
  const int n8 = 1 << (lg - 3);
  const int rem = lg % 3;
  int s = 0;
  if (rem == 1) { fft_bottom_r2(X, lg); s = 1; }
  else if (rem == 2) {
    const int n4 = 1 << (lg - 2);
    for (int j = tidx(); j < n4; j += NTHR) {
      const float2 x0 = X[4 * j], x1 = X[4 * j + 1], x2 = X[4 * j + 2], x3 = X[4 * j + 3];
      const float2 y0 = c_add(x0, x1), y1 = c_sub(x0, x1), y2 = c_add(x2, x3), y3 = c_pi(c_sub(x2, x3));
      X[4 * j] = c_add(y0, y2); X[4 * j + 2] = c_sub(y0, y2); X[4 * j + 1] = c_add(y1, y3); X[4 * j + 3] = c_sub(y1, y3);
    }
    __syncthreads();
    s = 2;
  }
  for (; s + 2 < lg; s += 3) {
    const int q = 1 << s;
    const float inv = 1.0f / (float)(8 * q);
    for (int j = tidx(); j < n8; j += NTHR) {
      const int p = j & (q - 1);
      const int i0 = ((j >> s) << (s + 3)) + p;
      float2 o[8];
#pragma unroll
      for (int k = 0; k < 8; ++k) o[k] = X[i0 + k * q];
      const float r = (float)p * inv;
      const float2 W = make_float2(cos_rev(r), sin_rev(r));
      const float2 W2 = make_float2(W.x * W.x - W.y * W.y, 2.f * W.x * W.y);
      const float2 W4 = make_float2(W2.x * W2.x - W2.y * W2.y, 2.f * W2.x * W2.y);
      float2 z[8];
#pragma unroll
      for (int b = 0; b < 8; b += 2) {
        const float2 t = c_mul(o[b + 1], W4);
        z[b] = c_add(o[b], t); z[b + 1] = c_sub(o[b], t);
      }
      float2 y[8];
#pragma unroll
      for (int b = 0; b < 8; b += 4) {
        const float2 t = c_mul(z[b + 2], W2);
        y[b] = c_add(z[b], t); y[b + 2] = c_sub(z[b], t);
        const float2 u = c_pi(c_mul(z[b + 3], W2));
        y[b + 1] = c_add(z[b + 1], u); y[b + 3] = c_sub(z[b + 1], u);
      }
#pragma unroll
      for (int k = 0; k < 4; ++k) {
        const float2 d = c_mul(y[k + 4], W);
        const float2 t = k == 0 ? d : (k == 1 ? make_float2((d.x - d.y) * RS2, (d.x + d.y) * RS2)
                                              : (k == 2 ? c_pi(d) : make_float2(-(d.x + d.y) * RS2, (d.x - d.y) * RS2)));
        X[i0 + k * q] = c_add(y[k], t);
        X[i0 + (k + 4) * q] = c_sub(y[k], t);
      }
    }
    __syncthreads();
  }
}

DI float conv3(const float* z, int t, int Ls, float w0, float w1, float w2, float bias) {
  const float zm = t > 0 ? z[t - 1] : 0.f, zc = z[t], zp = t < Ls - 1 ? z[t + 1] : 0.f;
  return w0 * zm + w1 * zc + w2 * zp + bias;
}

DI void hyena_item(const Params& p, int l, float2* X, int bp, int c, bool lat) {
  const int Ls = lat ? SEQ : CL, lg = lat ? 14 : 9, N = 2 * Ls;
  const float* zb0 = lat ? p.ZT + (size_t)(2 * bp) * 1024 * SEQ : p.ZTc + (size_t)(2 * bp) * 1024 * CL;
  const float* zb1 = zb0 + (size_t)1024 * Ls;
  const float* cw = p.hy_conv_w + (size_t)l * 3 * 768;
  const float* cb = p.hy_conv_b + (size_t)l * 768;
  const float w00 = cw[c], w01 = cw[768 + c], w02 = cw[1536 + c], b0 = cb[c];
  const float w10 = cw[256 + c], w11 = cw[768 + 256 + c], w12 = cw[1536 + 256 + c], b1 = cb[256 + c];
  const float w20 = cw[512 + c], w21 = cw[768 + 512 + c], w22 = cw[1536 + 512 + c], b2 = cb[512 + c];
  const float* x0a = zb0 + (size_t)c * Ls; const float* x1a = zb0 + (size_t)(256 + c) * Ls; const float* va = zb0 + (size_t)(512 + c) * Ls;
  const float* x0b = zb1 + (size_t)c * Ls; const float* x1b = zb1 + (size_t)(256 + c) * Ls; const float* vb = zb1 + (size_t)(512 + c) * Ls;
#pragma unroll 4
  for (int t = tidx(); t < Ls; t += NTHR) {
    const float ua = conv3(x1a, t, Ls, w10, w11, w12, b1) * conv3(va, t, Ls, w20, w21, w22, b2);
    const float ub = conv3(x1b, t, Ls, w10, w11, w12, b1) * conv3(vb, t, Ls, w20, w21, w22, b2);
    X[t] = make_float2(ua, ub);
    X[Ls + t] = make_float2(0.f, 0.f);
  }
  __syncthreads();
  fft_dif(X, lg);
  const float2* Kh = lat ? p.Khat + (size_t)(l * 256 + c) * (2 * SEQ) : p.Khatc + (size_t)(l * 256 + c) * (2 * CL);
#pragma unroll 8
  for (int i = tidx(); i < N; i += NTHR) {
    const float2 a = X[i], k = Kh[i];
    X[i] = make_float2(a.x * k.x - a.y * k.y, a.x * k.y + a.y * k.x);
  }
  __syncthreads();
  fft_dit_inv(X, lg);
  const float invN = 1.f / (float)N, skip = p.hy_skip[l * 256 + c];
  const size_t rba = lat ? (size_t)(2 * bp) * SEQ : (size_t)T + (size_t)(2 * bp) * CL;
  const size_t rbb = rba + Ls;
#pragma unroll 4
  for (int t = tidx(); t < Ls; t += NTHR) {
    const float2 y = X[t];
    const float ua = conv3(x1a, t, Ls, w10, w11, w12, b1) * conv3(va, t, Ls, w20, w21, w22, b2);
    const float ub = conv3(x1b, t, Ls, w10, w11, w12, b1) * conv3(vb, t, Ls, w20, w21, w22, b2);
    const float oa = (y.x * invN + skip * ua) * conv3(x0a, t, Ls, w00, w01, w02, b0);
    const float ob = (y.y * invN + skip * ub) * conv3(x0b, t, Ls, w00, w01, w02, b0);
    p.HO[(rba + t) * HS + 512 + c] = f2bf(oa);
    p.HO[(rbb + t) * HS + 512 + c] = f2bf(ob);
  }
  __syncthreads();
}

DI void fnet_item(const Params& p, float2* X, int b, int g, int m, bool lat) {
  const int Ls = lat ? SEQ : CL, lg = lat ? 13 : 8;
  const float* zb = lat ? p.ZT + (size_t)b * 1024 * SEQ : p.ZTc + (size_t)b * 1024 * CL;
  const float* re = zb + (size_t)(768 + g * 64 + m) * Ls;
  const bool hasim = (m >= 1 && m <= 31);
  const float* im = zb + (size_t)(768 + g * 64 + 32 + (hasim ? m : 0)) * Ls;
#pragma unroll 8
  for (int t = tidx(); t < Ls; t += NTHR) X[t] = make_float2(re[t], hasim ? im[t] : 0.f);
  __syncthreads();
  fft_dif(X, lg);
  const float s = rsqrtf((float)Ls * 64.f);
  const size_t rb = lat ? (size_t)b * SEQ : (size_t)T + (size_t)b * CL;
#pragma unroll 4
  for (int i = tidx(); i < Ls; i += NTHR) {
    const int k = (int)(__brev((unsigned)i) >> (32 - lg));
    const bf16_t v = f2bf(X[i].x * s);
    p.F[(rb + k) * 256 + g * 64 + m] = v;
    if (hasim) p.F[(rb + ((Ls - k) & (Ls - 1))) * 256 + g * 64 + 64 - m] = v;
  }
  __syncthreads();
}

DI void mixers_phase(const Params& p, int l, char* lds) {
  float2* X = (float2*)lds;
  const int xcd = blockIdx.x & 7;
#pragma unroll 1
  for (int it = 0;; ++it) {
    const int loc = xcd_local(it, l == DEPTH - 1 ? 256 : 264);
    if (loc < 0) break;
    int grp, pair, qrow0, qpos0, jfirst, nloc;
    bool window = false;
    if (loc < 256) {
      grp = loc < 128 ? 1 : 0;
      const int q = loc & 127, qb = q & 63;
      pair = 2 * xcd + (q >> 6);
      qpos0 = qb * 128;
      qrow0 = (pair >> 1) * SEQ + qpos0;
      if (grp) { jfirst = 0; nloc = 128; }
      else {
        const int fb = qb > 0 ? qb - 1 : 0, lb = qb < 63 ? qb + 1 : 63;
        jfirst = fb * 128; nloc = (lb - fb + 1) * 2; window = true;
      }
    } else {
      const int q = loc - 256;
      grp = q >> 2;
      pair = 2 * xcd + ((q >> 1) & 1);
      qpos0 = (q & 1) * 128;
      qrow0 = T + (pair >> 1) * CL + qpos0;
      jfirst = 0; nloc = 0;
    }
    if (grp) attn_item<true>(p, l, lds, grp, pair >> 1, pair & 1, qrow0, qpos0, jfirst, nloc, false);
    else attn_item<false>(p, l, lds, grp, pair >> 1, pair & 1, qrow0, qpos0, jfirst, nloc, window);
  }
#pragma unroll 1
  for (int it = 0;; ++it) {
    int loc = xcd_local(it, l == DEPTH - 1 ? 128 : 256);
    if (loc < 0) break;
    loc &= 255;
    hyena_item(p, l, X, (loc >> 5) & 3, xcd * 32 + (loc & 31), loc < 128);
  }
#pragma unroll 1
  for (int it = 0;; ++it) {
    int loc = xcd_local(it, l == DEPTH - 1 ? 132 : 264);
    if (loc < 0) break;
    if (loc >= 264) loc -= 264;
    const int q = loc < 132 ? loc : loc - 132;
    fnet_item(p, X, xcd, q / 33, q % 33, loc < 132);
  }
}

DI void row_pass(const Params& p, int l, int mode) {
  const int lane = tidx() & 63, wave = tidx() >> 6;
  const int nrows = (l == DEPTH - 1 && mode) ? T : MROWS;
  const bool first = (l == 0 && mode <= 1);
  const float* xl = first ? p.x : p.out;
  const float* xc = first ? p.ctx : p.cx;
  int ml = l, sho = 0, sco = 1024;
  if (mode == 1) { sho = 3072; sco = 4096; }
  if (mode == 2) ml = l + 1;
  const bool has_h = ml < DEPTH;
  const int stride = gridDim.x * 8;
  float4 LG[4], LB[4], GT[4], SH[4], SC[4];
#pragma unroll
  for (int j = 0; j < 4; ++j) {
    const int col = lane * 4 + 256 * j;
    LG[j] = mode ? *(const float4*)((mode == 1 ? p.ln1_g : p.ln2_g) + (size_t)l * D + col) : make_float4(0.f, 0.f, 0.f, 0.f);
    LB[j] = mode ? *(const float4*)((mode == 1 ? p.ln1_b : p.ln2_b) + (size_t)l * D + col) : make_float4(0.f, 0.f, 0.f, 0.f);
    GT[j] = SH[j] = SC[j] = make_float4(0.f, 0.f, 0.f, 0.f);
  }
  int mr_cur = -1;
  int r = blockIdx.x * 8 + wave;
  float4 xv[4];
  uint2 yv[4];
#define ROWLOAD(XV, YV, rr)                                                                       \
  {                                                                                               \
    const float* xs_ = (rr) < T ? xl + (size_t)(rr) * D : xc + (size_t)((rr) - T) * D;            \
    _Pragma("unroll") for (int j = 0; j < 4; ++j) { const f32x4 t_ = __builtin_nontemporal_load((const f32x4*)(xs_ + lane * 4 + 256 * j)); XV[j] = make_float4(t_.x, t_.y, t_.z, t_.w); } \
    if (mode) { const bf16_t* yr_ = p.Y + (size_t)(rr) * D;                                       \
      _Pragma("unroll") for (int j = 0; j < 4; ++j) { const u32x2 t_ = __builtin_nontemporal_load((const u32x2*)(yr_ + lane * 4 + 256 * j)); YV[j] = make_uint2(t_.x, t_.y); } } \
  }
  if (r < nrows) ROWLOAD(xv, yv, r);
#pragma unroll 1
  for (; r < nrows; r += stride) {
    float4 xn[4];
    uint2 yn[4];
    const int rn = r + stride;
    if (rn < nrows) ROWLOAD(xn, yn, rn);
    const bool lat = r < T;
    const int mr = lat ? (r >> 13) : 8;
    if (mr != mr_cur) {
      mr_cur = mr;
      const float* md = p.mod + ((size_t)l * 9 + mr) * 6144;
      const float* md2 = p.mod + ((size_t)(has_h ? ml : l) * 9 + mr) * 6144;
#pragma unroll
      for (int j = 0; j < 4; ++j) {
        const int col = lane * 4 + 256 * j;
        if (mode) GT[j] = *(const float4*)(md + (mode == 1 ? 2048 : 5120) + col);
        SH[j] = *(const float4*)(md2 + sho + col);
        SC[j] = *(const float4*)(md2 + sco + col);
      }
    }
    float v[16];
#pragma unroll
    for (int j = 0; j < 4; ++j) { v[4 * j] = xv[j].x; v[4 * j + 1] = xv[j].y; v[4 * j + 2] = xv[j].z; v[4 * j + 3] = xv[j].w; }
    if (mode) {
      float s = 0.f;
#pragma unroll
      for (int j = 0; j < 4; ++j) {
        v[4 * j] = ALPHA * v[4 * j] + GT[j].x * bf2f(yv[j].x & 0xffffu);
        v[4 * j + 1] = ALPHA * v[4 * j + 1] + GT[j].y * bf2f(yv[j].x >> 16);
        v[4 * j + 2] = ALPHA * v[4 * j + 2] + GT[j].z * bf2f(yv[j].y & 0xffffu);
        v[4 * j + 3] = ALPHA * v[4 * j + 3] + GT[j].w * bf2f(yv[j].y >> 16);
        s += v[4 * j] + v[4 * j + 1] + v[4 * j + 2] + v[4 * j + 3];
      }
      const float mu = wave_sum(s) * (1.f / D);
      float q = 0.f;
#pragma unroll
      for (int i = 0; i < 16; ++i) { const float d = v[i] - mu; q += d * d; }
      const float rstd = rsqrtf(wave_sum(q) * (1.f / D) + 1e-6f);
      float* xd = lat ? p.out + (size_t)r * D : p.cx + (size_t)(r - T) * D;
#pragma unroll
      for (int j = 0; j < 4; ++j) {
        const int col = lane * 4 + 256 * j;
        v[4 * j] = (v[4 * j] - mu) * rstd * LG[j].x + LB[j].x;
        v[4 * j + 1] = (v[4 * j + 1] - mu) * rstd * LG[j].y + LB[j].y;
        v[4 * j + 2] = (v[4 * j + 2] - mu) * rstd * LG[j].z + LB[j].z;
        v[4 * j + 3] = (v[4 * j + 3] - mu) * rstd * LG[j].w + LB[j].w;
        { const f32x4 t_ = {v[4 * j], v[4 * j + 1], v[4 * j + 2], v[4 * j + 3]}; __builtin_nontemporal_store(t_, (f32x4*)(xd + col)); }
      }
    }
    if (has_h) {
      float s = 0.f;
#pragma unroll
      for (int i = 0; i < 16; ++i) s += v[i];
      const float mu = wave_sum(s) * (1.f / D);
      float q = 0.f;
#pragma unroll
      for (int i = 0; i < 16; ++i) { const float d = v[i] - mu; q += d * d; }
      const float rstd = rsqrtf(wave_sum(q) * (1.f / D) + 1e-6f);
      bf16_t* hr = p.HO + (size_t)r * HS;
#pragma unroll
      for (int j = 0; j < 4; ++j) {
        const int col = lane * 4 + 256 * j;
        uint2 w;
        w.x = pack2((v[4 * j] - mu) * rstd * (1.f + SC[j].x) + SH[j].x, (v[4 * j + 1] - mu) * rstd * (1.f + SC[j].y) + SH[j].y);
        w.y = pack2((v[4 * j + 2] - mu) * rstd * (1.f + SC[j].z) + SH[j].z, (v[4 * j + 3] - mu) * rstd * (1.f + SC[j].w) + SH[j].w);
        *(uint2*)(hr + col) = w;
      }
    }
#pragma unroll
    for (int j = 0; j < 4; ++j) { xv[j] = xn[j]; yv[j] = yn[j]; }
  }
#undef ROWLOAD
}

DI void merge_norm_phase(const Params& p, int nrows) {
  const int lane = tidx() & 63, wave = tidx() >> 6;
#pragma unroll 1
  for (int r0 = (blockIdx.x * 8 + wave) * 4; r0 < nrows; r0 += gridDim.x * 32) {
    uint4 a[4], b[4];
#pragma unroll
    for (int k = 0; k < 4; ++k) {
      const int r = r0 + k < nrows ? r0 + k : nrows - 1;
      const bf16_t* hr = p.HO + (size_t)r * HS + lane * 16;
      a[k] = *(const uint4*)hr; b[k] = *(const uint4*)(hr + 8);
    }
#pragma unroll
    for (int k = 0; k < 4; ++k) {
      if (r0 + k >= nrows) break;
      bf16_t* hr = p.HO + (size_t)(r0 + k) * HS + lane * 16;
      unsigned u[8] = {a[k].x, a[k].y, a[k].z, a[k].w, b[k].x, b[k].y, b[k].z, b[k].w};
      float f[16];
      float ss = 0.f;
#pragma unroll
      for (int i = 0; i < 8; ++i) { f[2 * i] = bf2f(u[i] & 0xffffu); f[2 * i + 1] = bf2f(u[i] >> 16); ss += f[2 * i] * f[2 * i] + f[2 * i + 1] * f[2 * i + 1]; }
      ss = row16_sum(ss);
      const float rs = rsqrtf(ss * (1.f / 256.f) + 1e-6f);
#pragma unroll
      for (int i = 0; i < 8; ++i) u[i] = pack2(f[2 * i] * rs, f[2 * i + 1] * rs);
      *(uint4*)hr = make_uint4(u[0], u[1], u[2], u[3]);
      *(uint4*)(hr + 8) = make_uint4(u[4], u[5], u[6], u[7]);
    }
  }
}

DI void conv_tile(float* lds, const float* src, int ldsrc, bf16_t* dst, int ldd, int k0, int n0, const float* rowscale) {
  const int tid = tidx();
#pragma unroll
  for (int i = 0; i < 8; ++i) {
    const int idx = tid + NTHR * i, kk = idx >> 6, nn = idx & 63;
    float v = src[(size_t)(k0 + kk) * ldsrc + n0 + nn];
    if (rowscale) v *= rowscale[k0 + kk];
    lds[kk * 65 + nn] = v;
  }
  __syncthreads();
#pragma unroll
  for (int i = 0; i < 4; ++i) {
    const int pidx = tid + NTHR * i, nn = pidx >> 5, kp = pidx & 31;
    *(unsigned*)(dst + (size_t)(n0 + nn) * ldd + k0 + 2 * kp) = pack2(lds[(2 * kp) * 65 + nn], lds[(2 * kp + 1) * 65 + nn]);
  }
  __syncthreads();
}
DI void fold_tile(float* lds, const float* src, bf16_t* dst, int k0, int g) {
  const int tid = tidx();
  float* cs = lds + 64 * 65;
  float* sn = cs + 64;
#pragma unroll
  for (int i = 0; i < 8; ++i) {
    const int idx = tid + NTHR * i, kk = idx >> 6, nn = idx & 63;
    lds[kk * 65 + nn] = src[(size_t)(k0 + kk) * DP + 1792 + g * 64 + nn];
  }
  if (tid < 64) { cs[tid] = cos_rev((float)tid * (1.f / 64.f)); sn[tid] = sin_rev((float)tid * (1.f / 64.f)); }
  __syncthreads();
#pragma unroll 1
  for (int i = 0; i < 4; ++i) {
    const int pidx = tid + NTHR * i, mp = pidx >> 5, kp = pidx & 31;
    float a0 = 0.f, a1 = 0.f;
    const int mm = mp <= 32 ? mp : mp - 32;
#pragma unroll 4
    for (int j = 0; j < 64; ++j) {
      const int ph = (mm * j) & 63;
      const float cm = mp <= 32 ? cs[ph] : -sn[ph];
      a0 += lds[(2 * kp) * 65 + j] * cm;
      a1 += lds[(2 * kp + 1) * 65 + j] * cm;
    }
    *(unsigned*)(dst + (size_t)(1792 + g * 64 + mp) * HS + k0 + 2 * kp) = pack2(a0, a1);
  }
  __syncthreads();
}
DI void convert_phase(const Params& p, float* lds) {
  constexpr int PER = 2848;
  for (int job = blockIdx.x; job < PER * DEPTH; job += gridDim.x) {
    const int l = job / PER;
    int j = job - l * PER;
    if (j >= 448 && j < 512) {
      j -= 448;
      fold_tile(lds, p.w_in + (size_t)l * D * DP, p.Win + (size_t)l * DP * HS, (j & 15) * 64, j >> 4);
      continue;
    }
    const float* src; bf16_t* dst; int ldsrc, ldd, k0, n0; const float* rs = nullptr;
    if (j < 448) {
      src = p.w_in + (size_t)l * D * DP; ldsrc = DP; dst = p.Win + (size_t)l * DP * HS; ldd = HS; k0 = (j / 28) * 64; n0 = (j % 28) * 64;
    } else if (j < 768) {
      j -= 512;
      src = p.w_out + (size_t)l * D * D; ldsrc = D; dst = p.Wout + (size_t)l * D * HS; ldd = HS; k0 = (j >> 4) * 64; n0 = (j & 15) * 64;
      rs = p.out_norm_g + l * D;
    } else if (j < 2144) {
      j -= 768;
      src = p.ffn_w_up + (size_t)l * D * DFF2; ldsrc = DFF2; dst = p.Wup + (size_t)l * 2 * DFFP * HS; ldd = HS; k0 = (j / 86) * 64; n0 = (j % 86) * 64;
      if (n0 >= DFF) { src += DFF; dst += (size_t)DFFP * HS; n0 -= DFF; ldsrc = DFF2; }
    } else if (j < 2832) {
      j -= 2144;
      src = p.ffn_w_down + (size_t)l * DFF * D; ldsrc = D; dst = p.Wdn + (size_t)l * D * DFFP; ldd = DFFP; k0 = (j >> 4) * 64; n0 = (j & 15) * 64;
    } else {
      j -= 2832;
      src = p.fnet_w + (size_t)l * 256 * 256; ldsrc = 256; dst = p.Wfn + (size_t)l * 256 * 256; ldd = 256; k0 = (j >> 2) * 64; n0 = (j & 3) * 64;
    }
    conv_tile(lds, src, ldsrc, dst, ldd, k0, n0, rs);
  }
}
DI void pad_phase(const Params& p) {
  const int gtid = blockIdx.x * NTHR + tidx(), gn = gridDim.x * NTHR;
  for (int idx = gtid; idx < DEPTH * 2 * 64 * D; idx += gn) {
    const int k = idx & (D - 1), r = (idx >> 10) & 63, h = (idx >> 16) & 1, l = idx >> 17;
    p.Wup[((size_t)l * 2 * DFFP + (size_t)h * DFFP + DFF + r) * HS + k] = 0;
  }
  for (int idx = gtid; idx < DEPTH * D * 64; idx += gn) {
    const int k = idx & 63, r = idx >> 6;
    p.Wdn[(size_t)r * DFFP + DFF + k] = 0;
  }
  for (int idx = gtid; idx < DEPTH * 2 * DFFP; idx += gn) {
    const int c = idx % DFFP, h = (idx / DFFP) & 1, l = idx / (2 * DFFP);
    const bool ok = c < DFF;
    p.bupP[idx] = ok ? p.ffn_b_up[(size_t)l * DFF2 + h * DFF + c] : 0.f;
    p.cbP[idx] = ok ? p.ffn_conv_b[(size_t)l * DFF2 + h * DFF + c] : 0.f;
#pragma unroll
    for (int tap = 0; tap < 3; ++tap)
      p.cwP[(size_t)l * 6 * DFFP + (size_t)(tap * 2 + h) * DFFP + c] = ok ? p.ffn_conv_w[((size_t)l * 3 + tap) * DFF2 + h * DFF + c] : 0.f;
  }
}
DI void mod_phase(const Params& p, float* lds) {
  float* s = lds;
  float* part = lds + 9216;
  const int tid = tidx(), col = tid & 63, ks = tid >> 6;
  for (int item = blockIdx.x; item < DEPTH * 96; item += gridDim.x) {
    const int l = item / 96, n0 = (item % 96) * 64;
    for (int idx = tid; idx < 9 * 1024; idx += NTHR) {
      const int r = idx >> 10, k = idx & 1023;
      s[idx] = siluf(r < 8 ? p.c[r * D + k] : p.c_ctx[k]);
    }
    __syncthreads();
    float acc[9];
#pragma unroll
    for (int r = 0; r < 9; ++r) acc[r] = 0.f;
    const float* w = p.w_ada + (size_t)l * D * 6144 + n0 + col;
    for (int k = ks * 128; k < ks * 128 + 128; ++k) {
      const float wv = w[(size_t)k * 6144];
#pragma unroll
      for (int r = 0; r < 9; ++r) acc[r] += s[r * 1024 + k] * wv;
    }
#pragma unroll
    for (int r = 0; r < 9; ++r) part[(ks * 9 + r) * 64 + col] = acc[r];
    __syncthreads();
    for (int idx = tid; idx < 576; idx += NTHR) {
      const int r = idx >> 6, cc = idx & 63;
      float a = p.b_ada[l * 6144 + n0 + cc];
#pragma unroll
      for (int q = 0; q < 8; ++q) a += part[(q * 9 + r) * 64 + cc];
      p.mod[((size_t)l * 9 + r) * 6144 + n0 + cc] = a;
    }
    __syncthreads();
  }
}
DI void hy_mlp_item(const Params& p, float* lds, int l, int tt, bool lat) {
  const int Ls = lat ? SEQ : CL, t0 = tt * 32, tid = tidx();
  float* feat = lds;
  float* h1 = lds + 544;
  float* h2 = h1 + 2048;
  float* outl = h2 + 2048;
  for (int idx = tid; idx < 32 * 17; idx += NTHR) {
    const int t = idx / 17, f = idx % 17;
    const float tg = (float)(t0 + t);
    float v;
    if (f == 0) v = tg / (float)(Ls - 1);
    else {
      const int jb = (f - 1) & 7;
      const float band = 1e-4f + (float)jb * ((7.f - 1e-4f) / 7.f);
      const float rev = tg * band / (float)Ls;
      v = f <= 8 ? cos_rev(rev) : -sin_rev(rev);
    }
    feat[idx] = v;
  }
  __syncthreads();
  const float* w1 = p.hy_f_w1 + (size_t)l * 17 * 64;
  const float* w2 = p.hy_f_w2 + (size_t)l * 64 * 64;
  const float* w3 = p.hy_f_w3 + (size_t)l * 64 * 512;
#pragma unroll
  for (int i = 0; i < 4; ++i) {
    const int idx = tid + NTHR * i, t = idx >> 6, n = idx & 63;
    float a = p.hy_f_b1[l * 64 + n];
    for (int f = 0; f < 17; ++f) a += feat[t * 17 + f] * w1[f * 64 + n];
    h1[idx] = sin_rev(p.hy_f_freq[l * 64 + n] * a * INV2PI);
  }
  __syncthreads();
#pragma unroll
  for (int i = 0; i < 4; ++i) {
    const int idx = tid + NTHR * i, t = idx >> 6, n = idx & 63;
    float a = p.hy_f_b2[l * 64 + n];
    for (int k = 0; k < 64; ++k) a += h1[t * 64 + k] * w2[k * 64 + n];
    h2[n * 32 + t] = sin_rev(p.hy_f_freq[l * 64 + n] * a * INV2PI);
  }
  __syncthreads();
  {
    const int n = tid, c = n & 255;
    float acc[32];
#pragma unroll
    for (int t = 0; t < 32; ++t) acc[t] = 0.f;
#pragma unroll 2
    for (int k = 0; k < 64; ++k) {
      const float wv = w3[k * 512 + n];
#pragma unroll
      for (int t4 = 0; t4 < 8; ++t4) {
        const float4 hv = *(const float4*)(h2 + k * 32 + t4 * 4);
        acc[4 * t4] += hv.x * wv; acc[4 * t4 + 1] += hv.y * wv; acc[4 * t4 + 2] += hv.z * wv; acc[4 * t4 + 3] += hv.w * wv;
      }
    }
    const float mind = -3.0701134573253946f, maxd = -15.350567286626973f;
    const float delta = fabsf(mind + (maxd - mind) * ((float)c / 255.f));
#pragma unroll
    for (int t = 0; t < 32; ++t) {
      const float tn = (float)(t0 + t) / (float)(Ls - 1);
      outl[n * 33 + t] = acc[t] * __expf(-tn * delta);
    }
  }
  __syncthreads();
  const int N2 = 2 * Ls;
  float* kv = lat ? p.kvec + (size_t)l * 256 * (2 * SEQ) : p.kvecc + (size_t)l * 256 * (2 * CL);
  for (int idx = tid; idx < 512 * 32; idx += NTHR) {
    const int n = idx >> 5, t = idx & 31, c = n & 255, dir = n >> 8, tg = t0 + t;
    float val = outl[n * 33 + t];
    if (dir == 0) {
      if (tg == 0) val += outl[(256 + c) * 33];
      kv[(size_t)c * N2 + tg] = val;
    } else {
      if (tg == 0) kv[(size_t)c * N2 + Ls] = 0.f;
      else kv[(size_t)c * N2 + N2 - tg] = val;
    }
  }
  __syncthreads();
}
DI void khat_item(const Params& p, float2* X, int l, int c, bool lat) {
  const int Ls = lat ? SEQ : CL, lg = lat ? 14 : 9, N = 2 * Ls;
  const float* kv = lat ? p.kvec + (size_t)(l * 256 + c) * N : p.kvecc + (size_t)(l * 256 + c) * N;
  float2* Kh = lat ? p.Khat + (size_t)(l * 256 + c) * N : p.Khatc + (size_t)(l * 256 + c) * N;
#pragma unroll 8
  for (int i = tidx(); i < N; i += NTHR) X[i] = make_float2(kv[i], kv[N + i]);
  __syncthreads();
  fft_dif(X, lg);
#pragma unroll 4
  for (int i = tidx(); i < N; i += NTHR) {
    const int k = (int)(__brev((unsigned)i) >> (32 - lg));
    const int ip = (int)(__brev((unsigned)((N - k) & (N - 1))) >> (32 - lg));
    const float2 z = X[i], w = X[ip];
    Kh[i] = make_float2(0.5f * (z.x + w.x), 0.5f * (z.y - w.y));
    Kh[N + i] = make_float2(0.5f * (z.y + w.y), -0.5f * (z.x - w.x));
  }
  __syncthreads();
}

DI void grid_barrier(unsigned* bar, unsigned n) {
  asm volatile("s_waitcnt vmcnt(0) lgkmcnt(0)" ::: "memory");
  __syncthreads();
  if (threadIdx.x == 0) {
    const unsigned G = gridDim.x;
    __builtin_amdgcn_fence(__ATOMIC_RELEASE, "agent");
    if ((G & 7u) == 0u) {
      const unsigned x = blockIdx.x & 7u, per = G >> 3;
      unsigned* cnt = bar + 64 * (1 + x);
      unsigned* rel = bar + 64 * (9 + x);
      const unsigned old = __hip_atomic_fetch_add(cnt, 1u, __ATOMIC_RELAXED, __HIP_MEMORY_SCOPE_AGENT);
      if (old + 1u == n * per) {
        __hip_atomic_fetch_add(bar, 1u, __ATOMIC_RELAXED, __HIP_MEMORY_SCOPE_AGENT);
        while (__hip_atomic_load(bar, __ATOMIC_RELAXED, __HIP_MEMORY_SCOPE_AGENT) < n * 8u) __builtin_amdgcn_s_sleep(1);
        __hip_atomic_store(rel, n, __ATOMIC_RELAXED, __HIP_MEMORY_SCOPE_AGENT);
      } else {
        while (__hip_atomic_load(rel, __ATOMIC_RELAXED, __HIP_MEMORY_SCOPE_AGENT) < n) __builtin_amdgcn_s_sleep(1);
      }
    } else {
      __hip_atomic_fetch_add(bar, 1u, __ATOMIC_RELAXED, __HIP_MEMORY_SCOPE_AGENT);
      while (__hip_atomic_load(bar, __ATOMIC_RELAXED, __HIP_MEMORY_SCOPE_AGENT) < n * G) __builtin_amdgcn_s_sleep(1);
    }
    __builtin_amdgcn_fence(__ATOMIC_ACQUIRE, "agent");
  }
  __syncthreads();
}

__global__ void __launch_bounds__(NTHR) fwd_megakernel(Params p) {
  extern __shared__ __attribute__((aligned(16))) char lds[];
  cg::grid_group grid = cg::this_grid();
  float* ldsf = (float*)lds;
#pragma unroll 1
  for (int ph2 = 0; ph2 < 2 * (2 + 9 * DEPTH); ++ph2) {
    const int ph = ph2 >> 1;
    int l = 0, kind = ph;
    if (ph >= 2) { l = (ph - 2) / 9; kind = 3 + (ph - 2) % 9; }
    if ((ph2 & 1) && !(l == 0 && ((PROBE_DUP >> kind) & 1))) continue;
    if (kind == 0) {
      convert_phase(p, ldsf);
      pad_phase(p);
      mod_phase(p, ldsf);
#pragma unroll 1
      for (int item = blockIdx.x; item < DEPTH * 264; item += gridDim.x) {
        const int ll = item / 264, r = item % 264;
        hy_mlp_item(p, ldsf, ll, r < 256 ? r : r - 256, r < 256);
      }
    } else if (kind == 1) {
#pragma unroll 1
      for (int item = blockIdx.x; item < 2 * DEPTH * 128; item += gridDim.x)
        khat_item(p, (float2*)lds, (item >> 7) & 3, (item & 127) * 2, item < DEPTH * 128);
    }
    if (kind == 0) {
    } else if (kind == 1 || kind == 8 || kind == 11) {
      row_pass(p, l, kind == 1 ? 0 : (kind == 8 ? 1 : 2));
    } else if (kind == 3) {
      inproj_phase(p, l, lds);
    } else if (kind == 4) {
      mixers_phase(p, l, lds);
    } else if (kind == 6) {
      merge_norm_phase(p, l == DEPTH - 1 ? T : MROWS);
    } else if (kind == 9) {
      ffn_up_phase(p, l, lds);
    } else {
      const bf16_t* A; const bf16_t* Wt; const float* bias; bf16_t* out; int lda, ldw, K, NTn, ocol0;
      if (kind == 5) { A = p.F; lda = 256; Wt = p.Wfn + (size_t)l * 256 * 256; ldw = 256; K = 256; NTn = 1; bias = p.fnet_b + l * 256; out = p.HO; ocol0 = 768; }
      else if (kind == 7) { A = p.HO; lda = HS; Wt = p.Wout + (size_t)l * D * HS; ldw = HS; K = D; NTn = 4; bias = p.b_out + l * D; out = p.Y; ocol0 = 0; }
      else { A = p.ACT; lda = DFFP; Wt = p.Wdn + (size_t)l * D * DFFP; ldw = DFFP; K = DFFP; NTn = 4; bias = p.ffn_b_down + l * D; out = p.Y; ocol0 = 0; }
      gemm_plain_phase(lds, A, lda, Wt, ldw, K, l == DEPTH - 1 ? T / 256 : MROWS / 256, NTn, bias, out, kind == 5 ? HS : D, ocol0, kind == 10 ? 1 : 0);
    }
    if (ph == 0) grid.sync();
    else grid_barrier(p.bar, (unsigned)ph);
  }
}

extern "C" void kernel_launch(void* const* d_in, const int* in_sizes, int n_in, void* d_out, int out_size, void* d_ws,
                              size_t ws_size, hipStream_t stream) {
  Params p{};
  const float** pf = (const float**)&p;
  for (int i = 0; i < 34; ++i) pf[i] = (const float*)d_in[i];
  p.out = (float*)d_out;
  char* w = (char*)d_ws;
  size_t off = 8192;
  p.bar = (unsigned*)d_ws;
  (void)hipMemsetAsync(d_ws, 0, 8192, stream);
  auto take = [&](size_t bytes) { char* r = w + off; off += (bytes + 255) & ~(size_t)255; return r; };
  p.Win = (bf16_t*)take((size_t)DEPTH * DP * HS * 2);
  p.Wout = (bf16_t*)take((size_t)DEPTH * D * HS * 2);
  p.Wup = (bf16_t*)take((size_t)DEPTH * 2 * DFFP * HS * 2);
  p.Wdn = (bf16_t*)take((size_t)DEPTH * D * DFFP * 2);
  p.bupP = (float*)take((size_t)DEPTH * 2 * DFFP * 4);
  p.cwP = (float*)take((size_t)DEPTH * 6 * DFFP * 4);
  p.cbP = (float*)take((size_t)DEPTH * 2 * DFFP * 4);
  p.Wfn = (bf16_t*)take((size_t)DEPTH * 256 * 256 * 2);
  p.mod = (float*)take((size_t)DEPTH * 9 * 6144 * 4);
  p.Khat = (float2*)take((size_t)DEPTH * 256 * 2 * SEQ * 8);
  p.Khatc = (float2*)take((size_t)DEPTH * 256 * 2 * CL * 8);
  p.cx = (float*)take((size_t)TC * D * 4);
  p.HO = (bf16_t*)take((size_t)(MROWS + 256) * HS * 2);
  p.Y = (bf16_t*)take((size_t)MROWS * D * 2);
  const size_t r0 = off;
  p.Zq = (bf16_t*)take((size_t)MROWS * HS * 2);
  p.ZT = (float*)take((size_t)NB * 1024 * SEQ * 4);
  p.ZTc = (float*)take((size_t)NB * 1024 * CL * 4);
  p.VT = (bf16_t*)take((size_t)2 * NB * 2 * 64 * LV * 2);
  p.F = (bf16_t*)take((size_t)MROWS * 256 * 2);
  const size_t r1 = off;
  p.ACT = (bf16_t*)(w + r0);
  p.kvec = (float*)(w + r0);
  p.kvecc = (float*)(w + r0 + (size_t)DEPTH * 256 * 2 * SEQ * 4);
  const size_t act_end = r0 + (size_t)MROWS * DFFP * 2;
  if (act_end > off) off = act_end;
  (void)r1;
  if (off > ws_size) fprintf(stderr, "workspace too small: need %zu have %zu\n", off, ws_size);
  static int grid_blocks = 0;
  if (!grid_blocks) {
    (void)hipFuncSetAttribute((const void*)fwd_megakernel, hipFuncAttributeMaxDynamicSharedMemorySize, (int)LDS_BYTES);
    int dev = 0, cus = 0, per_cu = 0;
    (void)hipGetDevice(&dev);
    (void)hipDeviceGetAttribute(&cus, hipDeviceAttributeMultiprocessorCount, dev);
    (void)hipOccupancyMaxActiveBlocksPerMultiprocessor(&per_cu, fwd_megakernel, NTHR, LDS_BYTES);
    if (per_cu > 1) per_cu = 1;
    grid_blocks = cus * per_cu;
  }
  void* args[] = {&p};
  hipError_t e = hipLaunchCooperativeKernel((void*)fwd_megakernel, dim3(grid_blocks), dim3(NTHR), args, LDS_BYTES, stream);
  if (e != hipSuccess) fprintf(stderr, "cooperative launch failed: %s (grid %d)\n", hipGetErrorString(e), grid_blocks);
}
```
